# Optimizing an MI355X kernel written in HIP

```python
import jax
import jax.numpy as jnp
from jax import lax
import numpy as np

D_MODEL = 1024
BATCH = 8
SEQ = 2048
DEPTH = 2

F32 = jnp.float32
NORM_EPS = 1e-6
MIX_W = D_MODEL // 2

CONV_CH = MIX_W
CONV_WIDTH = 31
CONV_LN_EPS = 1e-5

GLA_HEADS = 4
GLA_DV = MIX_W // GLA_HEADS
GLA_DK = GLA_DV // 2
GLA_GATE_RANK = 16
GLA_TAU = 16.0
GLA_CHUNK = 64

RWKV_HEADS = 8
RWKV_HD = MIX_W // RWKV_HEADS
RWKV_W_RANK = 64
RWKV_A_RANK = 64
RWKV_G_RANK = 128
RWKV_DECAY_SCALE = 0.606531
RWKV_GN_EPS = 64e-5
RWKV_L2_EPS = 1e-12

FOX_HEADS = 8
FOX_HD = MIX_W // FOX_HEADS
FOX_BLOCK = 128

FFN_DENSE = 2816
N_EXPERTS = 8
TOP_K = 2
FFN_EXPERT = 3584

L0_SPLITS = (CONV_CH, CONV_CH, GLA_HEADS * GLA_DK, GLA_HEADS * GLA_DK, MIX_W, MIX_W, GLA_GATE_RANK)
RWKV_SPLITS = (MIX_W, MIX_W, MIX_W, RWKV_W_RANK, RWKV_A_RANK, RWKV_G_RANK)
FOX_SPLITS = (MIX_W, MIX_W, MIX_W, FOX_HEADS)
L0_COLS = sum(L0_SPLITS)
RWKV_COLS = sum(RWKV_SPLITS)
L1_COLS = RWKV_COLS + sum(FOX_SPLITS)

kernel_name = "hybrid_conv_gla_rwkv7_fox_moe_trunk"


def _split(p, sizes):
    idx = np.cumsum(sizes)[:-1].tolist()
    return jnp.split(p, idx, axis=-1)


def rmsnorm(x, g):
    xf = x.astype(F32)
    y = xf * lax.rsqrt(jnp.mean(xf * xf, axis=-1, keepdims=True) + NORM_EPS) * g.astype(F32)
    return y.astype(x.dtype)


def swiglu(h, w1, w3, w2):
    return (jax.nn.silu(h @ w1) * (h @ w3)) @ w2


def conformer_conv(val, gate, conv_w, conv_b, ln_g, ln_b):
    u = val * jax.nn.sigmoid(gate)
    u = lax.conv_general_dilated(
        u, conv_w[:, None, :], window_strides=(1,), padding=[(CONV_WIDTH - 1, 0)],
        dimension_numbers=("NWC", "WIO", "NWC"), feature_group_count=CONV_CH) + conv_b
    uf = u.astype(F32)
    mu = jnp.mean(uf, axis=-1, keepdims=True)
    var = jnp.mean(jnp.square(uf - mu), axis=-1, keepdims=True)
    uf = (uf - mu) * lax.rsqrt(var + CONV_LN_EPS) * ln_g + ln_b
    return jax.nn.silu(uf).astype(val.dtype)


def gla(q, k, v, g_out, a_lr, w_a2, b_a, norm_g):
    B, T, _ = q.shape
    H, C = GLA_HEADS, GLA_CHUNK
    N = T // C
    log_a = jax.nn.log_sigmoid((a_lr @ w_a2 + b_a).astype(F32)) / GLA_TAU

    def chunks(t, d):
        return t.astype(F32).reshape(B, N, C, H, d).transpose(0, 3, 1, 2, 4)

    qc = chunks(q, GLA_DK) * (GLA_DK ** -0.5)
    kc = chunks(k, GLA_DK)
    vc = chunks(v, GLA_DV)
    b = jnp.cumsum(chunks(log_a, GLA_DK), axis=3)
    b_last = b[:, :, :, -1:, :]
    q_dec = qc * jnp.exp(b)
    k_dec = kc * jnp.exp(-b)
    k_end = kc * jnp.exp(b_last - b)
    causal = jnp.tril(jnp.ones((C, C), dtype=bool))
    attn = jnp.where(causal, jnp.einsum("bhnik,bhnjk->bhnij", q_dec, k_dec), 0.0)
    o_intra = jnp.einsum("bhnij,bhnjv->bhniv", attn, vc)

    def step(S, inp):
        q_d, k_e, v_n, decay = inp
        o = jnp.einsum("bhck,bhkv->bhcv", q_d, S)
        S = S * decay[..., None] + jnp.einsum("bhck,bhcv->bhkv", k_e, v_n)
        return S, o

    xs = (jnp.moveaxis(q_dec, 2, 0), jnp.moveaxis(k_end, 2, 0), jnp.moveaxis(vc, 2, 0),
          jnp.moveaxis(jnp.exp(b_last[:, :, :, 0, :]), 2, 0))
    S0 = jnp.zeros((B, H, GLA_DK, GLA_DV), F32)
    _, o_inter = lax.scan(step, S0, xs)
    o = o_intra + jnp.moveaxis(o_inter, 0, 2)
    o = o * lax.rsqrt(jnp.mean(o * o, axis=-1, keepdims=True) + NORM_EPS)
    o = o.transpose(0, 2, 3, 1, 4).reshape(B, T, H * GLA_DV) * norm_g
    return (o * jax.nn.silu(g_out.astype(F32))).astype(q.dtype)


def rwkv7(p, mu, w_w2, w0, w_a2, a0, w_g2, k_k, k_a, r_k, lnx_g, lnx_b):
    B, T, _ = p.shape
    H, N = RWKV_HEADS, RWKV_HD
    prev = jnp.pad(p, ((0, 0), (1, 0), (0, 0)))[:, :-1]
    p = p + (prev - p) * mu
    r, k, v, xw, xa, xg = _split(p, RWKV_SPLITS)
    log_w = -RWKV_DECAY_SCALE * jax.nn.sigmoid((w0 + jnp.tanh(xw) @ w_w2).astype(F32))
    a = jax.nn.sigmoid((a0 + xa @ w_a2).astype(F32))
    g = (jax.nn.sigmoid(xg) @ w_g2).astype(F32)

    def heads(t):
        return t.astype(F32).reshape(B, T, H, N)

    kk = heads(k * k_k)
    kk = kk / jnp.maximum(jnp.sqrt(jnp.sum(kk * kk, axis=-1, keepdims=True)), RWKV_L2_EPS)
    k_mod = k.astype(F32) * (1.0 + (a - 1.0) * k_a)
    rh, kh, vh, ah, wh = heads(r), heads(k_mod), heads(v), heads(a), jnp.exp(heads(log_w))

    def step(S, inp):
        r_t, w_t, k_t, v_t, kk_t, a_t = inp
        sa = jnp.einsum("bhvk,bhk->bhv", S, kk_t)
        S = (S * w_t[:, :, None, :] - sa[..., None] * (kk_t * a_t)[:, :, None, :]
             + v_t[..., None] * k_t[:, :, None, :])
        return S, jnp.einsum("bhvk,bhk->bhv", S, r_t)

    xs = (jnp.moveaxis(rh, 1, 0), jnp.moveaxis(wh, 1, 0), jnp.moveaxis(kh, 1, 0),
          jnp.moveaxis(vh, 1, 0), jnp.moveaxis(kk, 1, 0), jnp.moveaxis(ah, 1, 0))
    S0 = jnp.zeros((B, H, N, N), F32)
    _, y = lax.scan(step, S0, xs)
    y = jnp.moveaxis(y, 0, 1)
    mean = jnp.mean(y, axis=-1, keepdims=True)
    var = jnp.mean(jnp.square(y - mean), axis=-1, keepdims=True)
    y = ((y - mean) * lax.rsqrt(var + RWKV_GN_EPS)).reshape(B, T, H * N) * lnx_g + lnx_b
    bonus = jnp.sum(rh * kh * r_k, axis=-1, keepdims=True) * vh
    y = y + bonus.reshape(B, T, H * N)
    return (y * g).astype(p.dtype)


def fox(q, k, v, f_logit, b_f):
    B, T, _ = q.shape
    H, d = FOX_HEADS, FOX_HD
    log_f = jax.nn.log_sigmoid((f_logit + b_f).astype(F32))
    c = jnp.cumsum(log_f, axis=1).transpose(0, 2, 1)

    def heads(t):
        return t.reshape(B, T, H, d).transpose(0, 2, 1, 3)

    qh, kh, vh = heads(q * (d ** -0.5)), heads(k), heads(v)
    outs = []
    for i in range(T // FOX_BLOCK):
        lo, hi = i * FOX_BLOCK, (i + 1) * FOX_BLOCK
        s = jnp.einsum("bhqd,bhkd->bhqk", qh[:, :, lo:hi], kh[:, :, :hi]).astype(F32)
        s = s + c[:, :, lo:hi, None] - c[:, :, None, :hi]
        mask = (lo + jnp.arange(FOX_BLOCK))[:, None] >= jnp.arange(hi)[None, :]
        pr = jax.nn.softmax(jnp.where(mask, s, -jnp.inf), axis=-1)
        outs.append(jnp.einsum("bhqk,bhkd->bhqd", pr.astype(vh.dtype), vh[:, :, :hi]))
    o = jnp.concatenate(outs, axis=2)
    return o.transpose(0, 2, 1, 3).reshape(B, T, H * d)


def moe(h, router, w1, w3, w2):
    logits = (h @ router).astype(F32)
    top_v, top_i = lax.top_k(logits, TOP_K)
    gates = jax.nn.softmax(top_v, axis=-1)
    dense_gate = jnp.sum(jax.nn.one_hot(top_i, N_EXPERTS, dtype=F32) * gates[..., None], axis=-2)
    out = jnp.zeros(h.shape, F32)
    for e in range(N_EXPERTS):
        out = out + dense_gate[..., e:e + 1] * swiglu(h, w1[e], w3[e], w2[e]).astype(F32)
    return out.astype(h.dtype)


def setup_inputs(seed: int = 0) -> dict:
    key = jax.random.key(seed)
    ks = iter(jax.random.split(key, 48))
    D = D_MODEL

    def nrm(shape, scale):
        return jax.random.normal(next(ks), shape, F32) * scale

    def gain(shape):
        return 1.0 + nrm(shape, 0.02)

    return {
        "x": nrm((BATCH, SEQ, D), 1.0),
        "norm_mix_g": gain((DEPTH, D)),
        "norm_ffn_g": gain((DEPTH, D)),
        "w_in0": nrm((D, L0_COLS), D ** -0.5),
        "conv_w": nrm((CONV_WIDTH, CONV_CH), CONV_WIDTH ** -0.5),
        "conv_b": nrm((CONV_CH,), 0.02),
        "conv_ln_g": gain((CONV_CH,)),
        "conv_ln_b": nrm((CONV_CH,), 0.02),
        "gla_w_a2": nrm((GLA_GATE_RANK, GLA_HEADS * GLA_DK), GLA_GATE_RANK ** -0.5),
        "gla_b_a": nrm((GLA_HEADS * GLA_DK,), 0.1),
        "gla_norm_g": gain((MIX_W,)),
        "w_out0": nrm((2 * MIX_W, D), (2 * MIX_W) ** -0.5),
        "ffn_w1": nrm((D, FFN_DENSE), D ** -0.5),
        "ffn_w3": nrm((D, FFN_DENSE), D ** -0.5),
        "ffn_w2": nrm((FFN_DENSE, D), FFN_DENSE ** -0.5),
        "w_in1": nrm((D, L1_COLS), D ** -0.5),
        "rwkv_mu": jax.random.uniform(next(ks), (RWKV_COLS,), F32),
        "rwkv_w2": nrm((RWKV_W_RANK, MIX_W), 0.5 * RWKV_W_RANK ** -0.5),
        "rwkv_w0": nrm((MIX_W,), 0.5),
        "rwkv_a2": nrm((RWKV_A_RANK, MIX_W), RWKV_A_RANK ** -0.5),
        "rwkv_a0": nrm((MIX_W,), 0.1),
        "rwkv_g2": nrm((RWKV_G_RANK, MIX_W), RWKV_G_RANK ** -0.5),
        "rwkv_k_k": 0.85 + nrm((MIX_W,), 0.02),
        "rwkv_k_a": gain((MIX_W,)),
        "rwkv_r_k": nrm((RWKV_HEADS, RWKV_HD), 0.1),
        "rwkv_lnx_g": gain((MIX_W,)),
        "rwkv_lnx_b": nrm((MIX_W,), 0.02),
        "fox_b_f": 2.0 + nrm((FOX_HEADS,), 0.5),
        "w_out1": nrm((2 * MIX_W, D), (2 * MIX_W) ** -0.5),
        "moe_router": nrm((D, N_EXPERTS), D ** -0.5),
        "moe_w1": nrm((N_EXPERTS, D, FFN_EXPERT), D ** -0.5),
        "moe_w3": nrm((N_EXPERTS, D, FFN_EXPERT), D ** -0.5),
        "moe_w2": nrm((N_EXPERTS, FFN_EXPERT, D), FFN_EXPERT ** -0.5),
        "final_norm_g": gain((D,)),
    }


def reference(x, norm_mix_g, norm_ffn_g, w_in0, conv_w, conv_b, conv_ln_g, conv_ln_b,
              gla_w_a2, gla_b_a, gla_norm_g, w_out0, ffn_w1, ffn_w3, ffn_w2,
              w_in1, rwkv_mu, rwkv_w2, rwkv_w0, rwkv_a2, rwkv_a0, rwkv_g2, rwkv_k_k, rwkv_k_a,
              rwkv_r_k, rwkv_lnx_g, rwkv_lnx_b, fox_b_f, w_out1,
              moe_router, moe_w1, moe_w3, moe_w2, final_norm_g):
    h = x
    for layer in range(DEPTH):
        u = rmsnorm(h, norm_mix_g[layer])
        if layer % 2 == 0:
            p = u @ w_in0
            c_val, c_gate, q, k, v, g_out, a_lr = _split(p, L0_SPLITS)
            y_conv = conformer_conv(c_val, c_gate, conv_w, conv_b, conv_ln_g, conv_ln_b)
            y_gla = gla(q, k, v, g_out, a_lr, gla_w_a2, gla_b_a, gla_norm_g)
            h = h + jnp.concatenate([y_conv, y_gla], axis=-1) @ w_out0
            h = h + swiglu(rmsnorm(h, norm_ffn_g[layer]), ffn_w1, ffn_w3, ffn_w2)
        else:
            p = u @ w_in1
            p_rwkv, p_fox = p[..., :RWKV_COLS], p[..., RWKV_COLS:]
            y_rwkv = rwkv7(p_rwkv, rwkv_mu, rwkv_w2, rwkv_w0, rwkv_a2, rwkv_a0, rwkv_g2,
                           rwkv_k_k, rwkv_k_a, rwkv_r_k, rwkv_lnx_g, rwkv_lnx_b)
            fq, fk, fv, f_logit = _split(p_fox, FOX_SPLITS)
            y_fox = fox(fq, fk, fv, f_logit, fox_b_f)
            h = h + jnp.concatenate([y_rwkv, y_fox], axis=-1) @ w_out1
            h = h + moe(rmsnorm(h, norm_ffn_g[layer]), moe_router, moe_w1, moe_w3, moe_w2)
    return rmsnorm(h, final_norm_g)
```

```cpp
#include <hip/hip_runtime.h>
#include <hip/hip_bf16.h>
#include <cstdio>
#include <cstdint>
#include <cmath>

#define LAS __attribute__((address_space(3)))
#define GAS __attribute__((address_space(1)))
typedef unsigned short bf16_t;
typedef short bf16x8 __attribute__((ext_vector_type(8)));
typedef float f32x4 __attribute__((ext_vector_type(4)));
typedef float f32x2 __attribute__((ext_vector_type(2)));
typedef unsigned u32x4 __attribute__((ext_vector_type(4)));
typedef unsigned u32x2 __attribute__((ext_vector_type(2)));
typedef float f32x16 __attribute__((ext_vector_type(16)));
typedef int v8i32 __attribute__((ext_vector_type(8)));
__device__ __forceinline__ unsigned pk_fp8x4(float a, float b, float c, float d) { a = fminf(fmaxf(a, -448.f), 448.f); b = fminf(fmaxf(b, -448.f), 448.f); c = fminf(fmaxf(c, -448.f), 448.f); d = fminf(fmaxf(d, -448.f), 448.f);
    int w = __builtin_amdgcn_cvt_pk_fp8_f32(a, b, 0, false); w = __builtin_amdgcn_cvt_pk_fp8_f32(c, d, w, true); return (unsigned)w; }

__device__ __forceinline__ unsigned cvt_pk_bf16(float lo, float hi) { unsigned r; asm volatile("v_cvt_pk_bf16_f32 %0, %1, %2" : "=v"(r) : "v"(lo), "v"(hi)); return r; }
__device__ __forceinline__ float bf2f(bf16_t b) { return __uint_as_float(((unsigned)b) << 16); }
__device__ __forceinline__ float bflo(unsigned w) { return __uint_as_float(w << 16); }
__device__ __forceinline__ float bfhi(unsigned w) { return __uint_as_float(w & 0xffff0000u); }
__device__ __forceinline__ unsigned f2bf(float f) { unsigned u = __float_as_uint(f); return (u + 0x7fffu + ((u >> 16) & 1u)) >> 16; }
__device__ __forceinline__ unsigned pk2(float lo, float hi) { return f2bf(lo) | (f2bf(hi) << 16); }
__device__ __forceinline__ float sigmoidf_(float x) { return __builtin_amdgcn_rcpf(1.0f + __expf(-x)); }
__device__ __forceinline__ float siluf_(float x) { return x * __builtin_amdgcn_rcpf(1.0f + __expf(-x)); }
__device__ __forceinline__ float logsigmoidf_(float x) { return fminf(x, 0.f) - log1pf(__expf(-fabsf(x))); }
__device__ __forceinline__ int fresh_tid() { int t = (int)threadIdx.x; asm volatile("" : "+v"(t)); return t; }
__device__ __forceinline__ float rows_sum(float v) {
    { const auto r = __builtin_amdgcn_permlane16_swap(__float_as_uint(v), __float_as_uint(v), false, false); v = __uint_as_float(r[0]) + __uint_as_float(r[1]); }
    { const auto r = __builtin_amdgcn_permlane32_swap(__float_as_uint(v), __float_as_uint(v), false, false); v = __uint_as_float(r[0]) + __uint_as_float(r[1]); }
    return v;
}
__device__ __forceinline__ float wave_sum(float v) {
    v += __int_as_float(__builtin_amdgcn_update_dpp(0, __float_as_int(v), 0xB1, 0xF, 0xF, false));
    v += __int_as_float(__builtin_amdgcn_update_dpp(0, __float_as_int(v), 0x4E, 0xF, 0xF, false));
    v += __int_as_float(__builtin_amdgcn_update_dpp(0, __float_as_int(v), 0x141, 0xF, 0xF, false));
    v += __int_as_float(__builtin_amdgcn_update_dpp(0, __float_as_int(v), 0x140, 0xF, 0xF, false));
    return rows_sum(v);
}

#define WT_RSRC(p) __builtin_amdgcn_make_buffer_rsrc((void*)(p), 0, 0x7fffffff, 0x27000)
__device__ __forceinline__ void wt_store16(__amdgpu_buffer_rsrc_t r, unsigned off, u32x4 v) { __builtin_amdgcn_raw_buffer_store_b128(v, r, (int)off, 0, 16); }
__device__ __forceinline__ void wt_store8(__amdgpu_buffer_rsrc_t r, unsigned off, u32x2 v) { __builtin_amdgcn_raw_buffer_store_b64(v, r, (int)off, 0, 16); }
namespace pg8 {
constexpr int BM = 256, BK = 64, HALF = 128, HTB = HALF * BK * 2, STAGE_BYTES = 8 * HTB, NXCD = 8, WGM = 8;
__host__ __device__ __forceinline__ int lds_byte(int r, int c) { const int st = (r >> 4) * 2 + (c >> 5), rr = r & 15, cc = c & 31, ob = rr * 64 + cc * 2; return st * 1024 + (ob ^ (((ob >> 9) & 1) << 5)); }
__host__ __device__ __forceinline__ void stage_rc(int b, int& R, int& C) { const int st = b / 1024, sb = b % 1024, swz = sb ^ (((sb >> 9) & 1) << 5); R = (st >> 1) * 16 + swz / 64; C = (st & 1) * 32 + (swz % 64) / 2; }
__host__ __device__ __forceinline__ int perm32(int rho) { const int n = rho >> 4, i = rho & 15; return 8 * (i >> 2) + 4 * n + (i & 3); }

struct Unit { int arow; int brow; int orow; int ocol; int nrows; int ex; const int* rows; int koff; int nt; };

struct StaticOrder {
    int nM, nN, nwg, G, c;
    __device__ void init(int M, int N, int G_, int c_) { nM = M / BM; nN = N / BM; nwg = nM * nN; G = G_; c = c_; }
    __device__ bool next(int i, Unit& u) const {
        const long L = (long)i * G + c; if (L >= nwg) return false;
        int wgid = (int)L; { const int q = nwg / NXCD, r = nwg % NXCD, xcd = wgid % NXCD, off = wgid / NXCD; wgid = (xcd < r ? xcd * (q + 1) : r * (q + 1) + (xcd - r) * q) + off; }
        const int nig = WGM * nN, gid = wgid / nig, fm = gid * WGM, gsz = (nM - fm) < WGM ? (nM - fm) : WGM;
        const int pm = fm + ((wgid % nig) % gsz), pn = (wgid % nig) / gsz;
        u.arow = pm * BM; u.brow = pn * BM; u.orow = pm * BM; u.ocol = pn * BM; u.nrows = BM; u.ex = 0; u.rows = nullptr; u.koff = 0; u.nt = 0; return true;
    }
};

template <class Epi, class Sched, bool GATHER, bool FP8 = false>
__device__ __forceinline__ void gemm_phase(LAS unsigned char* lds, const bf16_t* Ab, const bf16_t* Btb, const int K, const Sched& S, const Epi& E) {
    const int tid = fresh_tid(), wid = __builtin_amdgcn_readfirstlane(tid >> 6), lane = tid & 63, wr = wid >> 2, wc = wid & 3, fr = lane & 15, fq = lane >> 4;
    const int nt = K / BK;
    int Rs[2], Cs[2]; unsigned voffB[2];
#pragma unroll
    for (int i = 0; i < 2; ++i) { int R, C; stage_rc(tid * 16 + i * 8192, R, C); const int Rb = Epi::PERM ? ((R & ~31) + perm32(R & 31)) : R; Rs[i] = R; Cs[i] = C; voffB[i] = (unsigned)(Rb * K + C) * 2u; }
    const size_t kstep = (size_t)(BK * 2);
    const size_t hstep = (size_t)HALF * K * 2;
    const unsigned ldsw = (unsigned)wid * 1024u;
    const int aoff = lds_byte(wr * 64 + fr, fq * 8), boff = lds_byte(wc * 32 + fr, fq * 8);
#define PG8_SA(b, h) (((b) * 2 + (h)) * HTB)
#define PG8_SB(b, h) ((4 + (b) * 2 + (h)) * HTB)
#define PG8_STAGE(bufoff, gbase, voff) do { _Pragma("unroll") for (int _i = 0; _i < 2; ++_i) \
        __builtin_amdgcn_global_load_lds((const unsigned*)((const char*)(gbase) + (voff)[_i]), (LAS unsigned*)(lds + (bufoff) + ldsw + _i * 8192), 16, 0, 0); } while (0)
#define PG8_LD8(dst, idx, addr0, addr1) do { const u32x4 lo_ = *(const LAS u32x4*)(addr0), hi_ = *(const LAS u32x4*)(addr1); dst[idx] = (v8i32){(int)lo_[0], (int)lo_[1], (int)lo_[2], (int)lo_[3], (int)hi_[0], (int)hi_[1], (int)hi_[2], (int)hi_[3]}; } while (0)
#define PG8_LDA(dst, b, h) do { if constexpr (FP8) { _Pragma("unroll") for (int m = 0; m < 4; ++m) PG8_LD8(dst##8, m, lds + PG8_SA(b, h) + aoff + m * 2048, lds + PG8_SA(b, h) + aoff + m * 2048 + 1024); } \
        else { _Pragma("unroll") for (int m = 0; m < 4; ++m) _Pragma("unroll") for (int k = 0; k < 2; ++k) dst[m][k] = *(const LAS bf16x8*)(lds + PG8_SA(b, h) + aoff + m * 2048 + k * 1024); } } while (0)
#define PG8_LDB(dst, b, h) do { if constexpr (FP8) { _Pragma("unroll") for (int n = 0; n < 2; ++n) PG8_LD8(dst##8, n, lds + PG8_SB(b, h) + boff + n * 2048, lds + PG8_SB(b, h) + boff + n * 2048 + 1024); } \
        else { _Pragma("unroll") for (int n = 0; n < 2; ++n) _Pragma("unroll") for (int k = 0; k < 2; ++k) dst[n][k] = *(const LAS bf16x8*)(lds + PG8_SB(b, h) + boff + n * 2048 + k * 1024); } } while (0)
#define PG8_MMA(ai, bj, At, Bt) do { __builtin_amdgcn_s_setprio(1); \
        if constexpr (FP8) { _Pragma("unroll") for (int m = 0; m < 4; ++m) _Pragma("unroll") for (int n = 0; n < 2; ++n) \
            asm volatile("v_mfma_scale_f32_16x16x128_f8f6f4 %0, %1, %2, %0, %3, %3 op_sel_hi:[0,0,0]" : "+v"(acc[ai][bj][m][n]) : "v"(Bt##8[n]), "v"(At##8[m]), "v"(one8)); } \
        else { _Pragma("unroll") for (int m = 0; m < 4; ++m) _Pragma("unroll") for (int n = 0; n < 2; ++n) _Pragma("unroll") for (int k = 0; k < 2; ++k) \
            acc[ai][bj][m][n] = __builtin_amdgcn_mfma_f32_16x16x32_bf16(Bt[n][k], At[m][k], acc[ai][bj][m][n], 0, 0, 0); } \
        __builtin_amdgcn_s_setprio(0); } while (0)
#define PG8_WAIT_V(n) asm volatile("s_waitcnt vmcnt(" #n ")" ::: "memory")
#define PG8_WAIT_L(n) asm volatile("s_waitcnt lgkmcnt(" #n ")" ::: "memory")
#define PG8_BAR __builtin_amdgcn_s_barrier()
#define PG8_SCHED __builtin_amdgcn_sched_barrier(0)
#define PG8_UNIT_A(u, base, vA) do { if constexpr (GATHER) { base = (const char*)Ab + (size_t)(u).koff * 2; \
            _Pragma("unroll") for (int _h = 0; _h < 2; ++_h) _Pragma("unroll") for (int _i = 0; _i < 2; ++_i) { const int _r = _h * HALF + Rs[_i]; const int _row = (u).rows[_r < (u).nrows ? _r : (u).nrows - 1]; vA[_h][_i] = (unsigned)(_row * K + Cs[_i]) * 2u; } } \
        else { base = (const char*)Ab + ((size_t)(u).arow * K + (u).koff) * 2; \
            _Pragma("unroll") for (int _h = 0; _h < 2; ++_h) _Pragma("unroll") for (int _i = 0; _i < 2; ++_i) vA[_h][_i] = (unsigned)((_h * HALF + Rs[_i]) * K + Cs[_i]) * 2u; } } while (0)
    Unit cur, nxt; int ui = 0;
    if (!S.next(0, cur)) return;
    f32x4 acc[2][2][4][2];
#pragma unroll
    for (int a = 0; a < 2; ++a)
#pragma unroll
        for (int b = 0; b < 2; ++b)
#pragma unroll
            for (int m = 0; m < 4; ++m)
#pragma unroll
                for (int n = 0; n < 2; ++n) acc[a][b][m][n] = (f32x4){0.f, 0.f, 0.f, 0.f};
    const int one8 = 0x7F7F7F7F;
    bf16x8 At[4][2], B0[2][2], B1[2][2]; v8i32 At8[4], B08[2], B18[2];
    const char* cA; unsigned vAc[2][2], vAn[2][2];
    PG8_UNIT_A(cur, cA, vAc);
    const char* cB = (const char*)Btb + ((size_t)cur.brow * K + cur.koff) * 2;
    typename Epi::Pre pre = E.prefetch(cur, wr, fr);
    PG8_STAGE(PG8_SB(0, 0), cB, voffB); PG8_STAGE(PG8_SB(0, 1), cB + hstep, voffB); PG8_STAGE(PG8_SA(0, 0), cA, vAc[0]); PG8_STAGE(PG8_SA(0, 1), cA, vAc[1]);
    if (wr == 1) PG8_BAR;
    PG8_WAIT_V(2); PG8_BAR;
    PG8_STAGE(PG8_SB(1, 0), cB + kstep, voffB); PG8_STAGE(PG8_SA(1, 0), cA + kstep, vAc[0]); PG8_STAGE(PG8_SB(1, 1), cB + hstep + kstep, voffB);
    PG8_WAIT_V(6); PG8_BAR;
    for (;;) {
        const bool has_next = S.next(ui + 1, nxt);
        const char* nA = cA; const char* nB = cB;
#pragma unroll
        for (int h = 0; h < 2; ++h)
#pragma unroll
            for (int i = 0; i < 2; ++i) vAn[h][i] = vAc[h][i];
        if (has_next) { PG8_UNIT_A(nxt, nA, vAn); nB = (const char*)Btb + ((size_t)nxt.brow * K + nxt.koff) * 2; }
        const int ntc = cur.nt ? cur.nt : nt;
        for (int t = 0; t < ntc; t += 2) {
            const bool last = (t == ntc - 2);
            const char* a1 = cA + (size_t)(t + 1) * kstep;
            const char* a2 = last ? nA : cA + (size_t)(t + 2) * kstep; const char* b2 = last ? nB : cB + (size_t)(t + 2) * kstep;
            const char* a3 = a2 + kstep; const char* b3 = b2 + kstep;
            unsigned vs0[2], vs1[2];
#pragma unroll
            for (int i = 0; i < 2; ++i) { vs0[i] = last ? vAn[0][i] : vAc[0][i]; vs1[i] = last ? vAn[1][i] : vAc[1][i]; }
            PG8_LDB(B0, 0, 0); PG8_LDB(B1, 0, 1); PG8_SCHED; PG8_LDA(At, 0, 0); PG8_STAGE(PG8_SA(1, 1), a1, vAc[1]);
            PG8_WAIT_V(8); PG8_WAIT_L(0); PG8_BAR; PG8_MMA(0, 0, At, B0); PG8_MMA(0, 1, At, B1); PG8_BAR; PG8_SCHED;
            PG8_LDA(At, 0, 1); PG8_STAGE(PG8_SB(0, 0), b2, voffB); PG8_STAGE(PG8_SB(0, 1), b2 + hstep, voffB); PG8_STAGE(PG8_SA(0, 0), a2, vs0);
            PG8_WAIT_V(8); PG8_WAIT_L(0); PG8_BAR; PG8_MMA(1, 0, At, B0); PG8_MMA(1, 1, At, B1); PG8_BAR; PG8_SCHED;
            PG8_LDB(B0, 1, 0); PG8_LDB(B1, 1, 1); PG8_SCHED; PG8_LDA(At, 1, 0); PG8_STAGE(PG8_SA(0, 1), a2, vs1);
            PG8_WAIT_V(8); PG8_WAIT_L(0); PG8_BAR; PG8_MMA(0, 0, At, B0); PG8_MMA(0, 1, At, B1); PG8_BAR; PG8_SCHED;
            PG8_LDA(At, 1, 1); PG8_STAGE(PG8_SB(1, 0), b3, voffB); PG8_STAGE(PG8_SB(1, 1), b3 + hstep, voffB); PG8_STAGE(PG8_SA(1, 0), a3, vs0);
            PG8_WAIT_V(8); PG8_WAIT_L(0); PG8_BAR; PG8_MMA(1, 0, At, B0); PG8_MMA(1, 1, At, B1); PG8_BAR; PG8_SCHED;
        }
        if constexpr (FP8) asm volatile("s_nop 15\n\ts_nop 7" ::: "memory");
        if (wr == 0) PG8_BAR;
        E(acc, cur, wr, wc, fr, fq, pre);
        if (!has_next) break;
#pragma unroll
        for (int a = 0; a < 2; ++a)
#pragma unroll
            for (int b = 0; b < 2; ++b)
#pragma unroll
                for (int m = 0; m < 4; ++m)
#pragma unroll
                    for (int n = 0; n < 2; ++n) acc[a][b][m][n] = (f32x4){0.f, 0.f, 0.f, 0.f};
        cur = nxt; cA = nA; cB = nB; ++ui;
        pre = E.prefetch(cur, wr, fr);
#pragma unroll
        for (int h = 0; h < 2; ++h)
#pragma unroll
            for (int i = 0; i < 2; ++i) vAc[h][i] = vAn[h][i];
        if (wr == 1) PG8_BAR;
    }
    PG8_WAIT_V(0);
    PG8_BAR;
#undef PG8_SA
#undef PG8_SB
#undef PG8_STAGE
#undef PG8_LD8
#undef PG8_LDA
#undef PG8_LDB
#undef PG8_MMA
#undef PG8_WAIT_V
#undef PG8_WAIT_L
#undef PG8_BAR
#undef PG8_SCHED
#undef PG8_UNIT_A
}
}
namespace pg8 {
constexpr float NORM_EPS = 1e-6f;
typedef unsigned u64;
constexpr float SSQ_SCALE = 1024.0f;
struct PreNone {}; struct PreU64 { u64 v[2][4]; }; struct PreF32 { float v[2][4]; };
__device__ __forceinline__ float rs_from(u64 v) { return rsqrtf((float)v * (1.0f / (1024.0f * 1024.0f)) + NORM_EPS); }
struct EpiRowScale {
    static constexpr bool PERM = true;
    bf16_t* O; int ldc; const u64* ssq; int q_lo, q_hi; float qscale; float* side; int side_col;
    typedef PreU64 Pre;
    __device__ __forceinline__ Pre prefetch(const Unit& u, int wr, int fr) const { Pre p; const int row0 = u.orow + wr * 64 + fr;
#pragma unroll
        for (int ai = 0; ai < 2; ++ai)
#pragma unroll
            for (int m = 0; m < 4; ++m) p.v[ai][m] = ssq[row0 + ai * HALF + m * 16];
        return p; }
    __device__ __forceinline__ void operator()(const f32x4 (&acc)[2][2][4][2], const Unit& u, int wr, int wc, int fr, int fq, const Pre& pre) const {
        const int row0 = u.orow + wr * 64 + fr, col0 = u.ocol + wc * 32 + 8 * fq;
        const float cs = (u.ocol >= q_lo && u.ocol < q_hi) ? qscale : 1.0f;
        const bool do_side = (side != nullptr) && (u.ocol == side_col) && (wc == 0) && (fq == 0);
        const __amdgpu_buffer_rsrc_t orsrc = WT_RSRC(O);
#pragma unroll
        for (int ai = 0; ai < 2; ++ai)
#pragma unroll
            for (int m = 0; m < 4; ++m) { const int row = row0 + ai * HALF + m * 16; const float rs = rs_from(pre.v[ai][m]) * cs;
                const unsigned rowo = (unsigned)(((size_t)row * ldc + col0) * 2);
#pragma unroll
                for (int bj = 0; bj < 2; ++bj) { const f32x4 v0 = acc[ai][bj][m][0] * rs, v1 = acc[ai][bj][m][1] * rs;
                    u32x4 w; w.x = cvt_pk_bf16(v0[0], v0[1]); w.y = cvt_pk_bf16(v0[2], v0[3]); w.z = cvt_pk_bf16(v1[0], v1[1]); w.w = cvt_pk_bf16(v1[2], v1[3]);
                    wt_store16(orsrc, rowo + bj * HALF * 2, w);
                    if (bj == 0 && do_side) { *(f32x4*)(side + (size_t)row * 8) = v0; *(f32x4*)(side + (size_t)row * 8 + 4) = v1; } } }
    }
};
constexpr float Q8_H = 8.0f, Q8_W = 256.0f, Q8_ACT = 16.0f;
template <bool Q8> struct EpiResid {
    static constexpr bool PERM = false;
    const bf16_t* resid; bf16_t* Hb; unsigned char* H8; u64* ssq_out; bool do_ssq;
    typedef PreNone Pre;
    __device__ __forceinline__ Pre prefetch(const Unit&, int, int) const { return Pre{}; }
    __device__ __forceinline__ void operator()(const f32x4 (&acc)[2][2][4][2], const Unit& u, int wr, int wc, int fr, int fq, const Pre&) const {
        const int row0 = u.orow + wr * 64 + fr, col0 = u.ocol + wc * 32 + 4 * fq;
#pragma unroll
        for (int ai = 0; ai < 2; ++ai) {
            u32x2 rv[4][2][2];
#pragma unroll
            for (int m = 0; m < 4; ++m)
#pragma unroll
                for (int bj = 0; bj < 2; ++bj)
#pragma unroll
                    for (int n = 0; n < 2; ++n) rv[m][bj][n] = *(const u32x2*)(resid + (size_t)(row0 + ai * HALF + m * 16) * 1024 + col0 + bj * HALF + n * 16);
#pragma unroll
            for (int m = 0; m < 4; ++m) { const int row = row0 + ai * HALF + m * 16; const size_t off = (size_t)row * 1024 + col0; float s = 0.f;
#pragma unroll
                for (int bj = 0; bj < 2; ++bj)
#pragma unroll
                    for (int n = 0; n < 2; ++n) { const size_t o = off + bj * HALF + n * 16; const u32x2 r2 = rv[m][bj][n];
                        const f32x4 v = acc[ai][bj][m][n] + (f32x4){bflo(r2.x), bfhi(r2.x), bflo(r2.y), bfhi(r2.y)};
                        { u32x2 w; w.x = cvt_pk_bf16(v[0], v[1]); w.y = cvt_pk_bf16(v[2], v[3]); *(u32x2*)(Hb + o) = w; }
                        s += (v[0] * v[0] + v[1] * v[1]) + (v[2] * v[2] + v[3] * v[3]); }
                s = rows_sum(s);
                if (fq == 0 && do_ssq) atomicAdd(ssq_out + row, (u64)(s * SSQ_SCALE + 0.5f)); } }
    }
};
template <bool GATHER, bool Q8 = false> struct EpiSwiGLU {
    static constexpr bool PERM = true;
    bf16_t* O; int ldo; const u64* ssq; const float* rsl; const int* lists0;
    typedef PreU64 Pre;
    __device__ __forceinline__ Pre prefetch(const Unit& u, int wr, int fr) const { Pre p;
#pragma unroll
        for (int ai = 0; ai < 2; ++ai)
#pragma unroll
            for (int m = 0; m < 4; ++m) { const int r = ai * HALF + wr * 64 + m * 16 + fr;
                if constexpr (GATHER) p.v[ai][m] = (u64)__float_as_uint(rsl[(u.rows - lists0) + (r < u.nrows ? r : u.nrows - 1)]); else p.v[ai][m] = ssq[u.orow + r]; }
        return p; }
    __device__ __forceinline__ void operator()(const f32x4 (&acc)[2][2][4][2], const Unit& u, int wr, int wc, int fr, int fq, const Pre& pre) const {
        const int col0 = (u.ocol >> 1) + wc * 32 + 8 * fq;
        const __amdgpu_buffer_rsrc_t orsrc = WT_RSRC(O);
#pragma unroll
        for (int ai = 0; ai < 2; ++ai)
#pragma unroll
            for (int m = 0; m < 4; ++m) { const int r = ai * HALF + wr * 64 + m * 16 + fr;
                if (r < u.nrows) { const int orow = u.orow + r; const float rs = (GATHER ? __uint_as_float((unsigned)pre.v[ai][m]) : rs_from(pre.v[ai][m])) * (Q8 ? 1.0f / (Q8_H * Q8_W) : 1.0f);
                    const float c1 = -1.4426950408889634f * rs, ic2 = __builtin_amdgcn_rcpf(rs * rs * (Q8 ? Q8_ACT : 1.0f));
                    const f32x2 c1v = {c1, c1}, ic2v = {ic2, ic2};
                    f32x2 o[4];
#pragma unroll
                    for (int n = 0; n < 2; ++n)
#pragma unroll
                        for (int i = 0; i < 2; ++i) { const f32x4 ga = acc[ai][0][m][n], ua = acc[ai][1][m][n];
                            const f32x2 g = i ? __builtin_shufflevector(ga, ga, 2, 3) : __builtin_shufflevector(ga, ga, 0, 1), up = i ? __builtin_shufflevector(ua, ua, 2, 3) : __builtin_shufflevector(ua, ua, 0, 1);
                            const f32x2 t = g * up, x = g * c1v; f32x2 e; e.x = __builtin_amdgcn_exp2f(x.x); e.y = __builtin_amdgcn_exp2f(x.y);
                            const f32x2 d = e * ic2v + ic2v; f32x2 rr; rr.x = __builtin_amdgcn_rcpf(d.x); rr.y = __builtin_amdgcn_rcpf(d.y);
                            o[n * 2 + i] = t * rr; }
                    if constexpr (Q8) { u32x2 w; w.x = pk_fp8x4(o[0].x, o[0].y, o[1].x, o[1].y); w.y = pk_fp8x4(o[2].x, o[2].y, o[3].x, o[3].y); *(u32x2*)((unsigned char*)O + (size_t)orow * ldo + col0) = w; }
                    else { u32x4 w; w.x = cvt_pk_bf16(o[0].x, o[0].y); w.y = cvt_pk_bf16(o[1].x, o[1].y); w.z = cvt_pk_bf16(o[2].x, o[2].y); w.w = cvt_pk_bf16(o[3].x, o[3].y);
                        wt_store16(orsrc, (unsigned)(((size_t)orow * ldo + col0) * 2), w); } } }
    }
};
struct EpiMoeDown {
    static constexpr bool PERM = true;
    bf16_t* O; bf16_t* OP; int tail_row0; int tail_rows; float oscale;
    typedef PreF32 Pre;
    __device__ __forceinline__ Pre prefetch(const Unit& u, int wr, int fr) const { Pre p; const float* gl = (const float*)u.rows;
#pragma unroll
        for (int ai = 0; ai < 2; ++ai)
#pragma unroll
            for (int m = 0; m < 4; ++m) { const int r = ai * HALF + wr * 64 + m * 16 + fr; p.v[ai][m] = gl[r < u.nrows ? r : u.nrows - 1]; }
        return p; }
    __device__ __forceinline__ void operator()(const f32x4 (&acc)[2][2][4][2], const Unit& u, int wr, int wc, int fr, int fq, const Pre& pre) const {
        asm volatile("" : "+v"(fr), "+v"(fq));
        const int col0 = u.ocol + wc * 32 + 8 * fq;
        bf16_t* base = (u.ex == 0) ? O + (size_t)u.orow * 1024 : OP + ((size_t)(u.ex - 1) * tail_rows + (u.orow - tail_row0)) * 1024;
        const __amdgpu_buffer_rsrc_t orsrc = WT_RSRC(base);
#pragma unroll
        for (int ai = 0; ai < 2; ++ai)
#pragma unroll
            for (int m = 0; m < 4; ++m) { const int r = ai * HALF + wr * 64 + m * 16 + fr;
                if (r < u.nrows) { const float gs = pre.v[ai][m] * oscale; const unsigned rowo = (unsigned)(((size_t)r * 1024 + col0) * 2);
#pragma unroll
                    for (int bj = 0; bj < 2; ++bj) { const f32x4 v0 = acc[ai][bj][m][0] * gs, v1 = acc[ai][bj][m][1] * gs;
                        u32x4 w; w.x = cvt_pk_bf16(v0[0], v0[1]); w.y = cvt_pk_bf16(v0[2], v0[3]); w.z = cvt_pk_bf16(v1[0], v1[1]); w.w = cvt_pk_bf16(v1[2], v1[3]);
                        wt_store16(orsrc, rowo + bj * HALF * 2, w); } } }
    }
};
struct EpiLora {
    static constexpr bool PERM = false;
    float* WAG; const float* w0; const float* a0; int M;
    typedef PreNone Pre;
    __device__ __forceinline__ Pre prefetch(const Unit&, int, int) const { return Pre{}; }
    __device__ __forceinline__ void operator()(const f32x4 (&acc)[2][2][4][2], const Unit& u, int wr, int wc, int fr, int fq, const Pre&) const {
        const int type = u.ocol >> 9, colt = (u.ocol & 511) + wc * 32 + 4 * fq, row0 = u.orow + wr * 64 + fr;
        float* base = WAG + (size_t)type * M * 512;
        const __amdgpu_buffer_rsrc_t orsrc = WT_RSRC(base);
        f32x4 bv[2][2];
#pragma unroll
        for (int bj = 0; bj < 2; ++bj)
#pragma unroll
            for (int n = 0; n < 2; ++n) { const int c = colt + bj * HALF + n * 16; bv[bj][n] = type == 0 ? *(const f32x4*)(w0 + c) : (type == 1 ? *(const f32x4*)(a0 + c) : (f32x4){0.f, 0.f, 0.f, 0.f}); }
#pragma unroll
        for (int ai = 0; ai < 2; ++ai)
#pragma unroll
            for (int m = 0; m < 4; ++m) { const int row = row0 + ai * HALF + m * 16;
#pragma unroll
                for (int bj = 0; bj < 2; ++bj)
#pragma unroll
                    for (int n = 0; n < 2; ++n) { f32x4 v = acc[ai][bj][m][n] + bv[bj][n];
                        if (type == 0) {
#pragma unroll
                            for (int i = 0; i < 4; ++i) v[i] = -0.606531f * __builtin_amdgcn_rcpf(1.0f + __expf(-v[i])); }
                        else if (type == 1) {
#pragma unroll
                            for (int i = 0; i < 4; ++i) v[i] = __builtin_amdgcn_rcpf(1.0f + __expf(-v[i])); }
                        const int col = colt + bj * HALF + n * 16;
                        if (type == 0) wt_store16(orsrc, (unsigned)(((size_t)row * 512 + col) * 4), __builtin_bit_cast(u32x4, v));
                        else { u32x2 w; w.x = cvt_pk_bf16(v[0], v[1]); w.y = cvt_pk_bf16(v[2], v[3]);
                            unsigned char* pb = (unsigned char*)base + (type == 1 ? (size_t)row * 2048 + (col >> 6) * 256 + (col & 63) * 2 : (size_t)row * 1024 + col * 2);
                            *(u32x2*)pb = w; } } }
    }
};
}
#ifndef DBL_MASK
#define DBL_MASK 0
#endif
#ifndef DBG_SKIP
#define DBG_SKIP 0
#endif
constexpr int NB = 8, T = 2048, M = NB * T, D = 1024;
constexpr int N0 = 2576, N0P = 2816;
constexpr int C_VAL = 0, C_GATE = 512, C_GQ = 1024, C_GK = 1280, C_GV = 1536, C_GG = 2048, C_ALR = 2560;
constexpr int N1 = 3336, N1P = 3584;
constexpr int R_R = 0, R_K = 512, R_V = 1024, R_XW = 1536, R_XA = 1600, R_XG = 1664, F_Q = 1792, F_K = 2304, F_V = 2816, F_L = 3328;
constexpr int FF = 2816, FE = 3584, NE = 8;
constexpr float C2LOG = 0.125f * 1.4426950408889634f;
constexpr int NWAVES = 8, NTHR = 512;

constexpr size_t WS_CTL = 0, CTL_BYTES = 1u << 20;
constexpr size_t WS_WO1T = CTL_BYTES;
constexpr size_t WS_W0T = WS_WO1T + (size_t)D * D * 2;
constexpr size_t WS_WO0T = WS_W0T + (size_t)N0P * D * 2;
constexpr size_t WS_W13T = WS_WO0T + (size_t)D * D * 2;
constexpr size_t WS_W2T = WS_W13T + (size_t)2 * FF * D * 2;
constexpr size_t WS_W1IN = WS_W2T + (size_t)D * FF * 2;
constexpr size_t WS_LORA = WS_W1IN + (size_t)N1P * D * 2;
constexpr size_t WS_WE13T = WS_LORA + (size_t)1536 * 256 * 2;
constexpr size_t WS_WE2T = WS_WE13T + (size_t)NE * 2 * FE * D * 2;
constexpr size_t RB = WS_WE2T + (size_t)NE * D * FE * 2;
constexpr size_t MB335 = (size_t)M * D * 2;
constexpr size_t WS_XB = RB;
constexpr size_t WS_P0 = RB + MB335;
constexpr size_t WS_YC0 = WS_P0 + (size_t)M * N0P * 2;
constexpr size_t WS_H1B = WS_YC0 + MB335;
constexpr size_t WS_GLT = WS_H1B + MB335;
constexpr size_t WS_GST = WS_GLT + (size_t)1024 * 8192 * 4;
constexpr size_t WS_GDEC = WS_GST + (size_t)1024 * 8192 * 2;
constexpr size_t WS_ACT = RB;
constexpr size_t WS_H2B = WS_WE13T + ((size_t)60 << 20);
static_assert((size_t)NE * 2 * FE * D <= ((size_t)60 << 20) && WS_H2B + MB335 <= WS_WE2T, "h2 fits above the fp8 up-weights");
constexpr size_t WS_H3 = WS_H1B;
constexpr size_t WS_P1 = RB;
constexpr size_t WS_FL32 = RB + (size_t)120 * 1000000;
constexpr size_t WS_CFOX = RB + (size_t)121 * 1000000;
constexpr size_t WS_BON = RB + (size_t)118 * 1000000;
constexpr size_t WS_CAUG = RB + (size_t)122 * 1000000;
constexpr size_t WS_YRAW = WS_W0T;
constexpr size_t WS_ALORA = WS_H1B;
constexpr size_t WS_WAG = WS_H1B + (size_t)M * 256 * 2;
constexpr size_t WS_YC1 = WS_YC0;
constexpr size_t WS_ACTE = RB;
constexpr size_t WS_H3B = RB + (size_t)(32768 + 256) * FE * 2;
constexpr size_t WS_LIST = WS_H3B + MB335;
constexpr size_t WS_GLIST = WS_LIST + (size_t)NE * M * 4;
constexpr size_t WS_RLIST = WS_GLIST + (size_t)NE * M * 4;
constexpr size_t WS_TOKI = WS_RLIST + (size_t)NE * M * 4;
constexpr size_t WS_OUTS = WS_WE13T;
constexpr int MOE_KS = 7, MOE_TAIL_ROWS = 2304;
constexpr size_t WS_OUTP = WS_OUTS + (size_t)32768 * D * 2;
static_assert(WS_OUTP + (size_t)MOE_KS * MOE_TAIL_ROWS * D * 2 <= WS_WE2T, "tail slabs fit over the dead up-weights");
constexpr size_t WS_END = WS_TOKI + (size_t)M * 16;
static_assert(WS_P1 + (size_t)M * N1P * 2 <= WS_BON && WS_BON + (size_t)M * 8 * 4 <= WS_FL32, "bonus map");
static_assert(WS_P1 + (size_t)M * N1P * 2 <= WS_FL32 && WS_CFOX + 64 * 2048 * 4 <= WS_CAUG && WS_CAUG + 64 * 2048 * 8 <= WS_YC0, "layer-1 map");
static_assert(WS_GDEC + 1024 * 64 * 4 <= WS_END, "gla map");
static_assert(WS_YRAW + (size_t)M * 512 * 2 <= WS_W2T && WS_WAG + (size_t)3 * M * 512 * 4 <= WS_END && WS_END <= 487325728ull, "ws map");
constexpr int CW_BAR = 4096, CW_CNT = 8192, CW_SSQ1 = 16384, CW_SSQ2 = 49152, CW_SSQ3 = 81920, CW_SSQ0 = 114688;

constexpr int RING_BYTES = 131072, LDSCTL_OFF = RING_BYTES, MISC_OFF = LDSCTL_OFF + 320, LDS_BYTES = 147456;

#define RLX_AGENT __ATOMIC_RELAXED, __HIP_MEMORY_SCOPE_AGENT
#define LDS_WAIT() asm volatile("s_waitcnt lgkmcnt(0)" ::: "memory")
#define VM_WAIT() asm volatile("s_waitcnt vmcnt(0)" ::: "memory")
#define XB_TMO      128
#define XB_XCNT(j)  (256  + 64 * (j))
#define XB_XSUB(j)  (1280 + 64 * (j))
#define XB_XGEN(j)  (2304 + 64 * (j))
#define XB_TOP      3328
#define XB_TOPGEN   3392
#define XCD_BAR_WORDS 3456
#define XB_SPIN_CAP (1u << 18)

__device__ __forceinline__ unsigned xb_ld(unsigned* p)              { return __hip_atomic_load(p, __ATOMIC_RELAXED, __HIP_MEMORY_SCOPE_AGENT); }
__device__ __forceinline__ unsigned xb_add(unsigned* p, unsigned v) { return __hip_atomic_fetch_add(p, v, __ATOMIC_RELAXED, __HIP_MEMORY_SCOPE_AGENT); }
__device__ __forceinline__ unsigned xb_xcc_id() { return (unsigned)__builtin_amdgcn_s_getreg((3 << 11) | 20) & 0xFu; }
#define XB_SPIN(cond, bar) do { unsigned _sp = 0; while (cond) { __builtin_amdgcn_s_sleep(1); \
    if ((++_sp & 255u) == 0u) { if (xb_ld(&(bar)[XB_TMO])) break; if (_sp > XB_SPIN_CAP) { atomicAdd(&(bar)[XB_TMO], 1u); break; } } } } while (0)

struct XcdBarrier {
    unsigned* bar; unsigned x;
    volatile LAS unsigned* st;
};

__device__ __forceinline__ XcdBarrier xcd_barrier_post(unsigned* bar, volatile LAS unsigned* st) {
    XcdBarrier b; b.bar = bar; b.x = xb_xcc_id(); b.st = st;
    if (threadIdx.x == 0) (void)xb_add(&bar[XB_XCNT(b.x)], 1u);
    return b;
}
__device__ __forceinline__ void xcd_barrier_complete(unsigned* bar, unsigned x, unsigned& nloc, unsigned& nx) {
    const unsigned G = gridDim.x * gridDim.y * gridDim.z;
    unsigned sum, cnt, mine, sp = 0u;
    for (;;) {
        sum = 0u; cnt = 0u; mine = 0u;
#pragma unroll
        for (unsigned j = 0; j < 16; ++j) { const unsigned c = xb_ld(&bar[XB_XCNT(j)]); sum += c; cnt += (c > 0u) ? 1u : 0u; mine = (j == x) ? c : mine; }
        if (sum == G) break;
        __builtin_amdgcn_s_sleep(1);
        if ((++sp & 255u) == 0u) { if (xb_ld(&bar[XB_TMO])) break; if (sp > XB_SPIN_CAP) { atomicAdd(&bar[XB_TMO], 1u); break; } }
    }
    nloc = mine > 0u ? mine : 1u; nx = cnt > 0u ? cnt : 1u;
}

__device__ __forceinline__ void xcd_barrier(const XcdBarrier& b) {
    asm volatile("s_waitcnt vmcnt(0)" ::: "memory");
    __syncthreads();
    if (threadIdx.x == 0) {
        unsigned* bar = b.bar;
        __builtin_amdgcn_s_waitcnt(0);
        unsigned nloc = b.st[0], nx = b.st[1];
        if (nloc == 0u) { xcd_barrier_complete(bar, b.x, nloc, nx); b.st[0] = nloc; b.st[1] = nx; }
        const unsigned old = xb_add(&bar[XB_XSUB(b.x)], 1u);
        const unsigned gen = old / nloc;
        if (old + 1u == (gen + 1u) * nloc) {
            __builtin_amdgcn_fence(__ATOMIC_RELEASE, "agent");
            asm volatile("s_waitcnt vmcnt(0)" ::: "memory");
            const unsigned og = xb_add(&bar[XB_TOP], 1u);
            const unsigned tg = og / nx;
            if (og + 1u == (tg + 1u) * nx) xb_add(&bar[XB_TOPGEN], 1u);
            else XB_SPIN(xb_ld(&bar[XB_TOPGEN]) == tg, bar);
            __builtin_amdgcn_fence(__ATOMIC_ACQUIRE, "agent");
            xb_add(&bar[XB_XGEN(b.x)], 1u);
            asm volatile("s_waitcnt vmcnt(0)" ::: "memory");
        } else {
            XB_SPIN(xb_ld(&bar[XB_XGEN(b.x)]) == gen, bar);
            __builtin_amdgcn_fence(__ATOMIC_ACQUIRE, "agent");
            asm volatile("s_waitcnt vmcnt(0)" ::: "memory");
        }
    }
    __syncthreads();
}
namespace attn_body {
using bf16=__hip_bfloat16;
using bf16x8=__attribute__((ext_vector_type(8)))short;
using s16x4=__attribute__((ext_vector_type(4)))short;
using f32x16=__attribute__((ext_vector_type(16)))float;
using u32x4=__attribute__((ext_vector_type(4)))unsigned;
constexpr int BATCH=8,NHEAD=8,SEQ=2048,D=64,DM=3584,DMO=1024;
constexpr int NW=8,QBLK=32,QB=QBLK*NW,KVBLK=64,NQB=SEQ/QB;
constexpr int ATTN_PITCH=DM, ATTN_UNIT_ROWS=QB;
__device__ __forceinline__ int crow(int r,int hi){return (r&3)+8*(r>>2)+4*hi;}
#define SBAR() __builtin_amdgcn_sched_barrier(0)
__device__ __forceinline__ void cmask(f32x16&p0,f32x16&p1,int jb,int qrel,int hi){
  const float NEG=-INFINITY; int kb=64*jb+4*hi;
  #pragma unroll
  for(int r=0;r<16;++r){int kv=kb+(r&3)+8*(r>>2); if(kv>qrel)p0[r]=NEG; if(kv+32>qrel)p1[r]=NEG;}
}

constexpr int NSLOT=3, SLOTB=8192;
constexpr int LDS_K=0, LDS_V=NSLOT*SLOTB, LDS_WS=2*NSLOT*SLOTB, LDS_OST=LDS_WS+NW*64*4, LDS_AUG=LDS_OST+NW*4096, LDS_BYTES=LDS_AUG+SEQ*8+64;
constexpr float C2=0.125f*1.4426950408889634f;
__device__ __forceinline__ void glds16(const void*gsrc,unsigned lds_dst){unsigned keep;
  asm volatile("s_mov_b32 %0, m0\n\ts_mov_b32 m0, %2\n\ts_nop 0\n\tglobal_load_lds_dwordx4 %1, off\n\ts_mov_b32 m0, %0":"=&s"(keep):"v"(gsrc),"s"(lds_dst):"memory");}
__device__ __forceinline__ float max3f(float a,float b,float c){float r;asm("v_max3_f32 %0, %1, %2, %3":"=v"(r):"v"(a),"v"(b),"v"(c));return r;}
__device__ __forceinline__ float max2f(float a,float b){float r;asm("v_max_f32_e32 %0, %1, %2":"=v"(r):"v"(a),"v"(b));return r;}
__device__ __forceinline__ float fadd_s(float a,float b){float r;asm("v_add_f32_e32 %0, %1, %2":"=v"(r):"v"(a),"v"(b));return r;}
__device__ __forceinline__ float fsub_s(float a,float b){float r;asm("v_sub_f32_e32 %0, %1, %2":"=v"(r):"v"(a),"v"(b));return r;}
typedef float f32x2_t __attribute__((ext_vector_type(2))); typedef __bf16 bf16x2_t __attribute__((ext_vector_type(2)));
__device__ __forceinline__ unsigned cvtpk_s(float lo,float hi){f32x2_t v={lo,hi};bf16x2_t b=__builtin_convertvector(v,bf16x2_t);return __builtin_bit_cast(unsigned,b);}
#define WAIT_BAR(N) asm volatile("s_waitcnt vmcnt(" #N ") lgkmcnt(0)\n\ts_barrier":::"memory")

__device__ __forceinline__ void qkt(f32x16&p0,f32x16&p1,const char*Kslot,const bf16x8*qr,int r32,int hi,bf16x8 ka0,bf16x8 ka1,bf16x8 qa){ const f32x16 negm=f32x16{};
  const char*kb=Kslot+hi*1024+r32*16;
  p0=__builtin_amdgcn_mfma_f32_32x32x16_bf16(ka0,qa,negm,0,0,0);p1=__builtin_amdgcn_mfma_f32_32x32x16_bf16(ka1,qa,negm,0,0,0);
  #pragma unroll
  for(int d0=0;d0<4;++d0){
    const bf16x8 b0=*reinterpret_cast<const bf16x8*>(kb+d0*2048);
    const bf16x8 b1=*reinterpret_cast<const bf16x8*>(kb+d0*2048+512);
    p0=__builtin_amdgcn_mfma_f32_32x32x16_bf16(b0,qr[d0],p0,0,0,0);p1=__builtin_amdgcn_mfma_f32_32x32x16_bf16(b1,qr[d0],p1,0,0,0);}
}
typedef __attribute__((address_space(3))) const char* lds_cptr;
typedef short v4i16_t __attribute__((ext_vector_type(4)));
__device__ __forceinline__ void kload8(bf16x8*kf,lds_cptr kp){
  kf[0]=*(const __attribute__((address_space(3))) bf16x8*)(kp);      kf[1]=*(const __attribute__((address_space(3))) bf16x8*)(kp+512);
  kf[2]=*(const __attribute__((address_space(3))) bf16x8*)(kp+2048); kf[3]=*(const __attribute__((address_space(3))) bf16x8*)(kp+2560);
  kf[4]=*(const __attribute__((address_space(3))) bf16x8*)(kp+4096); kf[5]=*(const __attribute__((address_space(3))) bf16x8*)(kp+4608);
  kf[6]=*(const __attribute__((address_space(3))) bf16x8*)(kp+6144); kf[7]=*(const __attribute__((address_space(3))) bf16x8*)(kp+6656);
}
__device__ __forceinline__ void kload2(bf16x8*kf,lds_cptr kp,int j){ kf[2*j]=*(const __attribute__((address_space(3))) bf16x8*)(kp+j*2048); kf[2*j+1]=*(const __attribute__((address_space(3))) bf16x8*)(kp+j*2048+512); }
__device__ __forceinline__ s16x4 vtr(lds_cptr p){ return __builtin_bit_cast(s16x4,__builtin_amdgcn_ds_read_tr16_b64_v4i16((__attribute__((address_space(3))) v4i16_t*)p)); }
__device__ __forceinline__ float rowmax(const f32x16&p0,const f32x16&p1){
  float a=max3f(p0[0],p0[1],p1[0]),b=max3f(p0[2],p0[3],p1[1]);a=max3f(a,p1[2],p1[3]);
  #pragma unroll
  for(int r=4;r<16;r+=4){a=max3f(a,p0[r],p0[r+1]);b=max3f(b,p0[r+2],p0[r+3]);a=max3f(a,p1[r],p1[r+1]);b=max3f(b,p1[r+2],p1[r+3]);}
  const float m=max2f(a,b);
  auto rr=__builtin_amdgcn_permlane32_swap(__float_as_uint(m),__float_as_uint(m),false,false);
  return max2f(__uint_as_float(rr[0]),__uint_as_float(rr[1]));
}
__device__ __forceinline__ void pv(f32x16*o,int vb,bf16x8 pa0,bf16x8 pa1,bf16x8 pa2,bf16x8 pa3){
  #pragma unroll
  for(int d0=0;d0<2;++d0){s16x4 lo[4],hi[4];
    #pragma unroll
    for(int ks=0;ks<4;++ks){
      asm volatile("ds_read_b64_tr_b16 %0,%1 offset:%c2":"=&v"(lo[ks]):"v"(vb),"i"(d0*4096+ks*1024):"memory");
      asm volatile("ds_read_b64_tr_b16 %0,%1 offset:%c2":"=&v"(hi[ks]):"v"(vb),"i"(d0*4096+ks*1024+512):"memory");}
    asm volatile("s_waitcnt lgkmcnt(0)":::"memory");SBAR();
    #define PK(k) (bf16x8){lo[k][0],lo[k][1],lo[k][2],lo[k][3],hi[k][0],hi[k][1],hi[k][2],hi[k][3]}
    o[d0]=__builtin_amdgcn_mfma_f32_32x32x16_bf16(pa0,PK(0),o[d0],0,0,0);
    o[d0]=__builtin_amdgcn_mfma_f32_32x32x16_bf16(pa1,PK(1),o[d0],0,0,0);
    o[d0]=__builtin_amdgcn_mfma_f32_32x32x16_bf16(pa2,PK(2),o[d0],0,0,0);
    o[d0]=__builtin_amdgcn_mfma_f32_32x32x16_bf16(pa3,PK(3),o[d0],0,0,0);
    #undef PK
  }
}

#ifndef ATTN_STORE16
#define ATTN_STORE16(p,v) (*(u32x4*)(p)=(v))
#endif
template<int THRL> __device__ __forceinline__ void attn_unit(int b,int h,int qb,const bf16*Q,const bf16*__restrict__ K,const bf16*__restrict__ V,bf16*O,const unsigned long long*__restrict__ AUG,char*shm){
  const int tid=fresh_tid(),lane=tid&63,r32=lane&31,hi=lane>>5; const int wid=__builtin_amdgcn_readfirstlane(tid>>6);
  const long rowbase=(long)b*SEQ; const int q0=qb*QB; unsigned long long augq_;
  const bf16*Qw=Q+(rowbase+q0+wid*QBLK)*DM+h*D;
  const bf16*Kh=K+rowbase*DM+h*D,*Vh=V+rowbase*DM+h*D;
  const unsigned lds0=(unsigned)(uintptr_t)shm;
  float*wsf=(float*)(shm+LDS_WS)+wid*64;
  const bf16*ksrc=Kh+(long)lane*DM+wid*8;
  const bf16*vsrc=Vh+(long)(16*(wid&3)+(lane>>2))*DM+(wid>>2)*32+(lane&3)*8;
  const unsigned kdst=lds0+LDS_K+wid*1024, vdst=lds0+LDS_V+wid*1024;
  #define DMA_K(t,slot) glds16(ksrc+(long)(t)*KVBLK*DM,(unsigned)__builtin_amdgcn_readfirstlane(kdst+(slot)))
  #define DMA_V(t,slot) glds16(vsrc+(long)(t)*KVBLK*DM,(unsigned)__builtin_amdgcn_readfirstlane(vdst+(slot)))
  const int vb0=(int)(lds0+LDS_V)+((lane>>4)&1)*32+(lane&3)*8+(4*hi+((lane&15)>>2))*64;
  const char*Kbase=shm+LDS_K; bf16x8 kf[8];
  const lds_cptr shm3=(lds_cptr)shm; const lds_cptr kp0=shm3+LDS_K+hi*1024+r32*16; const lds_cptr vp0=shm3+LDS_V+((lane>>4)&1)*32+(lane&3)*8+(4*hi+((lane&15)>>2))*64;
  const int NT=(q0+QB)/KVBLK;
  const unsigned long long*augb=AUG+(long)(b*NHEAD+h)*SEQ;
  { const int nk=q0+QB; unsigned long long t_[4];
    _Pragma("unroll") for(int i=0;i<4;++i){const int k_=tid+512*i; t_[i]=(k_<nk)?augb[k_]:0ull;}
    const unsigned long long qw_=augb[q0+wid*QBLK+r32];
    asm volatile("s_waitcnt vmcnt(0)":::"memory");
    _Pragma("unroll") for(int i=0;i<4;++i){const int k_=tid+512*i; if(k_<nk)*(unsigned long long*)(shm+LDS_AUG+k_*8)=t_[i];}
    augq_=qw_; }
  bf16x8 qa=__builtin_bit_cast(bf16x8,(u32x4){hi?0u:0x3F803F80u,hi?0u:(0x3F80u|((unsigned)augq_<<16)),hi?0u:(((unsigned)augq_>>16)|((unsigned)(augq_>>32)<<16)),0u});
  #define SETQA() do{ const float nm_=-mhat; const unsigned a1_=cvtpk_s(nm_,0.f)&0xffffu; const float r1_=nm_-__uint_as_float(a1_<<16); const unsigned a2_=cvtpk_s(r1_,0.f)&0xffffu; const float r2_=r1_-__uint_as_float(a2_<<16); const unsigned a3_=cvtpk_s(r2_,0.f)&0xffffu; \
      u32x4 q4_=__builtin_bit_cast(u32x4,qa); q4_[0]=hi?(a1_|(a2_<<16)):q4_[0]; q4_[1]=hi?a3_:q4_[1]; qa=__builtin_bit_cast(bf16x8,q4_); }while(0)
  const lds_cptr augp=(lds_cptr)shm+LDS_AUG+r32*8;
  #define KAUG(t,half) ({ const unsigned long long w_=*(const __attribute__((address_space(3))) unsigned long long*)(augp+((t)*64+(half)*32)*8); \
      __builtin_bit_cast(bf16x8,(u32x4){hi?0x3F803F80u:(((unsigned)w_)^0x80008000u),hi?0x3F80u:(((((unsigned)(w_>>32))&0xffffu)^0x8000u)|0x3F800000u),hi?0u:0x3F803F80u,0u}); })
  DMA_K(0,0);DMA_V(0,0);DMA_K(1,SLOTB);
  bf16x8 qr[4];
  #pragma unroll
  for(int d0=0;d0<4;++d0)qr[d0]=*reinterpret_cast<const bf16x8*>(&Qw[(long)r32*DM+d0*16+hi*8]);
  float mhat=0.f,l_reg=0.f;f32x16 o[2];o[0]=f32x16{};o[1]=f32x16{};const f32x16 zero16=f32x16{};
  const int qrel=wid*QBLK+r32;
  #define CMASK(P0,P1,t) do{int jb_=(t)-(NT-4); if(jb_>=0)cmask(P0,P1,jb_,qrel,hi);}while(0)
  bool resc=false;
  #define START(P0,P1) do{ const float rm=rowmax(P0,P1); resc=false; \
    { const float dl=rm; mhat=fadd_s(mhat,dl); \
      _Pragma("unroll") for(int r=0;r<16;++r){P0[r]=fsub_s(P0[r],dl);P1[r]=fsub_s(P1[r],dl);} \
      SETQA(); } \
    _Pragma("unroll") for(int r=0;r<16;++r)P0[r]=__builtin_amdgcn_exp2f(P0[r]); }while(0)
  #define RESC() do{ if(resc){ asm volatile("s_waitcnt lgkmcnt(0)":::"memory"); \
      _Pragma("unroll") for(int d_=0;d_<2;++d_) _Pragma("unroll") for(int r=0;r<16;++r)o[d_][r]*=wsf[crow(r,hi)]; } }while(0)
  f32x16 pA0,pA1,pB0,pB1;
  int sl_prev=0,sl_cur=0,sl_next=SLOTB;
  #define ROT() do{sl_prev=sl_cur;sl_cur=sl_next;sl_next=(sl_next==(NSLOT-1)*SLOTB)?0:sl_next+SLOTB;}while(0)
  DMA_K(2,2*SLOTB);
  WAIT_BAR(3);
  qkt(pA0,pA1,Kbase,qr,r32,hi,KAUG(0,0),KAUG(0,1),qa);asm volatile("s_nop 15\n\ts_nop 7":"+v"(pA0),"+v"(pA1));CMASK(pA0,pA1,0);
  START(pA0,pA1);
  _Pragma("unroll") for(int r=0;r<16;++r)pA1[r]=__builtin_amdgcn_exp2f(pA1[r]);
  WAIT_BAR(0);
  DMA_K(3,0);DMA_V(1,SLOTB);
  ROT();
  kload8(kf,kp0+sl_cur);
  WAIT_BAR(2);
  s16x4 vlo[8],vhi[8]; u32x4 pw0,pw1,pw2,pw3;
  #define PKW(P,B) cvtpk_s(P[B],P[B+1])
  #define PAF(k) __builtin_bit_cast(bf16x8,pw##k)
  #define VFR(i) (bf16x8){vlo[i][0],vlo[i][1],vlo[i][2],vlo[i][3],vhi[i][0],vhi[i][1],vhi[i][2],vhi[i][3]}
  #define PIN(x) asm volatile("":"+v"(x))
  #define MX3(a,b,c) __builtin_fmaxf(__builtin_fmaxf((a),(b)),(c))
  #define GAPA(MF,A0,A1,A2,A3,W0,W1,PW) do{ MF; sacc+=A0; sacc+=A1; sacc+=A2; sacc+=A3; PIN(sacc); W0; W1; PIN(PW); SBAR(); }while(0)
  #define EX(v) __builtin_amdgcn_exp2f(v)
  #define GAPB(MF,X,B) do{ MF; X[B]=EX(X[B]); X[B+1]=EX(X[B+1]); X[B+2]=EX(X[B+2]); X[B+3]=EX(X[B+3]); PIN(X); SBAR(); }while(0)
  #define VRD(i) do{ vlo[i]=vtr(vp_+(((i)>>2)*4096+((i)&3)*1024)); vhi[i]=vtr(vp_+(((i)>>2)*4096+((i)&3)*1024+512)); }while(0)
  #define KRD(G,j) do{ if(G){ kload2(kf,kp0+sl_next,j); SBAR(); } }while(0)
  #define STEP(C0,C1,P0,P1,t,GK,GV,GL) do{ SBAR(); \
    const lds_cptr vp_=vp0+sl_prev; \
    { const bf16x8 ka0_=KAUG(t,0), ka1_=KAUG(t,1); C0=__builtin_amdgcn_mfma_f32_32x32x16_bf16(ka0_,qa,zero16,0,0,0); C1=__builtin_amdgcn_mfma_f32_32x32x16_bf16(ka1_,qa,zero16,0,0,0); } SBAR(); \
    VRD(0); SBAR(); float sacc=(P0[0]+P0[1]); \
    GAPA(C0=__builtin_amdgcn_mfma_f32_32x32x16_bf16(kf[0],qr[0],C0,0,0,0), P0[2],P0[3],P0[4],P0[5],     pw0[0]=PKW(P0,0), pw0[1]=PKW(P0,2), pw0); \
    VRD(4); SBAR(); GAPA(C1=__builtin_amdgcn_mfma_f32_32x32x16_bf16(kf[1],qr[0],C1,0,0,0), P0[6],P0[7],P0[8],P0[9],     pw0[2]=PKW(P0,4), pw0[3]=PKW(P0,6), pw0); \
    VRD(1); SBAR(); GAPA(C0=__builtin_amdgcn_mfma_f32_32x32x16_bf16(kf[2],qr[1],C0,0,0,0),   P0[10],P0[11],P0[12],P0[13], pw1[0]=PKW(P0,8), pw1[1]=PKW(P0,10), pw1); \
    VRD(5); SBAR(); GAPA(C1=__builtin_amdgcn_mfma_f32_32x32x16_bf16(kf[3],qr[1],C1,0,0,0),   P0[14],P0[15],P1[0],P1[1],   pw1[2]=PKW(P0,12),pw1[3]=PKW(P0,14), pw1); \
    VRD(2); SBAR(); GAPA(C0=__builtin_amdgcn_mfma_f32_32x32x16_bf16(kf[4],qr[2],C0,0,0,0),   P1[2],P1[3],P1[4],P1[5],     pw2[0]=PKW(P1,0), pw2[1]=PKW(P1,2), pw2); \
    VRD(6); SBAR(); GAPA(C1=__builtin_amdgcn_mfma_f32_32x32x16_bf16(kf[5],qr[2],C1,0,0,0),   P1[6],P1[7],P1[8],P1[9],     pw2[2]=PKW(P1,4), pw2[3]=PKW(P1,6), pw2); \
    VRD(3); SBAR(); GAPA(C0=__builtin_amdgcn_mfma_f32_32x32x16_bf16(kf[6],qr[3],C0,0,0,0),   P1[10],P1[11],P1[12],P1[13], pw3[0]=PKW(P1,8), pw3[1]=PKW(P1,10), pw3); \
    VRD(7); SBAR(); GAPA(C1=__builtin_amdgcn_mfma_f32_32x32x16_bf16(kf[7],qr[3],C1,0,0,0),   P1[14],P1[15],0.f,0.f,       pw3[2]=PKW(P1,12),pw3[3]=PKW(P1,14), pw3); \
    l_reg+=sacc; \
    if(GK){DMA_K((t)+3,sl_cur);} if(GV){DMA_V((t)+1,sl_next);} \
    CMASK(C0,C1,t); \
    { float a=MX3(C0[0],C0[1],C1[0]),b=MX3(C0[2],C0[3],C1[1]); a=MX3(a,C1[2],C1[3]); \
      _Pragma("unroll") for(int r=4;r<16;r+=4){a=MX3(a,C0[r],C0[r+1]);b=MX3(b,C0[r+2],C0[r+3]);a=MX3(a,C1[r],C1[r+1]);b=MX3(b,C1[r+2],C1[r+3]);} \
      float rm=__builtin_fmaxf(a,b); { auto rr=__builtin_amdgcn_permlane32_swap(__float_as_uint(rm),__float_as_uint(rm),false,false); rm=__builtin_fmaxf(__uint_as_float(rr[0]),__uint_as_float(rr[1])); } \
      resc=false; \
      if(__builtin_expect(__any(rm>(float)THRL),0)){ const float dl=__builtin_fmaxf(rm,0.f); mhat+=dl; \
        _Pragma("unroll") for(int r=0;r<16;++r){C0[r]-=dl;C1[r]-=dl;} \
        SETQA(); \
        const float f=__builtin_amdgcn_exp2f(-dl); l_reg*=f; if(hi==0)wsf[r32]=f; resc=true; } } \
    SBAR(); \
    GAPB(o[0]=__builtin_amdgcn_mfma_f32_32x32x16_bf16(PAF(0),VFR(0),o[0],0,0,0), C0,0); \
    GAPB(o[1]=__builtin_amdgcn_mfma_f32_32x32x16_bf16(PAF(0),VFR(4),o[1],0,0,0), C0,4); \
    KRD(GL,0); GAPB(o[0]=__builtin_amdgcn_mfma_f32_32x32x16_bf16(PAF(1),VFR(1),o[0],0,0,0), C0,8); \
    KRD(GL,1); GAPB(o[1]=__builtin_amdgcn_mfma_f32_32x32x16_bf16(PAF(1),VFR(5),o[1],0,0,0), C0,12); \
    KRD(GL,2); GAPB(o[0]=__builtin_amdgcn_mfma_f32_32x32x16_bf16(PAF(2),VFR(2),o[0],0,0,0), C1,0); \
    KRD(GL,3); GAPB(o[1]=__builtin_amdgcn_mfma_f32_32x32x16_bf16(PAF(2),VFR(6),o[1],0,0,0), C1,4); \
    GAPB(o[0]=__builtin_amdgcn_mfma_f32_32x32x16_bf16(PAF(3),VFR(3),o[0],0,0,0), C1,8); \
    GAPB(o[1]=__builtin_amdgcn_mfma_f32_32x32x16_bf16(PAF(3),VFR(7),o[1],0,0,0), C1,12); \
    }while(0)
  int t=1;
  #undef CMASK
  #define CMASK(P0,P1,t) do{}while(0)
  for(;t+5<NT;t+=2){
    STEP(pB0,pB1,pA0,pA1,t,true,true,true);     WAIT_BAR(2); RESC(); ROT();
    STEP(pA0,pA1,pB0,pB1,t+1,true,true,true);   WAIT_BAR(2); RESC(); ROT();
  }
  #undef CMASK
  #define CMASK(P0,P1,t) do{int jb_=(t)-(NT-4); if(jb_>=0)cmask(P0,P1,jb_,qrel,hi);}while(0)
  #define ENDW(tt) do{ if((tt)+3<NT){WAIT_BAR(2);} else if((tt)+2<NT){WAIT_BAR(1);} else {WAIT_BAR(0);} }while(0)
  for(;t+1<NT;t+=2){
    STEP(pB0,pB1,pA0,pA1,t,(t+3<NT),(t+1<NT),(t+1<NT));       ENDW(t);   RESC(); ROT();
    STEP(pA0,pA1,pB0,pB1,t+1,(t+4<NT),(t+2<NT),(t+2<NT));     ENDW(t+1); RESC(); ROT();
  }
  STEP(pB0,pB1,pA0,pA1,NT-1,false,false,false); RESC();
  { float sacc=pB0[0]+pB0[1]; _Pragma("unroll") for(int r=2;r<16;++r)sacc+=pB0[r]; _Pragma("unroll") for(int r=0;r<16;++r)sacc+=pB1[r]; l_reg+=sacc;
    pw0=(u32x4){PKW(pB0,0),PKW(pB0,2),PKW(pB0,4),PKW(pB0,6)};pw1=(u32x4){PKW(pB0,8),PKW(pB0,10),PKW(pB0,12),PKW(pB0,14)};pw2=(u32x4){PKW(pB1,0),PKW(pB1,2),PKW(pB1,4),PKW(pB1,6)};pw3=(u32x4){PKW(pB1,8),PKW(pB1,10),PKW(pB1,12),PKW(pB1,14)};
    SBAR(); pv(o,vb0+sl_cur,PAF(0),PAF(1),PAF(2),PAF(3)); }
  #undef PKW
  #undef PAF
  #undef VFR
  #undef PIN
  #undef MX3
  #undef GAPA
  #undef GAPB
  #undef EX
  #undef VRD
  #undef KRD
  #undef STEP
  #undef ENDW
  {auto rr=__builtin_amdgcn_permlane32_swap(__float_as_uint(l_reg),__float_as_uint(l_reg),false,false);l_reg=__uint_as_float(rr[0])+__uint_as_float(rr[1]);}
  if(hi==0)wsf[32+r32]=l_reg;asm volatile("s_waitcnt lgkmcnt(0)":::"memory");
  float rli[16];
  #pragma unroll
  for(int r=0;r<16;++r)rli[r]=__builtin_amdgcn_rcpf(wsf[32+crow(r,hi)]);
  bf16*Ow=O+(rowbase+q0+wid*QBLK)*DMO+h*D;
  { bf16*stg=(bf16*)(shm+LDS_OST)+wid*2048;
    #pragma unroll
    for(int r=0;r<16;++r){const int orow=crow(r,hi);
      #pragma unroll
      for(int d0=0;d0<2;++d0)stg[orow*64+d0*32+r32]=__float2bfloat16(o[d0][r]*rli[r]);}
    asm volatile("s_waitcnt lgkmcnt(0)":::"memory");
    #pragma unroll
    for(int i=0;i<4;++i){const int row=i*8+(lane>>3),ch=lane&7; const u32x4 v=*(const u32x4*)(stg+row*64+ch*8); ATTN_STORE16(Ow+(long)row*DMO+ch*8,v);} }
  asm volatile("s_waitcnt lgkmcnt(0)\n\ts_barrier":::"memory");
  #undef KAUG
  #undef SETQA
  #undef DMA_K
  #undef DMA_V
  #undef CMASK
  #undef START
  #undef RESC
  #undef ROT
}
constexpr int ATTN_LDS_BYTES=LDS_BYTES;
struct AttnTensors { const bf16* Q; const bf16* K; const bf16* V; bf16* O; const unsigned long long* AUG; };
struct AttnUnit { int bh; int qb; };
struct StaticOrder {
  int fb, nb;
  __device__ __forceinline__ explicit StaticOrder(int nblk,int idx):fb(idx),nb(nblk){}
  __device__ __forceinline__ bool next(int i,AttnUnit&u)const{
    if(nb==256){ if(i>=2)return false; const int s=fb&3; u.bh=fb>>2; u.qb=(i==0)?7-s:s; return true; }
    if(i>=4)return false; const int s=(fb&1)*2+(i>>1); u.bh=fb>>1; u.qb=(i&1)?s:7-s; return true; }
  __device__ __forceinline__ void a_ready(const AttnUnit&)const{}
  __device__ __forceinline__ void done(const AttnUnit&)const{}
};
template<class Sched,int THRL=8> __device__ __forceinline__ void attn_phase(char*lds,const AttnTensors&T,const Sched&S){
  AttnUnit u;
  for(int i=0;S.next(i,u);++i){ S.a_ready(u); attn_unit<THRL>(u.bh/NHEAD,u.bh%NHEAD,u.qb,T.Q,T.K,T.V,T.O,T.AUG,lds); S.done(u); }
}
#undef SBAR
#undef WAIT_BAR
}
struct Frame {
    LAS unsigned char* lds;
    unsigned* ctl;
    unsigned char* ws;
    int tid, lane, wave, vcu, G;
};
struct Args { const float* in[34]; float* out; unsigned char* ws; int ph_lo, ph_hi; };

__device__ __forceinline__ void tr_item(const float* W, int K, int N, int NP, bf16_t* WT, int ldk, int kcol_off, int mode, int row_off, const float* gk, LAS float* scr, int item, int lane) {
    const int nblk = NP / 32, kb = item / nblk, nb = item % nblk, k0 = 64 * kb, n0 = 32 * nb;
    (void)K;
    { const int n4 = (lane & 7) * 4, kr = lane >> 3; f32x4 v[8];
#pragma unroll
      for (int i = 0; i < 8; ++i) { const int kk = 8 * i + kr; v[i] = (n0 + n4 < N) ? *(const f32x4*)(W + (size_t)(k0 + kk) * N + n0 + n4) : (f32x4){0.f, 0.f, 0.f, 0.f}; }
#pragma unroll
      for (int i = 0; i < 8; ++i) { const int kk = 8 * i + kr; const float g = gk ? gk[k0 + kk] : 1.0f; LAS float* d = scr + kk * 33 + n4; d[0] = v[i].x * g; d[1] = v[i].y * g; d[2] = v[i].z * g; d[3] = v[i].w * g; } }
    LDS_WAIT(); asm volatile("" ::: "memory");
    const int c = lane & 7;
#pragma unroll
    for (int j = 0; j < 4; ++j) { const int n = (lane >> 3) + 8 * j; const LAS float* s = scr + (8 * c) * 33 + n; const int ng = n0 + n;
        const int drow = row_off + (mode ? ((ng >> 7) * 256 + (ng & 127)) : ng);
        u32x4 o; o.x = pk2(s[0 * 33], s[1 * 33]); o.y = pk2(s[2 * 33], s[3 * 33]); o.z = pk2(s[4 * 33], s[5 * 33]); o.w = pk2(s[6 * 33], s[7 * 33]);
        *(u32x4*)(WT + (size_t)drow * ldk + kcol_off + k0 + 8 * c) = o; }
    LDS_WAIT(); asm volatile("" ::: "memory");
}
__device__ __forceinline__ void tr_item8(const float* W, int N, unsigned char* WT, int ldk, int mode, int row_off, const float* gk, float scale, LAS float* scr, int item, int lane) {
    const int nblk = N / 32, kb = item / nblk, nb = item % nblk, k0 = 64 * kb, n0 = 32 * nb;
    { const int n4 = (lane & 7) * 4, kr = lane >> 3; f32x4 v[8];
#pragma unroll
      for (int i = 0; i < 8; ++i) { const int kk = 8 * i + kr; v[i] = *(const f32x4*)(W + (size_t)(k0 + kk) * N + n0 + n4); }
#pragma unroll
      for (int i = 0; i < 8; ++i) { const int kk = 8 * i + kr; const float g = (gk ? gk[k0 + kk] : 1.0f) * scale; LAS float* d = scr + kk * 33 + n4; d[0] = v[i].x * g; d[1] = v[i].y * g; d[2] = v[i].z * g; d[3] = v[i].w * g; } }
    LDS_WAIT(); asm volatile("" ::: "memory");
    const int c = lane & 3;
#pragma unroll
    for (int j = 0; j < 2; ++j) { const int n = (lane >> 2) + 16 * j; const LAS float* s = scr + (16 * c) * 33 + n; const int ng = n0 + n;
        const int drow = row_off + (mode ? ((ng >> 7) * 256 + (ng & 127)) : ng);
        u32x4 o; o.x = pk_fp8x4(s[0 * 33], s[1 * 33], s[2 * 33], s[3 * 33]); o.y = pk_fp8x4(s[4 * 33], s[5 * 33], s[6 * 33], s[7 * 33]);
        o.z = pk_fp8x4(s[8 * 33], s[9 * 33], s[10 * 33], s[11 * 33]); o.w = pk_fp8x4(s[12 * 33], s[13 * 33], s[14 * 33], s[15 * 33]);
        *(u32x4*)(WT + (size_t)drow * ldk + k0 + 16 * c) = o; }
    LDS_WAIT(); asm volatile("" ::: "memory");
}
__device__ __forceinline__ void p0_prologue(Frame& F, const Args& A) {
    F.tid = fresh_tid(); F.lane = F.tid & 63;
    LAS float* scr = (LAS float*)(F.lds + F.wave * 16384);
    const int gw = F.vcu * NWAVES + F.wave, NGW = F.G * NWAVES, lane = F.lane;
    unsigned char* ws = F.ws;
    const float* g_mix = A.in[1]; const float* g_ffn = A.in[2];
    constexpr int I_IN0 = 16 * (N0P / 32), I_SQ = 16 * 32, I_F13 = 16 * (FF / 32), I_F2 = (FF / 64) * 32, I_IN1 = 16 * (N1P / 32);
    constexpr int I_L1 = 1 * 16, I_L2 = 1 * 16, I_L3 = 2 * 16;
    constexpr int NITEMS = I_IN0 + I_SQ + 2 * I_F13 + I_F2 + I_IN1 + I_SQ + I_L1 + I_L2 + I_L3;
    for (int it = gw; it < NITEMS; it += NGW) {
        int r = it;
        if (r < I_IN0) { tr_item(A.in[3], D, N0, N0P, (bf16_t*)(ws + WS_W0T), D, 0, 0, 0, g_mix, scr, r, lane); continue; } r -= I_IN0;
        if (r < I_SQ) { tr_item(A.in[11], D, D, D, (bf16_t*)(ws + WS_WO0T), D, 0, 0, 0, nullptr, scr, r, lane); continue; } r -= I_SQ;
        if (r < I_F13) { tr_item(A.in[12], D, FF, FF, (bf16_t*)(ws + WS_W13T), D, 0, 1, 0, g_ffn, scr, r, lane); continue; } r -= I_F13;
        if (r < I_F13) { tr_item(A.in[13], D, FF, FF, (bf16_t*)(ws + WS_W13T), D, 0, 1, 128, g_ffn, scr, r, lane); continue; } r -= I_F13;
        if (r < I_F2) { tr_item(A.in[14], FF, D, D, (bf16_t*)(ws + WS_W2T), FF, 0, 0, 0, nullptr, scr, r, lane); continue; } r -= I_F2;
        if (r < I_IN1) { tr_item(A.in[15], D, N1, N1P, (bf16_t*)(ws + WS_W1IN), D, 0, 0, 0, g_mix + D, scr, r, lane); continue; } r -= I_IN1;
        if (r < I_SQ) { tr_item(A.in[28], D, D, D, (bf16_t*)(ws + WS_WO1T), D, 0, 0, 0, nullptr, scr, r, lane); continue; } r -= I_SQ;
        if (r < I_L1) { tr_item(A.in[17], 64, 512, 512, (bf16_t*)(ws + WS_LORA), 256, 0, 0, 0, nullptr, scr, r, lane); continue; } r -= I_L1;
        if (r < I_L2) { tr_item(A.in[19], 64, 512, 512, (bf16_t*)(ws + WS_LORA), 256, 64, 0, 512, nullptr, scr, r, lane); continue; } r -= I_L2;
        tr_item(A.in[21], 128, 512, 512, (bf16_t*)(ws + WS_LORA), 256, 128, 0, 1024, nullptr, scr, r, lane);
    }
    { bf16_t* L = (bf16_t*)(ws + WS_LORA);
      for (int i = (F.vcu * NTHR + F.tid); i < 1536 * 256 / 8; i += F.G * NTHR) { const int row = i >> 5, c8 = (i & 31) * 8; const int type = row >> 9;
          const bool diag = (type == 0) ? (c8 < 64) : (type == 1) ? (c8 >= 64 && c8 < 128) : (c8 >= 128);
          if (!diag) *(u32x4*)(L + (size_t)row * 256 + c8) = (u32x4){0u, 0u, 0u, 0u}; } }
    { const float* x = A.in[0]; bf16_t* xb = (bf16_t*)(ws + WS_XB); pg8::u64* ssq0 = (pg8::u64*)(F.ctl + CW_SSQ0);
      for (int m = gw; m < M; m += NGW) { const f32x4* xr = (const f32x4*)(x + (size_t)m * D) + lane; f32x4 v[4]; float s = 0.f;
#pragma unroll
          for (int j = 0; j < 4; ++j) { v[j] = xr[64 * j]; s += (v[j].x * v[j].x + v[j].y * v[j].y) + (v[j].z * v[j].z + v[j].w * v[j].w); }
          s = wave_sum(s); if (lane == 0) ssq0[m] = (pg8::u64)(s * pg8::SSQ_SCALE + 0.5f);
          u32x2* o8 = (u32x2*)(xb + (size_t)m * D) + lane;
#pragma unroll
          for (int j = 0; j < 4; ++j) { u32x2 w; w.x = cvt_pk_bf16(v[j].x, v[j].y); w.y = cvt_pk_bf16(v[j].z, v[j].w); o8[64 * j] = w; } } }
}
__device__ __forceinline__ void moe_convert(Frame& F, const Args& A, int wi, int nw, int lo = 0, int hi = 0x7fffffff) {
    F.tid = fresh_tid(); F.lane = F.tid & 63;
    LAS float* scr = (LAS float*)(F.lds + F.wave * 16384); unsigned char* ws = F.ws; const float* g_ffn = A.in[2]; const int lane = F.lane;
    constexpr int I_E13 = 16 * (FE / 32), I_E2 = (FE / 64) * 32, NITEMS = NE * (2 * I_E13 + I_E2);
    for (int it = lo + wi; it < (hi < NITEMS ? hi : NITEMS); it += nw) {
        int r = it;
        if (r < NE * I_E13) { const int e = r / I_E13; tr_item8(A.in[30] + (size_t)e * D * FE, FE, ws + WS_WE13T + (size_t)e * 2 * FE * D, D, 1, 0, g_ffn + D, pg8::Q8_W, scr, r % I_E13, lane); continue; } r -= NE * I_E13;
        if (r < NE * I_E13) { const int e = r / I_E13; tr_item8(A.in[31] + (size_t)e * D * FE, FE, ws + WS_WE13T + (size_t)e * 2 * FE * D, D, 1, 128, g_ffn + D, pg8::Q8_W, scr, r % I_E13, lane); continue; } r -= NE * I_E13;
        const int e = r / I_E2; tr_item8(A.in[32] + (size_t)e * FE * D, D, ws + WS_WE2T + (size_t)e * D * FE, FE, 0, 0, nullptr, pg8::Q8_W, scr, r % I_E2, lane);
    }
}

__device__ __forceinline__ void conv_phase(Frame& F, const Args& A) {
    F.tid = fresh_tid(); F.lane = F.tid & 63;
    const bf16_t* P0 = (const bf16_t*)(F.ws + WS_P0); bf16_t* YC = (bf16_t*)(F.ws + WS_YC0);
    const float* cw = A.in[4]; const float* cb = A.in[5]; const float* lg = A.in[6]; const float* lb = A.in[7];
    LAS bf16_t* U = (LAS bf16_t*)F.lds; LAS float* Y = (LAS float*)(F.lds + 65536);
    const int c = F.tid;
    float w[31];
#pragma unroll
    for (int j = 0; j < 31; ++j) w[j] = cw[j * 512 + c];
    const float bias = cb[c];
    for (int unit = blockIdx.x; unit < M / 32; unit += F.G) {
        const int m0 = unit * 32, t0 = m0 % T;
        { u32x4 va[8], ga[8];
#pragma unroll
          for (int j = 0; j < 8; ++j) { const int it = F.tid + NTHR * j, i = it >> 6, c8 = (it & 63) * 8; const bool ok = (it < 62 * 64) && (t0 - 30 + i >= 0);
              const bf16_t* rp = P0 + (size_t)(ok ? (m0 - 30 + i) : m0) * N0P; va[j] = *(const u32x4*)(rp + C_VAL + c8); ga[j] = *(const u32x4*)(rp + C_GATE + c8); }
#pragma unroll
          for (int j = 0; j < 8; ++j) { const int it = F.tid + NTHR * j, i = it >> 6, c8 = (it & 63) * 8; const bool ok = (t0 - 30 + i >= 0);
              if (it < 62 * 64) { u32x4 o = (u32x4){0u, 0u, 0u, 0u};
                  if (ok) { float r[8];
#pragma unroll
                      for (int q = 0; q < 4; ++q) { r[2 * q] = bflo(va[j][q]) * sigmoidf_(bflo(ga[j][q])); r[2 * q + 1] = bfhi(va[j][q]) * sigmoidf_(bfhi(ga[j][q])); }
                      o.x = cvt_pk_bf16(r[0], r[1]); o.y = cvt_pk_bf16(r[2], r[3]); o.z = cvt_pk_bf16(r[4], r[5]); o.w = cvt_pk_bf16(r[6], r[7]); }
                  *(LAS u32x4*)(U + i * 512 + c8) = o; } } }
        __syncthreads();
        { float y[32];
#pragma unroll
          for (int t = 0; t < 32; ++t) y[t] = bias;
#pragma unroll
          for (int i = 0; i < 62; ++i) { const float uv = bf2f(U[i * 512 + c]);
#pragma unroll
              for (int t = 0; t < 32; ++t) { if (i - t >= 0 && i - t <= 30) y[t] += uv * w[i - t]; } }
#pragma unroll
          for (int t = 0; t < 32; ++t) Y[t * 512 + c] = y[t]; }
        __syncthreads();
        for (int t = F.wave; t < 32; t += NWAVES) { const LAS f32x4* yr = (const LAS f32x4*)(Y + t * 512 + F.lane * 8); const f32x4 a = yr[0], b = yr[1];
            float s = (a.x + a.y) + (a.z + a.w) + (b.x + b.y) + (b.z + b.w); const float mean = wave_sum(s) * (1.0f / 512.0f);
            const f32x4 da = a - mean, db = b - mean; float q = (da.x * da.x + da.y * da.y) + (da.z * da.z + da.w * da.w) + (db.x * db.x + db.y * db.y) + (db.z * db.z + db.w * db.w);
            const float rstd = rsqrtf(wave_sum(q) * (1.0f / 512.0f) + 1e-5f);
            const f32x4 g0 = *(const f32x4*)(lg + F.lane * 8), g1 = *(const f32x4*)(lg + F.lane * 8 + 4), b0 = *(const f32x4*)(lb + F.lane * 8), b1 = *(const f32x4*)(lb + F.lane * 8 + 4);
            float o[8];
#pragma unroll
            for (int i = 0; i < 4; ++i) { o[i] = siluf_(da[i] * rstd * g0[i] + b0[i]); o[4 + i] = siluf_(db[i] * rstd * g1[i] + b1[i]); }
            u32x4 wv; wv.x = cvt_pk_bf16(o[0], o[1]); wv.y = cvt_pk_bf16(o[2], o[3]); wv.z = cvt_pk_bf16(o[4], o[5]); wv.w = cvt_pk_bf16(o[6], o[7]);
            *(u32x4*)(YC + (size_t)(m0 + t) * D + F.lane * 8) = wv; }
        __syncthreads();
    }
}

__device__ __forceinline__ float rdl(float x, int l) { return __int_as_float(__builtin_amdgcn_readlane(__float_as_int(x), l)); }

constexpr int GL_LD = 72;
constexpr int GL_QD = 0, GL_KD = 9216, GL_VT = 18432, GL_ST = 36864, GL_AT = 55296, GL_O = 64512, GL_OLD = 132;
__device__ __forceinline__ int crow32(int r, int hi) { return (r & 3) + 8 * (r >> 2) + 4 * hi; }
constexpr int GL_LA = 98304;
constexpr int GL_WA = GL_LA + 16384, GL_BA = GL_WA + 4096;
__device__ __forceinline__ void gla_bcum(const u32x4 a0, const u32x4 a1, const LAS float* WAl, const LAS float* BAl, int lane, LAS float* LA, int kw, float (&bc)[8], float (&bl)[8]) {
    float al[16];
#pragma unroll
    for (int q = 0; q < 4; ++q) { al[2 * q] = bflo(a0[q]); al[2 * q + 1] = bfhi(a0[q]); al[8 + 2 * q] = bflo(a1[q]); al[8 + 2 * q + 1] = bfhi(a1[q]); }
    float la[8];
    { const f32x4 b0 = *(const LAS f32x4*)(BAl + kw), b1 = *(const LAS f32x4*)(BAl + kw + 4);
#pragma unroll
      for (int j = 0; j < 4; ++j) { la[j] = b0[j]; la[4 + j] = b1[j]; }
#pragma unroll
      for (int r = 0; r < 16; ++r) { const f32x4 w0 = *(const LAS f32x4*)(WAl + r * 64 + kw), w1 = *(const LAS f32x4*)(WAl + r * 64 + kw + 4);
#pragma unroll
          for (int j = 0; j < 4; ++j) { la[j] += al[r] * w0[j]; la[4 + j] += al[r] * w1[j]; } }
#pragma unroll
      for (int j = 0; j < 8; ++j) { const float lg = la[j]; la[j] = (fminf(lg, 0.f) - __logf(1.0f + __expf(-fabsf(lg)))) * (1.0f / 16.0f); } }
    *(LAS f32x4*)(LA + lane * 64 + kw) = (f32x4){la[0], la[1], la[2], la[3]}; *(LAS f32x4*)(LA + lane * 64 + kw + 4) = (f32x4){la[4], la[5], la[6], la[7]};
    asm volatile("s_waitcnt lgkmcnt(0)" ::: "memory");
    if (lane < 8) { float xs[64];
#pragma unroll
        for (int t = 0; t < 64; ++t) xs[t] = LA[t * 64 + kw + lane];
#pragma unroll
        for (int t = 1; t < 64; ++t) xs[t] += xs[t - 1];
#pragma unroll
        for (int t = 0; t < 64; ++t) LA[t * 64 + kw + lane] = xs[t]; }
    asm volatile("s_waitcnt lgkmcnt(0)" ::: "memory");
    const f32x4 b0 = *(const LAS f32x4*)(LA + lane * 64 + kw), b1 = *(const LAS f32x4*)(LA + lane * 64 + kw + 4), e0 = *(const LAS f32x4*)(LA + 63 * 64 + kw), e1 = *(const LAS f32x4*)(LA + 63 * 64 + kw + 4);
#pragma unroll
    for (int j = 0; j < 4; ++j) { bc[j] = b0[j]; bc[4 + j] = b1[j]; bl[j] = e0[j]; bl[4 + j] = e1[j]; }
}
__device__ __forceinline__ void gla_load_v(u32x4 (&vr)[2], const bf16_t* P0, size_t m0, int h, int tid) {
#pragma unroll
    for (int i = 0; i < 2; ++i) { const int it = tid + 512 * i, t = it & 63, d8 = (it >> 6) * 8; vr[i] = *(const u32x4*)(P0 + (m0 + t) * N0P + C_GV + h * 128 + d8); }
}
__device__ __forceinline__ void gla_stage_vt(LAS bf16_t* VT, const u32x4 (&vr)[2], int tid) {
#pragma unroll
    for (int i = 0; i < 2; ++i) { const int it = tid + 512 * i, t = it & 63, d8 = (it >> 6) * 8; const u32x4 v = vr[i];
#pragma unroll
        for (int q = 0; q < 4; ++q) { VT[(d8 + 2 * q) * GL_LD + t] = (bf16_t)(v[q] & 0xffffu); VT[(d8 + 2 * q + 1) * GL_LD + t] = (bf16_t)(v[q] >> 16); } }
}
__device__ __forceinline__ f32x16 gla_mma64(f32x16 acc, const LAS bf16_t* A, const LAS bf16_t* Bt, int r32, int hi) {
#pragma unroll
    for (int s = 0; s < 4; ++s) { const bf16x8 a = *(const LAS bf16x8*)(A + r32 * GL_LD + 16 * s + 8 * hi), b = *(const LAS bf16x8*)(Bt + r32 * GL_LD + 16 * s + 8 * hi);
        acc = __builtin_amdgcn_mfma_f32_32x32x16_bf16(a, b, acc, 0, 0, 0); }
    return acc;
}
__device__ __forceinline__ void gla_x_phase(Frame& F, const Args& A) {
    F.tid = fresh_tid(); F.lane = F.tid & 63;
    const int tid = F.tid, lane = F.lane, wave = F.wave, r32 = lane & 31, hi = lane >> 5;
    const bf16_t* P0 = (const bf16_t*)(F.ws + WS_P0); float* LT = (float*)(F.ws + WS_GLT); float* DEC = (float*)(F.ws + WS_GDEC);
    LAS bf16_t* KET = (LAS bf16_t*)(F.lds + GL_QD); LAS bf16_t* VT = (LAS bf16_t*)(F.lds + GL_VT);
    { const int hh = ((int)blockIdx.x >> 5) & 3; LAS float* WAl = (LAS float*)(F.lds + GL_WA); LAS float* BAl = (LAS float*)(F.lds + GL_BA);
      for (int i = tid; i < 1024; i += NTHR) WAl[i] = A.in[8][(i >> 6) * 256 + hh * 64 + (i & 63)];
      if (tid < 64) BAl[tid] = A.in[9][hh * 64 + tid];
      __syncthreads(); }
    u32x4 n_a0, n_a1, n_kv, n_vr[2];
#define GX_LOAD(c_) do { const int bh_ = (c_) >> 5, n_ = (c_) & 31, b_ = bh_ >> 2, h_ = bh_ & 3; const size_t m0_ = (size_t)b_ * T + n_ * 64; const bf16_t* rp_ = P0 + (m0_ + lane) * N0P; \
        n_a0 = *(const u32x4*)(rp_ + C_ALR); n_a1 = *(const u32x4*)(rp_ + C_ALR + 8); n_kv = *(const u32x4*)(rp_ + C_GK + h_ * 64 + wave * 8); gla_load_v(n_vr, P0, m0_, h_, tid); } while (0)
    GX_LOAD((int)blockIdx.x);
    for (int c = blockIdx.x; c < 1024; c += F.G) { const int bh = c >> 5, n = c & 31, b = bh >> 2, h = bh & 3; const size_t m0 = (size_t)b * T + n * 64;
        float bc[8], bl[8];
        const u32x4 a0 = n_a0, a1 = n_a1, kv = n_kv; u32x4 vr[2] = {n_vr[0], n_vr[1]};
        if (c + F.G < 1024) GX_LOAD(c + F.G);
        gla_bcum(a0, a1, (const LAS float*)(F.lds + GL_WA), (const LAS float*)(F.lds + GL_BA), lane, (LAS float*)(F.lds + GL_LA), wave * 8, bc, bl);
        {
#pragma unroll
          for (int q = 0; q < 4; ++q) { KET[(wave * 8 + 2 * q) * GL_LD + lane] = (bf16_t)f2bf(bflo(kv[q]) * __expf(bl[2 * q] - bc[2 * q])); KET[(wave * 8 + 2 * q + 1) * GL_LD + lane] = (bf16_t)f2bf(bfhi(kv[q]) * __expf(bl[2 * q + 1] - bc[2 * q + 1])); }
          if (lane < 8) { float d = bl[0];
#pragma unroll
              for (int j = 1; j < 8; ++j) d = (lane == j) ? bl[j] : d;
              DEC[(size_t)c * 64 + wave * 8 + lane] = __expf(d); } }
        gla_stage_vt(VT, vr, tid);
        __syncthreads();
        { const int tv = wave >> 1, tk = wave & 1; f32x16 acc = {}; acc = gla_mma64(acc, VT + 32 * tv * GL_LD, KET + 32 * tk * GL_LD, r32, hi);
          float* lp = LT + (size_t)c * 8192 + 32 * tk + r32;
#pragma unroll
          for (int r = 0; r < 16; ++r) lp[(32 * tv + crow32(r, hi)) * 64] = acc[r]; }
        __syncthreads();
    }
#undef GX_LOAD
}
__device__ __forceinline__ void gla_carry_phase(Frame& F, const Args& A) {
    F.tid = fresh_tid(); (void)A;
    const float* LT = (const float*)(F.ws + WS_GLT); const float* DEC = (const float*)(F.ws + WS_GDEC); bf16_t* ST = (bf16_t*)(F.ws + WS_GST);
    const int gid = F.vcu * NTHR + F.tid; if (gid >= 32 * 8192 / 2) return;
    const int e = gid * 2, bh = e >> 13, rem = e & 8191, dk = rem & 63; float S0 = 0.f, S1 = 0.f;
#pragma unroll 8
    for (int n = 0; n < 32; ++n) { const size_t c = (size_t)bh * 32 + n; *(unsigned*)(ST + c * 8192 + rem) = cvt_pk_bf16(S0, S1);
        const f32x2 l = *(const f32x2*)(LT + c * 8192 + rem), d = *(const f32x2*)(DEC + c * 64 + dk); S0 = S0 * d.x + l.x; S1 = S1 * d.y + l.y; }
}
__device__ __forceinline__ void gla_z_phase(Frame& F, const Args& A) {
    F.tid = fresh_tid(); F.lane = F.tid & 63;
    const int tid = F.tid, lane = F.lane, wave = F.wave, r32 = lane & 31, hi = lane >> 5;
    const bf16_t* P0 = (const bf16_t*)(F.ws + WS_P0); const bf16_t* STg = (const bf16_t*)(F.ws + WS_GST); bf16_t* YC = (bf16_t*)(F.ws + WS_YC0); const float* ng = A.in[10];
    LAS bf16_t* QD = (LAS bf16_t*)(F.lds + GL_QD); LAS bf16_t* KD = (LAS bf16_t*)(F.lds + GL_KD); LAS bf16_t* VT = (LAS bf16_t*)(F.lds + GL_VT); LAS bf16_t* STl = (LAS bf16_t*)(F.lds + GL_ST);
    LAS bf16_t* AT = (LAS bf16_t*)(F.lds + GL_AT); LAS float* OL = (LAS float*)(F.lds + GL_O);
    { const int hh = ((int)blockIdx.x >> 5) & 3; LAS float* WAl = (LAS float*)(F.lds + GL_WA); LAS float* BAl = (LAS float*)(F.lds + GL_BA);
      for (int i = tid; i < 1024; i += NTHR) WAl[i] = A.in[8][(i >> 6) * 256 + hh * 64 + (i & 63)];
      if (tid < 64) BAl[tid] = A.in[9][hh * 64 + tid];
      __syncthreads(); }
    u32x4 n_a0, n_a1, n_qv, n_kv, n_vr[2], n_sr[2], n_g0, n_g1;
#define GZ_LOAD(c_) do { const int bh_ = (c_) >> 5, n_ = (c_) & 31, b_ = bh_ >> 2, h_ = bh_ & 3; const size_t m0_ = (size_t)b_ * T + n_ * 64; const bf16_t* rp_ = P0 + (m0_ + lane) * N0P; \
        n_a0 = *(const u32x4*)(rp_ + C_ALR); n_a1 = *(const u32x4*)(rp_ + C_ALR + 8); n_qv = *(const u32x4*)(rp_ + C_GQ + h_ * 64 + wave * 8); n_kv = *(const u32x4*)(rp_ + C_GK + h_ * 64 + wave * 8); \
        gla_load_v(n_vr, P0, m0_, h_, tid); \
        _Pragma("unroll") for (int i_ = 0; i_ < 2; ++i_) { const int it_ = tid + 512 * i_, dv_ = it_ >> 3, c8_ = (it_ & 7) * 8; n_sr[i_] = *(const u32x4*)(STg + (size_t)(c_) * 8192 + dv_ * 64 + c8_); } \
        const bf16_t* gp_ = P0 + (m0_ + (tid >> 3)) * N0P + C_GG + h_ * 128 + (tid & 7) * 16; n_g0 = *(const u32x4*)gp_; n_g1 = *(const u32x4*)(gp_ + 8); } while (0)
    GZ_LOAD((int)blockIdx.x);
    for (int c = blockIdx.x; c < 1024; c += F.G) { const int bh = c >> 5, n = c & 31, b = bh >> 2, h = bh & 3; const size_t m0 = (size_t)b * T + n * 64;
        float bc[8], bl[8];
        const u32x4 a0 = n_a0, a1 = n_a1, qv = n_qv, kv = n_kv, g0 = n_g0, g1 = n_g1; u32x4 vr[2] = {n_vr[0], n_vr[1]}, sr[2] = {n_sr[0], n_sr[1]};
        if (c + F.G < 1024) GZ_LOAD(c + F.G);
        gla_bcum(a0, a1, (const LAS float*)(F.lds + GL_WA), (const LAS float*)(F.lds + GL_BA), lane, (LAS float*)(F.lds + GL_LA), wave * 8, bc, bl);
        { u32x4 qo, ko;
#pragma unroll
          for (int q = 0; q < 4; ++q) { const float e0 = __expf(bc[2 * q]), e1 = __expf(bc[2 * q + 1]);
              qo[q] = cvt_pk_bf16(bflo(qv[q]) * 0.125f * e0, bfhi(qv[q]) * 0.125f * e1); ko[q] = cvt_pk_bf16(bflo(kv[q]) * __builtin_amdgcn_rcpf(e0), bfhi(kv[q]) * __builtin_amdgcn_rcpf(e1)); }
          *(LAS u32x4*)(QD + lane * GL_LD + wave * 8) = qo; *(LAS u32x4*)(KD + lane * GL_LD + wave * 8) = ko; }
        gla_stage_vt(VT, vr, tid);
#pragma unroll
        for (int i = 0; i < 2; ++i) { const int it = tid + 512 * i, dv = it >> 3, c8 = (it & 7) * 8; *(LAS u32x4*)(STl + dv * GL_LD + c8) = sr[i]; }
        __syncthreads();
        if (wave < 4) { const int ti = wave >> 1, tj = wave & 1; f32x16 acc = {};
            if (tj <= ti) acc = gla_mma64(acc, QD + 32 * ti * GL_LD, KD + 32 * tj * GL_LD, r32, hi);
#pragma unroll
            for (int r = 0; r < 16; ++r) { const int il = crow32(r, hi); float v = acc[r]; if (ti == tj && r32 > il) v = 0.f; AT[(32 * ti + il) * GL_LD + 32 * tj + r32] = (bf16_t)f2bf(v); } }
        __syncthreads();
        { const int ti = wave >> 2, tn = wave & 3; f32x16 acc = {};
          acc = gla_mma64(acc, AT + 32 * ti * GL_LD, VT + 32 * tn * GL_LD, r32, hi);
          acc = gla_mma64(acc, QD + 32 * ti * GL_LD, STl + 32 * tn * GL_LD, r32, hi);
#pragma unroll
          for (int r = 0; r < 16; ++r) OL[(32 * ti + crow32(r, hi)) * GL_OLD + 32 * tn + r32] = acc[r]; }
        __syncthreads();
        { const int i = tid >> 3, seg = (tid & 7) * 16; const LAS f32x4* op = (const LAS f32x4*)(OL + i * GL_OLD + seg); f32x4 o[4]; float ss = 0.f;
#pragma unroll
          for (int q = 0; q < 4; ++q) { o[q] = op[q]; ss += (o[q].x * o[q].x + o[q].y * o[q].y) + (o[q].z * o[q].z + o[q].w * o[q].w); }
          ss += __int_as_float(__builtin_amdgcn_update_dpp(0, __float_as_int(ss), 0xB1, 0xF, 0xF, false));
          ss += __int_as_float(__builtin_amdgcn_update_dpp(0, __float_as_int(ss), 0x4E, 0xF, 0xF, false));
          ss += __int_as_float(__builtin_amdgcn_update_dpp(0, __float_as_int(ss), 0x141, 0xF, 0xF, false));
          const float rs = rsqrtf(ss * (1.0f / 128.0f) + 1e-6f);
          float res[16];
#pragma unroll
          for (int q = 0; q < 4; ++q) { const f32x4 nv = *(const f32x4*)(ng + h * 128 + seg + 4 * q); const unsigned gw0 = (q < 2) ? g0[2 * q] : g1[2 * q - 4], gw1 = (q < 2) ? g0[2 * q + 1] : g1[2 * q - 3];
              res[4 * q] = o[q].x * rs * nv.x * siluf_(bflo(gw0)); res[4 * q + 1] = o[q].y * rs * nv.y * siluf_(bfhi(gw0)); res[4 * q + 2] = o[q].z * rs * nv.z * siluf_(bflo(gw1)); res[4 * q + 3] = o[q].w * rs * nv.w * siluf_(bfhi(gw1)); }
          u32x4 w0, w1; w0.x = cvt_pk_bf16(res[0], res[1]); w0.y = cvt_pk_bf16(res[2], res[3]); w0.z = cvt_pk_bf16(res[4], res[5]); w0.w = cvt_pk_bf16(res[6], res[7]);
          w1.x = cvt_pk_bf16(res[8], res[9]); w1.y = cvt_pk_bf16(res[10], res[11]); w1.z = cvt_pk_bf16(res[12], res[13]); w1.w = cvt_pk_bf16(res[14], res[15]);
          bf16_t* yp = YC + (m0 + i) * D + 512 + h * 128 + seg; *(u32x4*)yp = w0; *(u32x4*)(yp + 8) = w1; }
        __syncthreads();
    }
#undef GZ_LOAD
}

__device__ __forceinline__ void lora_prep_phase(Frame& F, const Args& A) {
    F.tid = fresh_tid(); F.lane = F.tid & 63;
    const bf16_t* P1 = (const bf16_t*)(F.ws + WS_P1); bf16_t* AL = (bf16_t*)(F.ws + WS_ALORA); const float* mu = A.in[16];
    {
      const int gt = F.vcu * NTHR + F.tid, c8 = (gt & 31) * 8; const f32x4 mu0 = *(const f32x4*)(mu + R_XW + c8), mu1 = *(const f32x4*)(mu + R_XW + c8 + 4);
      u32x4 cur[4], prv[4];
#pragma unroll
      for (int j = 0; j < 4; ++j) { const int m = (gt >> 5) + j * (F.G * NTHR / 32); cur[j] = *(const u32x4*)(P1 + (size_t)m * N1P + R_XW + c8);
          prv[j] = ((m % T) > 0) ? *(const u32x4*)(P1 + (size_t)(m - 1) * N1P + R_XW + c8) : (u32x4){0u, 0u, 0u, 0u}; }
#pragma unroll
      for (int j = 0; j < 4; ++j) { const int m = (gt >> 5) + j * (F.G * NTHR / 32); float r[8];
#pragma unroll
          for (int q = 0; q < 4; ++q) { const float c0 = bflo(cur[j][q]), c1 = bfhi(cur[j][q]), p0 = bflo(prv[j][q]), p1 = bfhi(prv[j][q]); const float m0_ = (q < 2) ? mu0[2 * q] : mu1[2 * q - 4], m1_ = (q < 2) ? mu0[2 * q + 1] : mu1[2 * q - 3];
              r[2 * q] = c0 + (p0 - c0) * m0_; r[2 * q + 1] = c1 + (p1 - c1) * m1_; }
          if (c8 < 64) {
#pragma unroll
              for (int q = 0; q < 8; ++q) r[q] = 1.0f - 2.0f * __builtin_amdgcn_rcpf(1.0f + __expf(2.0f * r[q])); }
          else if (c8 >= 128) {
#pragma unroll
              for (int q = 0; q < 8; ++q) r[q] = sigmoidf_(r[q]); }
          u32x4 o; o.x = cvt_pk_bf16(r[0], r[1]); o.y = cvt_pk_bf16(r[2], r[3]); o.z = cvt_pk_bf16(r[4], r[5]); o.w = cvt_pk_bf16(r[6], r[7]);
          *(u32x4*)(AL + (size_t)m * 256 + c8) = o; } }
    const int gw = F.vcu * NWAVES + F.wave;
    if (gw < 64) { const int b = gw >> 3, h = gw & 7; const float* fl = (const float*)(F.ws + WS_FL32); unsigned long long* ca = (unsigned long long*)(F.ws + WS_CAUG) + (size_t)gw * T; const float bf = A.in[27][h];
        float ls[32];
#pragma unroll
        for (int i = 0; i < 32; ++i) ls[i] = fl[((size_t)b * T + F.lane * 32 + i) * 8 + h];
        float s = 0.f;
#pragma unroll
        for (int i = 0; i < 32; ++i) { const float xg = ls[i] + bf; ls[i] = fminf(xg, 0.f) - __logf(1.0f + __expf(-fabsf(xg))); s += ls[i]; }
        float inc = s;
#pragma unroll
        for (int o = 1; o < 64; o <<= 1) { const float n = __shfl_up(inc, o); if (F.lane >= o) inc += n; }
        float run = inc - s;
#pragma unroll
        for (int i = 0; i < 32; ++i) { run += ls[i];
            const float c2 = run * 1.4426950408889634f; const unsigned p1 = f2bf(c2); const float r1 = c2 - __uint_as_float(p1 << 16); const unsigned p2 = f2bf(r1); const float r2 = r1 - __uint_as_float(p2 << 16); const unsigned p3 = f2bf(r2);
            ca[F.lane * 32 + i] = (unsigned long long)(p1 | (p2 << 16)) | ((unsigned long long)p3 << 32); } }
}


__device__ __forceinline__ float dpp_sum16(float x) {
    x += __int_as_float(__builtin_amdgcn_update_dpp(0, __float_as_int(x), 0xB1, 0xF, 0xF, false));
    x += __int_as_float(__builtin_amdgcn_update_dpp(0, __float_as_int(x), 0x4E, 0xF, 0xF, false));
    x += __int_as_float(__builtin_amdgcn_update_dpp(0, __float_as_int(x), 0x141, 0xF, 0xF, false));
    x += __int_as_float(__builtin_amdgcn_update_dpp(0, __float_as_int(x), 0x140, 0xF, 0xF, false));
    return x;
}
constexpr int RW_TS = 32;
__device__ __forceinline__ void rwkv_scan_phase(Frame& F, const Args& A, int rb) {
    F.tid = fresh_tid(); F.lane = F.tid & 63;
    const int tid = F.tid, lane = F.lane, wave = F.wave;
    const int bh = rb >> 1, half = rb & 1, b = bh >> 3, h = bh & 7;
    const bf16_t* P1 = (const bf16_t*)(F.ws + WS_P1); const float* WAG = (const float*)(F.ws + WS_WAG); bf16_t* YR = (bf16_t*)(F.ws + WS_YRAW);
    const float* mu = A.in[16];
    LAS float* LW = (LAS float*)F.lds; LAS float* LKK = LW + 2048; LAS float* LBB = LKK + 2048; LAS float* LKM = LBB + 2048; LAS float* LRR = LKM + 2048; LAS float* LV = LRR + 2048; LAS float* LY = LV + 1024;
    const int ps = tid >> 4, pq = tid & 15, kc = h * 64 + pq * 4, vc = h * 64 + half * 32 + pq * 2;
    f32x4 mur, muk, kkc, kac; float muv[2];
#pragma unroll
    for (int i = 0; i < 4; ++i) { mur[i] = mu[R_R + kc + i]; muk[i] = mu[R_K + kc + i]; kkc[i] = A.in[22][kc + i]; kac[i] = A.in[23][kc + i]; }
    muv[0] = mu[R_V + vc]; muv[1] = mu[R_V + vc + 1];
    const int sq = lane & 15, vl = wave * 4 + (lane >> 4);
    f32x2 S01 = {0.f, 0.f}, S23 = {0.f, 0.f}; const bool b3 = (sq & 8) != 0, b2 = (sq & 4) != 0, b1 = (sq & 2) != 0, b0 = (sq & 1) != 0;
    u32x2 g_r, g_k, g_pr, g_pk; unsigned g_v, g_pv; f32x4 g_w, g_a;
#define RW_LOAD(t0) do { const size_t m_ = (size_t)b * T + (t0) + ps; const bf16_t* rp_ = P1 + m_ * N1P; const bool hp_ = ((t0) + ps) > 0; \
        g_r = *(const u32x2*)(rp_ + R_R + kc); g_k = *(const u32x2*)(rp_ + R_K + kc); g_v = *(const unsigned*)(rp_ + R_V + vc); \
        g_pr = hp_ ? *(const u32x2*)(rp_ - N1P + R_R + kc) : (u32x2){0u, 0u}; g_pk = hp_ ? *(const u32x2*)(rp_ - N1P + R_K + kc) : (u32x2){0u, 0u}; g_pv = hp_ ? *(const unsigned*)(rp_ - N1P + R_V + vc) : 0u; \
        g_w = *(const f32x4*)(WAG + m_ * 512 + kc); g_a = *(const f32x4*)(WAG + (size_t)M * 512 + m_ * 512 + kc); } while (0)
#define RW_PREP() do { f32x4 r_, k_, pr_, pk_; \
        r_[0] = bflo(g_r.x); r_[1] = bfhi(g_r.x); r_[2] = bflo(g_r.y); r_[3] = bfhi(g_r.y); k_[0] = bflo(g_k.x); k_[1] = bfhi(g_k.x); k_[2] = bflo(g_k.y); k_[3] = bfhi(g_k.y); \
        pr_[0] = bflo(g_pr.x); pr_[1] = bfhi(g_pr.x); pr_[2] = bflo(g_pr.y); pr_[3] = bfhi(g_pr.y); pk_[0] = bflo(g_pk.x); pk_[1] = bfhi(g_pk.x); pk_[2] = bflo(g_pk.y); pk_[3] = bfhi(g_pk.y); \
        r_ = r_ + (pr_ - r_) * mur; k_ = k_ + (pk_ - k_) * muk; \
        f32x4 kk_ = k_ * kkc; const float ss_ = dpp_sum16((kk_[0] * kk_[0] + kk_[1] * kk_[1]) + (kk_[2] * kk_[2] + kk_[3] * kk_[3])); \
        kk_ = kk_ * (1.0f / fmaxf(sqrtf(ss_), 1e-12f)); const f32x4 km_ = k_ * (1.0f + (g_a - 1.0f) * kac), bb_ = kk_ * g_a; \
        *(LAS f32x4*)(LW + ps * 64 + pq * 4) = g_w; *(LAS f32x4*)(LKK + ps * 64 + pq * 4) = kk_; *(LAS f32x4*)(LBB + ps * 64 + pq * 4) = bb_; \
        *(LAS f32x4*)(LKM + ps * 64 + pq * 4) = km_; *(LAS f32x4*)(LRR + ps * 64 + pq * 4) = r_; \
        const float v0_ = bflo(g_v), v1_ = bfhi(g_v), pv0_ = bflo(g_pv), pv1_ = bfhi(g_pv); \
        LV[ps * 32 + pq * 2] = v0_ + (pv0_ - v0_) * muv[0]; LV[ps * 32 + pq * 2 + 1] = v1_ + (pv1_ - v1_) * muv[1]; } while (0)
    RW_LOAD(0); RW_PREP();
    for (int t0 = 0; t0 < T; t0 += RW_TS) {
        __syncthreads();
        if (t0 + RW_TS < T) RW_LOAD(t0 + RW_TS);
        f32x4 wv = *(const LAS f32x4*)(LW + sq * 4), kkv = *(const LAS f32x4*)(LKK + sq * 4), bbv = *(const LAS f32x4*)(LBB + sq * 4), kmv = *(const LAS f32x4*)(LKM + sq * 4), rrv = *(const LAS f32x4*)(LRR + sq * 4); float vv = LV[vl];
        float yp[16];
#pragma unroll
        for (int s = 0; s < RW_TS; ++s) {
            f32x4 wn = wv, kkn = kkv, bbn = bbv, kmn = kmv, rrn = rrv; float vn = vv;
            if (s + 1 < RW_TS) { wn = *(const LAS f32x4*)(LW + (s + 1) * 64 + sq * 4); kkn = *(const LAS f32x4*)(LKK + (s + 1) * 64 + sq * 4); bbn = *(const LAS f32x4*)(LBB + (s + 1) * 64 + sq * 4);
                kmn = *(const LAS f32x4*)(LKM + (s + 1) * 64 + sq * 4); rrn = *(const LAS f32x4*)(LRR + (s + 1) * 64 + sq * 4); vn = LV[(s + 1) * 32 + vl]; }
            const f32x2 d2 = S01 * (f32x2){kkv[0], kkv[1]} + S23 * (f32x2){kkv[2], kkv[3]};
            const float sa = dpp_sum16(d2.x + d2.y);
            const f32x2 sa2 = {sa, sa}, v2 = {vv, vv};
            const f32x2 t01 = v2 * (f32x2){kmv[0], kmv[1]} - sa2 * (f32x2){bbv[0], bbv[1]}, t23 = v2 * (f32x2){kmv[2], kmv[3]} - sa2 * (f32x2){bbv[2], bbv[3]};
            S01 = S01 * (f32x2){wv[0], wv[1]} + t01; S23 = S23 * (f32x2){wv[2], wv[3]} + t23;
            const f32x2 e2 = S01 * (f32x2){rrv[0], rrv[1]} + S23 * (f32x2){rrv[2], rrv[3]};
            yp[s & 15] = e2.x + e2.y;
            if ((s & 15) == 15) {
                float t8[8], u4[4], w2[2];
#pragma unroll
                for (int i = 0; i < 8; ++i) { const float keep = b3 ? yp[i + 8] : yp[i], give = b3 ? yp[i] : yp[i + 8]; t8[i] = keep + __int_as_float(__builtin_amdgcn_update_dpp(0, __float_as_int(give), 0x140, 0xF, 0xF, false)); }
#pragma unroll
                for (int i = 0; i < 4; ++i) { const float keep = b2 ? t8[i + 4] : t8[i], give = b2 ? t8[i] : t8[i + 4]; u4[i] = keep + __int_as_float(__builtin_amdgcn_update_dpp(0, __float_as_int(give), 0x141, 0xF, 0xF, false)); }
#pragma unroll
                for (int i = 0; i < 2; ++i) { const float keep = b1 ? u4[i + 2] : u4[i], give = b1 ? u4[i] : u4[i + 2]; w2[i] = keep + __int_as_float(__builtin_amdgcn_update_dpp(0, __float_as_int(give), 0x1B, 0xF, 0xF, false)); }
                const float keep = b0 ? w2[1] : w2[0], give = b0 ? w2[0] : w2[1];
                LY[((s & ~15) + sq) * 32 + vl] = keep + __int_as_float(__builtin_amdgcn_update_dpp(0, __float_as_int(give), 0xB1, 0xF, 0xF, false));
            }
            wv = wn; kkv = kkn; bbv = bbn; kmv = kmn; rrv = rrn; vv = vn;
        }
        __syncthreads();
        { const float y0 = LY[ps * 32 + pq * 2], y1 = LY[ps * 32 + pq * 2 + 1];
          *(unsigned*)(YR + ((size_t)b * T + t0 + ps) * 512 + vc) = cvt_pk_bf16(y0, y1); }
        if (t0 + RW_TS < T) RW_PREP();
    }
#undef RW_LOAD
#undef RW_PREP
}
__device__ __forceinline__ void rwkv_post_phase(Frame& F, const Args& A) {
    F.tid = fresh_tid(); F.lane = F.tid & 63;
    const int gw = F.vcu * NWAVES + F.wave, NGW = F.G * NWAVES, lane = F.lane;
    const bf16_t* P1 = (const bf16_t*)(F.ws + WS_P1); const float* WAG = (const float*)(F.ws + WS_WAG); const bf16_t* YR = (const bf16_t*)(F.ws + WS_YRAW); bf16_t* YC = (bf16_t*)(F.ws + WS_YC1);
    const float* mu = A.in[16];
    const int hq = gw & 1, hc = (hq * 4 + (lane >> 4)) * 64 + (lane & 15) * 4;
    const f32x4 mur = *(const f32x4*)(mu + R_R + hc), muk = *(const f32x4*)(mu + R_K + hc), muv = *(const f32x4*)(mu + R_V + hc);
    const f32x4 ka = *(const f32x4*)(A.in[23] + hc), rk = *(const f32x4*)(A.in[24] + hc), lg = *(const f32x4*)(A.in[25] + hc), lb = *(const f32x4*)(A.in[26] + hc);
#define UNP4(dst, w) do { dst[0] = bflo((w).x); dst[1] = bfhi((w).x); dst[2] = bflo((w).y); dst[3] = bfhi((w).y); } while (0)
    for (int it0 = gw; it0 < M * 2; it0 += 2 * NGW) {
        u32x2 cr[2], ck[2], cv[2], pr[2], pk[2], pv[2], yw[2]; f32x4 a4[2], g4[2]; int mm[2]; bool ok[2];
#pragma unroll
        for (int j = 0; j < 2; ++j) { const int it = it0 + j * NGW; ok[j] = it < M * 2; const int m = ok[j] ? (it >> 1) : 0; mm[j] = m; const bf16_t* rp = P1 + (size_t)m * N1P; const bool hp = (m % T) > 0;
            cr[j] = *(const u32x2*)(rp + R_R + hc); ck[j] = *(const u32x2*)(rp + R_K + hc); cv[j] = *(const u32x2*)(rp + R_V + hc);
            pr[j] = hp ? *(const u32x2*)(rp - N1P + R_R + hc) : (u32x2){0u, 0u}; pk[j] = hp ? *(const u32x2*)(rp - N1P + R_K + hc) : (u32x2){0u, 0u}; pv[j] = hp ? *(const u32x2*)(rp - N1P + R_V + hc) : (u32x2){0u, 0u};
            a4[j] = *(const f32x4*)(WAG + (size_t)M * 512 + (size_t)m * 512 + hc); g4[j] = *(const f32x4*)(WAG + (size_t)2 * M * 512 + (size_t)m * 512 + hc); yw[j] = *(const u32x2*)(YR + (size_t)m * 512 + hc); }
#pragma unroll
        for (int j = 0; j < 2; ++j) { f32x4 r, k, v, r0, k0, v0, y;
            UNP4(r, cr[j]); UNP4(k, ck[j]); UNP4(v, cv[j]); UNP4(r0, pr[j]); UNP4(k0, pk[j]); UNP4(v0, pv[j]); UNP4(y, yw[j]);
            r = r + (r0 - r) * mur; k = k + (k0 - k) * muk; v = v + (v0 - v) * muv;
            const f32x4 km = k * (1.0f + (a4[j] - 1.0f) * ka);
            const float mean = dpp_sum16((y[0] + y[1]) + (y[2] + y[3])) * (1.0f / 64.0f); const f32x4 d = y - mean;
            const float var = dpp_sum16((d[0] * d[0] + d[1] * d[1]) + (d[2] * d[2] + d[3] * d[3])) * (1.0f / 64.0f); const float rstd = rsqrtf(var + 64e-5f);
            const f32x4 t = r * km * rk; const float bsum = dpp_sum16((t[0] + t[1]) + (t[2] + t[3]));
            const f32x4 o = (d * rstd * lg + lb + v * bsum) * g4[j];
            if (ok[j]) { u32x2 w; w.x = cvt_pk_bf16(o[0], o[1]); w.y = cvt_pk_bf16(o[2], o[3]); *(u32x2*)(YC + (size_t)mm[j] * D + hc) = w; } }
    }
#undef UNP4
}

__device__ __forceinline__ void router_phase(Frame& F, const Args& A, const bf16_t* H) {
    F.tid = fresh_tid(); F.lane = F.tid & 63;
    LAS float* RW = (LAS float*)F.lds;
    LAS int* LC = (LAS int*)(F.lds + 32768);
    LAS float* LG = (LAS float*)(F.lds + 36864);
    const float* rt = A.in[29]; const float* gf = A.in[2] + D; const pg8::u64* ssq = (const pg8::u64*)(F.ctl + CW_SSQ3);
    unsigned* cnt = F.ctl + CW_CNT; int* lists = (int*)(F.ws + WS_LIST); float* glists = (float*)(F.ws + WS_GLIST); float* rlists = (float*)(F.ws + WS_RLIST); int* toki = (int*)(F.ws + WS_TOKI);
    for (int i = F.tid; i < 8192; i += NTHR) { const int k = i >> 3, e = i & 7; RW[((e * 4 + ((k >> 2) & 3)) * 64 + (k >> 4)) * 4 + (k & 3)] = rt[i] * gf[k]; }
    __syncthreads();
    unsigned char* h8 = F.ws + WS_H3B;
    for (int blk = blockIdx.x; blk < M / 64; blk += F.G) {
        if (F.tid < 8) LC[F.tid] = 0;
        __syncthreads();
        for (int j = 0; j < 8; ++j) { const int tl = F.wave * 8 + j, m = blk * 64 + tl; const u32x4* hr = (const u32x4*)(H + (size_t)m * D) + 2 * F.lane;
            float acc[8];
#pragma unroll
            for (int e = 0; e < 8; ++e) acc[e] = 0.f;
            const u32x4 xb0 = hr[0], xb1 = hr[1]; f32x4 x[4];
            x[0] = (f32x4){bflo(xb0.x), bfhi(xb0.x), bflo(xb0.y), bfhi(xb0.y)}; x[1] = (f32x4){bflo(xb0.z), bfhi(xb0.z), bflo(xb0.w), bfhi(xb0.w)};
            x[2] = (f32x4){bflo(xb1.x), bfhi(xb1.x), bflo(xb1.y), bfhi(xb1.y)}; x[3] = (f32x4){bflo(xb1.z), bfhi(xb1.z), bflo(xb1.w), bfhi(xb1.w)};
            { u32x4 w;
              w.x = pk_fp8x4(x[0].x * pg8::Q8_H, x[0].y * pg8::Q8_H, x[0].z * pg8::Q8_H, x[0].w * pg8::Q8_H); w.y = pk_fp8x4(x[1].x * pg8::Q8_H, x[1].y * pg8::Q8_H, x[1].z * pg8::Q8_H, x[1].w * pg8::Q8_H);
              w.z = pk_fp8x4(x[2].x * pg8::Q8_H, x[2].y * pg8::Q8_H, x[2].z * pg8::Q8_H, x[2].w * pg8::Q8_H); w.w = pk_fp8x4(x[3].x * pg8::Q8_H, x[3].y * pg8::Q8_H, x[3].z * pg8::Q8_H, x[3].w * pg8::Q8_H);
              *(u32x4*)(h8 + (size_t)m * D + F.lane * 16) = w; }
#pragma unroll
            for (int q = 0; q < 4; ++q) {
#pragma unroll
                for (int e = 0; e < 8; ++e) { const f32x4 wv = *(const LAS f32x4*)(RW + ((e * 4 + q) * 64 + F.lane) * 4); acc[e] += (x[q].x * wv.x + x[q].y * wv.y) + (x[q].z * wv.z + x[q].w * wv.w); } }
            const float rs = pg8::rs_from(ssq[m]);
#pragma unroll
            for (int e = 0; e < 8; ++e) acc[e] = wave_sum(acc[e]) * rs;
            int e1 = 0; float v1 = acc[0];
#pragma unroll
            for (int e = 1; e < 8; ++e) if (acc[e] > v1) { v1 = acc[e]; e1 = e; }
            int e2 = (e1 == 0) ? 1 : 0; float v2 = -INFINITY;
#pragma unroll
            for (int e = 0; e < 8; ++e) if (e != e1 && acc[e] > v2) { v2 = acc[e]; e2 = e; }
            const float g2 = 1.0f / (1.0f + __expf(v1 - v2)), g1 = 1.0f - g2;
            if (F.lane == 0) { const int lp1 = atomicAdd((int*)&LC[e1], 1), lp2 = atomicAdd((int*)&LC[e2], 1);
                LC[16 + tl * 4 + 0] = e1; LC[16 + tl * 4 + 1] = e2; LC[16 + tl * 4 + 2] = lp1; LC[16 + tl * 4 + 3] = lp2; LG[16 + tl * 2] = g1; LG[16 + tl * 2 + 1] = g2; } }
        __syncthreads();
        if (F.tid < 8) LC[8 + F.tid] = (int)atomicAdd(cnt + F.tid, (unsigned)LC[F.tid]);
        __syncthreads();
        if (F.tid < 64) { const int tl = F.tid, m = blk * 64 + tl; const int e1 = LC[16 + tl * 4], e2 = LC[16 + tl * 4 + 1]; const int p1 = LC[8 + e1] + LC[16 + tl * 4 + 2], p2 = LC[8 + e2] + LC[16 + tl * 4 + 3];
            lists[e1 * M + p1] = m; lists[e2 * M + p2] = m; glists[e1 * M + p1] = LG[16 + tl * 2]; glists[e2 * M + p2] = LG[16 + tl * 2 + 1];
            { const float rsm = pg8::rs_from(ssq[m]); rlists[e1 * M + p1] = rsm; rlists[e2 * M + p2] = rsm; }
            *(int4*)(toki + (size_t)m * 4) = make_int4(e1, p1, e2, p2); }
        __syncthreads();
    }
}

struct MoeOrder {
    int cn[8]; int NT, G, c; bool down; const int* lists; const float* glists; int kdiv;
    __device__ __forceinline__ int total_units() const { int P = 0;
#pragma unroll
        for (int q = 0; q < 8; ++q) P += (cn[q] + 255) >> 8;
        return P * NT; }
    __device__ __forceinline__ bool split_tail() const { const int U = total_units(); return down && U > 512 && U <= 548; }
    __device__ __forceinline__ int tail_row0() const { int gp = 0, seg = 0, r0 = 0; bool f = false;
#pragma unroll
        for (int q = 0; q < 8; ++q) { const int nq = (cn[q] + 255) >> 8; if (!f && gp + nq > 128) { r0 = seg + (128 - gp) * 256; f = true; } gp += nq; seg += cn[q]; }
        return r0; }
    __device__ bool next(int i, pg8::Unit& u) const {
        const int cp = (c % 8) * (G / 8) + c / 8; int L = i * G + cp, ks = -1;
        if (split_tail() && i >= 2) { const int sub = (i - 2) * G + cp; if (sub >= MOE_KS * (total_units() - 512)) return false; L = 512 + sub / MOE_KS; ks = sub % MOE_KS; }
        int seg = 0, e = 8, np = 0, ce = 0; bool found = false;
#pragma unroll
        for (int q = 0; q < 8; ++q) { if (!found) { const int cq = cn[q], nq = (cq + 255) >> 8, ne = nq * NT; if (L < ne) { found = true; e = q; ce = cq; np = nq; } else { L -= ne; seg += cq; } } }
        if (!found) return false;
        const int full = NT >> 3, remt = NT & 7; int p, tile;
        if (L < full * np * 8) { const int tg = L / (np * 8), rem = L % (np * 8); p = rem >> 3; tile = tg * 8 + (rem & 7); }
        else { const int l2 = L - full * np * 8; p = l2 / remt; tile = full * 8 + l2 % remt; }
        u.nrows = min(256, ce - p * 256); u.orow = seg + p * 256; u.ocol = tile * 256; u.ex = 0; u.arow = seg + p * 256; u.koff = 0; u.nt = 0;
        if (ks >= 0) { u.ex = 1 + ks; u.koff = ks * (FE / MOE_KS) / kdiv; u.nt = FE / MOE_KS / 64 / kdiv; }
        if (!down) { u.brow = e * 2 * FE + tile * 256; u.rows = lists + e * M + p * 256; }
        else { u.brow = e * D + tile * 256; u.rows = (const int*)(glists + e * M + p * 256); }
        return true;
    }
};

__device__ __forceinline__ void final_phase(Frame& F, const Args& A, const bf16_t* H3, float* H) {
    F.tid = fresh_tid(); F.lane = F.tid & 63;
    const int gw = F.vcu * NWAVES + F.wave, NGW = F.G * NWAVES, lane = F.lane; const unsigned* cnt = F.ctl + CW_CNT; const int* toki = (const int*)(F.ws + WS_TOKI);
    const bf16_t* OS = (const bf16_t*)(F.ws + WS_OUTS); const bf16_t* OP = (const bf16_t*)(F.ws + WS_OUTP); const float* fg = A.in[33];
    int seg[8]; MoeOrder MO; { int s = 0;
#pragma unroll
        for (int e = 0; e < 8; ++e) { seg[e] = s; MO.cn[e] = (int)cnt[e]; s += (int)cnt[e]; } }
    MO.NT = D / 256; MO.down = true; MO.kdiv = 2; const bool split = MO.split_tail(); const int tr0 = split ? MO.tail_row0() : 0x7fffffff;
    f32x4 gv[4];
#pragma unroll
    for (int j = 0; j < 4; ++j) gv[j] = *((const f32x4*)fg + lane + 64 * j);
    for (int m0 = gw; m0 < M; m0 += 2 * NGW) {
        int sl[2][2]; f32x4 v[2][4]; u32x2 o[2][2][4];
#pragma unroll
        for (int q = 0; q < 2; ++q) { const int m = m0 + q * NGW; const int4 ti = *(const int4*)(toki + (size_t)m * 4); int s1 = 0, s2 = 0;
#pragma unroll
            for (int e = 0; e < 8; ++e) { if (ti.x == e) s1 = seg[e]; if (ti.z == e) s2 = seg[e]; }
            sl[q][0] = s1 + ti.y; sl[q][1] = s2 + ti.w; }
#pragma unroll
        for (int q = 0; q < 2; ++q) { const int m = m0 + q * NGW; const u32x2* hr = (const u32x2*)(H3 + (size_t)m * D) + lane;
#pragma unroll
            for (int j = 0; j < 4; ++j) { const u32x2 hb = hr[64 * j]; v[q][j] = (f32x4){bflo(hb.x), bfhi(hb.x), bflo(hb.y), bfhi(hb.y)}; }
#pragma unroll
            for (int w2 = 0; w2 < 2; ++w2) { const int s_ = sl[q][w2];
                if (s_ < tr0) { const u32x2* o1 = (const u32x2*)(OS + (size_t)s_ * D) + lane;
#pragma unroll
                    for (int j = 0; j < 4; ++j) o[q][w2][j] = o1[64 * j]; }
                else {
#pragma unroll
                    for (int j = 0; j < 4; ++j) o[q][w2][j] = (u32x2){0u, 0u};
                    for (int ks = 0; ks < MOE_KS; ++ks) { const u32x2* o1 = (const u32x2*)(OP + ((size_t)ks * MOE_TAIL_ROWS + (s_ - tr0)) * D) + lane;
#pragma unroll
                        for (int j = 0; j < 4; ++j) { const u32x2 a = o1[64 * j]; v[q][j].x += bflo(a.x); v[q][j].y += bfhi(a.x); v[q][j].z += bflo(a.y); v[q][j].w += bfhi(a.y); } } } } }
#pragma unroll
        for (int q = 0; q < 2; ++q) { const int m = m0 + q * NGW; float s = 0.f;
#pragma unroll
            for (int j = 0; j < 4; ++j) {
#pragma unroll
                for (int w2 = 0; w2 < 2; ++w2) { const u32x2 a = o[q][w2][j]; v[q][j].x += bflo(a.x); v[q][j].y += bfhi(a.x); v[q][j].z += bflo(a.y); v[q][j].w += bfhi(a.y); }
                s += (v[q][j].x * v[q][j].x + v[q][j].y * v[q][j].y) + (v[q][j].z * v[q][j].z + v[q][j].w * v[q][j].w); }
            const float rs = rsqrtf(wave_sum(s) * (1.0f / 1024.0f) + 1e-6f); f32x4* hw = (f32x4*)(H + (size_t)m * D) + lane;
#pragma unroll
            for (int j = 0; j < 4; ++j) hw[64 * j] = v[q][j] * rs * gv[j]; } }
}
typedef __bf16 bf16x2c_t __attribute__((ext_vector_type(2)));
__device__ __forceinline__ unsigned cvt_pk_c(float lo, float hi) { f32x2 v = {lo, hi}; bf16x2c_t b = __builtin_convertvector(v, bf16x2c_t); return __builtin_bit_cast(unsigned, b); }
constexpr int RP = 72;
constexpr int RC_A = 0, RC_B = 9216, RC_K = 18432, RC_R = 27648, RC_AT = 36864, RC_BHT = 46080, RC_KHT = 55296, RC_VT = 64512;
constexpr int RC_AAB = 73728, RC_T = 90368, RC_AAK = 107008, RC_MRK = 116224, RC_ELC = 125440, RC_TMP = 125696;
constexpr int RC_LA = RC_AAB, RC_SS = RC_T, RC_MRB = RC_A, RC_X1T = RC_B, RC_TB = RC_K, RC_WT = RC_AAB, RC_U0T = RC_T, RC_GI = RC_AT, RC_QI = RC_B;
static_assert(RC_TMP + 4096 <= RING_BYTES, "rwkv pre LDS map");
__device__ __forceinline__ size_t wag_fp(int m0, int h, int o) { return ((size_t)(m0 + (o >> 8)) * 512 + h * 64) * 4 + (o & 255); }

__device__ __forceinline__ void rwkv_pre_phase(Frame& F, const Args& A) {
    F.tid = fresh_tid(); F.lane = F.tid & 63;
    const int tid = F.tid, lane = F.lane, wave = F.wave, r32 = lane & 31, hi = lane >> 5, kw = wave * 8;
    const bf16_t* P1 = (const bf16_t*)(F.ws + WS_P1); unsigned char* WAG0 = F.ws + WS_WAG; unsigned char* WAG1 = F.ws + WS_WAG + (size_t)M * 512 * 4; float* BON = (float*)(F.ws + WS_BON);
    LAS unsigned char* L = F.lds;
    LAS bf16_t* IA = (LAS bf16_t*)(L + RC_A); LAS bf16_t* IB = (LAS bf16_t*)(L + RC_B); LAS bf16_t* IK = (LAS bf16_t*)(L + RC_K); LAS bf16_t* IR = (LAS bf16_t*)(L + RC_R);
    LAS bf16_t* IAT = (LAS bf16_t*)(L + RC_AT); LAS bf16_t* IBH = (LAS bf16_t*)(L + RC_BHT); LAS bf16_t* IKH = (LAS bf16_t*)(L + RC_KHT); LAS bf16_t* IVT = (LAS bf16_t*)(L + RC_VT);
    LAS float* AAB = (LAS float*)(L + RC_AAB); LAS float* TM = (LAS float*)(L + RC_T); LAS bf16_t* IAK = (LAS bf16_t*)(L + RC_AAK); LAS bf16_t* IMK = (LAS bf16_t*)(L + RC_MRK);
    LAS float* ELC = (LAS float*)(L + RC_ELC); LAS float* TMP = (LAS float*)(L + RC_TMP); LAS float* LA = (LAS float*)(L + RC_LA); LAS float* SS = (LAS float*)(L + RC_SS);
    LAS bf16_t* IMB = (LAS bf16_t*)(L + RC_MRB); LAS bf16_t* IX1 = (LAS bf16_t*)(L + RC_X1T); LAS bf16_t* ITB = (LAS bf16_t*)(L + RC_TB); LAS bf16_t* IWT = (LAS bf16_t*)(L + RC_WT); LAS bf16_t* IU0 = (LAS bf16_t*)(L + RC_U0T);
    LAS bf16_t* IGI = (LAS bf16_t*)(L + RC_GI); LAS bf16_t* IQI = (LAS bf16_t*)(L + RC_QI);
    const int h = ((int)blockIdx.x >> 5) & 7;
    const float* mu = A.in[16]; const int hc = h * 64 + kw;
    for (int c = blockIdx.x; c < 2048; c += F.G) {
        const int bh = c >> 5, n = c & 31, b = bh >> 3, m0 = b * T + n * 64; const bool hp = (n * 64 + lane) > 0;
        f32x4 mur[2], muk[2], muv[2], kkc[2], kac[2], rkc[2];
#pragma unroll
        for (int q = 0; q < 2; ++q) { mur[q] = *(const f32x4*)(mu + R_R + hc + 4 * q); muk[q] = *(const f32x4*)(mu + R_K + hc + 4 * q); muv[q] = *(const f32x4*)(mu + R_V + hc + 4 * q);
            kkc[q] = *(const f32x4*)(A.in[22] + hc + 4 * q); kac[q] = *(const f32x4*)(A.in[23] + hc + 4 * q); rkc[q] = *(const f32x4*)(A.in[24] + hc + 4 * q); }
        const bf16_t* rowp = P1 + (size_t)(m0 + lane) * N1P;
        const u32x4 cr = *(const u32x4*)(rowp + R_R + hc), ck = *(const u32x4*)(rowp + R_K + hc), cv = *(const u32x4*)(rowp + R_V + hc);
        const u32x4 z4 = (u32x4){0u, 0u, 0u, 0u};
        const u32x4 pr = hp ? *(const u32x4*)(rowp - N1P + R_R + hc) : z4, pk = hp ? *(const u32x4*)(rowp - N1P + R_K + hc) : z4, pv = hp ? *(const u32x4*)(rowp - N1P + R_V + hc) : z4;
        const size_t wo = ((size_t)(m0 + lane) * 512 + hc) * 4;
        const f32x4 lw0 = *(const f32x4*)(WAG0 + wo), lw1 = *(const f32x4*)(WAG0 + wo + 16); const u32x4 asb = *(const u32x4*)(WAG1 + (size_t)(m0 + lane) * 2048 + (hc >> 6) * 256 + (hc & 63) * 2);
        float r[8], k[8], v[8], lw[8], as[8];
#pragma unroll
        for (int q = 0; q < 4; ++q) { const float m_r0 = mur[q >> 1][(q & 1) * 2], m_r1 = mur[q >> 1][(q & 1) * 2 + 1], m_k0 = muk[q >> 1][(q & 1) * 2], m_k1 = muk[q >> 1][(q & 1) * 2 + 1], m_v0 = muv[q >> 1][(q & 1) * 2], m_v1 = muv[q >> 1][(q & 1) * 2 + 1];
            float c0 = bflo(cr[q]), c1 = bfhi(cr[q]); r[2 * q] = c0 + (bflo(pr[q]) - c0) * m_r0; r[2 * q + 1] = c1 + (bfhi(pr[q]) - c1) * m_r1;
            c0 = bflo(ck[q]); c1 = bfhi(ck[q]); k[2 * q] = c0 + (bflo(pk[q]) - c0) * m_k0; k[2 * q + 1] = c1 + (bfhi(pk[q]) - c1) * m_k1;
            c0 = bflo(cv[q]); c1 = bfhi(cv[q]); v[2 * q] = c0 + (bflo(pv[q]) - c0) * m_v0; v[2 * q + 1] = c1 + (bfhi(pv[q]) - c1) * m_v1; }
#pragma unroll
        for (int j = 0; j < 4; ++j) { lw[j] = lw0[j]; lw[4 + j] = lw1[j]; as[2 * j] = bflo(asb[j]); as[2 * j + 1] = bfhi(asb[j]); }
        float kkv[8], km[8], ssp = 0.f, bp = 0.f;
#pragma unroll
        for (int j = 0; j < 8; ++j) { kkv[j] = k[j] * kkc[j >> 2][j & 3]; ssp += kkv[j] * kkv[j]; km[j] = k[j] * (1.0f + (as[j] - 1.0f) * kac[j >> 2][j & 3]); bp += r[j] * km[j] * rkc[j >> 2][j & 3]; }
        SS[wave * 64 + lane] = ssp; SS[512 + wave * 64 + lane] = bp;
        *(LAS f32x4*)(LA + lane * 64 + kw) = lw0; *(LAS f32x4*)(LA + lane * 64 + kw + 4) = lw1;
        asm volatile("s_waitcnt lgkmcnt(0)" ::: "memory");
        if (lane < 8) { float xs[64];
#pragma unroll
            for (int t = 0; t < 64; ++t) xs[t] = LA[t * 64 + kw + lane];
#pragma unroll
            for (int t = 1; t < 64; ++t) xs[t] += xs[t - 1];
#pragma unroll
            for (int t = 0; t < 64; ++t) LA[t * 64 + kw + lane] = xs[t]; }
        asm volatile("s_waitcnt lgkmcnt(0)" ::: "memory");
        float Lc[8], LC[8];
        { const f32x4 b0 = *(const LAS f32x4*)(LA + lane * 64 + kw), b1 = *(const LAS f32x4*)(LA + lane * 64 + kw + 4), e0 = *(const LAS f32x4*)(LA + 63 * 64 + kw), e1 = *(const LAS f32x4*)(LA + 63 * 64 + kw + 4);
#pragma unroll
          for (int j = 0; j < 4; ++j) { Lc[j] = b0[j]; Lc[4 + j] = b1[j]; LC[j] = e0[j]; LC[4 + j] = e1[j]; } }
        __syncthreads();
        float ss = 0.f, bon = 0.f;
#pragma unroll
        for (int w = 0; w < 8; ++w) { ss += SS[w * 64 + lane]; bon += SS[512 + w * 64 + lane]; }
        const float inv = rsqrtf(fmaxf(ss, 1e-24f));
        if (wave == 0) BON[(size_t)(m0 + lane) * 8 + h] = bon;
        { float ia[8], ib[8], ik[8], ir[8], ibh[8], ikh[8];
#pragma unroll
          for (int j = 0; j < 8; ++j) { const float kn = kkv[j] * inv, bb = kn * as[j], eL = __expf(Lc[j]), eN = __expf(-Lc[j]), eP = __expf(Lc[j] - lw[j]), eC = __expf(LC[j] - Lc[j]);
              ia[j] = -kn * eP; ib[j] = bb * eN; ik[j] = km[j] * eN; ir[j] = r[j] * eL; ibh[j] = bb * eC; ikh[j] = km[j] * eC; }
          u32x4 w4;
#define PK8(src) (w4.x = cvt_pk_bf16(src[0], src[1]), w4.y = cvt_pk_bf16(src[2], src[3]), w4.z = cvt_pk_bf16(src[4], src[5]), w4.w = cvt_pk_bf16(src[6], src[7]), w4)
          *(LAS u32x4*)(IA + lane * RP + kw) = PK8(ia); *(LAS u32x4*)(IB + lane * RP + kw) = PK8(ib); *(LAS u32x4*)(IK + lane * RP + kw) = PK8(ik); *(LAS u32x4*)(IR + lane * RP + kw) = PK8(ir);
#undef PK8
#pragma unroll
          for (int j = 0; j < 8; ++j) { IAT[(kw + j) * RP + lane] = (bf16_t)f2bf(ia[j]); IBH[(kw + j) * RP + lane] = (bf16_t)f2bf(ibh[j]); IKH[(kw + j) * RP + lane] = (bf16_t)f2bf(ikh[j]); IVT[(kw + j) * RP + lane] = (bf16_t)f2bf(v[j]); }
          if (lane < 8) { float d = LC[0];
#pragma unroll
              for (int j = 1; j < 8; ++j) d = (lane == j) ? LC[j] : d;
              ELC[kw + lane] = __expf(d); } }
        __syncthreads();
        for (int i = tid; i < 64 * 65; i += NTHR) TM[i] = 0.f;
        { const int ti = wave >> 2, which = (wave >> 1) & 1, tj = wave & 1; f32x16 acc = {};
          if (tj <= ti) acc = gla_mma64(acc, IA + 32 * ti * RP, (which ? IK : IB) + 32 * tj * RP, r32, hi);
#pragma unroll
          for (int rr = 0; rr < 16; ++rr) { const int t = 32 * ti + crow32(rr, hi), s = 32 * tj + r32; const float val = (s < t) ? acc[rr] : 0.f;
              if (which == 0) AAB[t * 65 + s] = val; else IAK[t * RP + s] = (bf16_t)f2bf(val); } }
        __syncthreads();
        { const int ti = wave >> 2, which = (wave >> 1) & 1, tj = wave & 1; f32x16 acc = {};
          if (tj <= ti) acc = gla_mma64(acc, IR + 32 * ti * RP, (which ? IK : IB) + 32 * tj * RP, r32, hi);
          LAS bf16_t* dst = which ? IMK : IMB;
#pragma unroll
          for (int rr = 0; rr < 16; ++rr) { const int t = 32 * ti + crow32(rr, hi), s = 32 * tj + r32; float mv = (s <= t) ? acc[rr] : 0.f; if ((DBG_SKIP) & 32768) mv = (s <= t) ? 0.01f : 0.f; dst[t * RP + s] = (bf16_t)f2bf(mv); } }
        __syncthreads();
        if (wave < 4) { const int tv = wave >> 1, tt = wave & 1; f32x16 acc = {}; acc = gla_mma64(acc, IVT + 32 * tv * RP, IAK + 32 * tt * RP, r32, hi);
#pragma unroll
            for (int rr = 0; rr < 16; ++rr) IX1[(32 * tv + crow32(rr, hi)) * RP + 32 * tt + r32] = (bf16_t)f2bf(acc[rr]); }
        else if (wave == 4) {
            { int cc = lane & 15; asm volatile("" : "+v"(cc)); const int bi = lane >> 4; float x[16];
#pragma unroll
              for (int t = 0; t < 16; ++t) { float s = (t == cc) ? 1.0f : 0.f;
#pragma unroll
                  for (int q = 0; q < 16; ++q) if (q < t) s += AAB[(16 * bi + t) * 65 + 16 * bi + q] * x[q];
                  x[t] = s; TM[(16 * bi + t) * 65 + 16 * bi + cc] = s; } }
            asm volatile("s_waitcnt lgkmcnt(0)" ::: "memory");
            const int l15 = lane & 15, lq = lane >> 4;
#pragma unroll
            for (int blk = 0; blk < 2; ++blk) { const int bi = 2 * blk + 1, bj = 2 * blk; f32x4 p = {0.f, 0.f, 0.f, 0.f};
#pragma unroll
                for (int kk = 0; kk < 4; ++kk) p = __builtin_amdgcn_mfma_f32_16x16x4f32(AAB[(16 * bi + l15) * 65 + 16 * bj + 4 * kk + lq], TM[(16 * bj + 4 * kk + lq) * 65 + 16 * bj + l15], p, 0, 0, 0);
#pragma unroll
                for (int j = 0; j < 4; ++j) TMP[blk * 256 + (4 * lq + j) * 16 + l15] = p[j]; }
            asm volatile("s_waitcnt lgkmcnt(0)" ::: "memory");
#pragma unroll
            for (int blk = 0; blk < 2; ++blk) { const int bi = 2 * blk + 1, bj = 2 * blk; f32x4 p = {0.f, 0.f, 0.f, 0.f};
#pragma unroll
                for (int kk = 0; kk < 4; ++kk) p = __builtin_amdgcn_mfma_f32_16x16x4f32(TM[(16 * bi + l15) * 65 + 16 * bi + 4 * kk + lq], TMP[blk * 256 + (4 * kk + lq) * 16 + l15], p, 0, 0, 0);
#pragma unroll
                for (int j = 0; j < 4; ++j) TM[(16 * bi + 4 * lq + j) * 65 + 16 * bj + l15] = p[j]; }
            asm volatile("s_waitcnt lgkmcnt(0)" ::: "memory");
            { f32x16 x = {};
#pragma unroll
              for (int kk = 0; kk < 16; ++kk) x = __builtin_amdgcn_mfma_f32_32x32x2f32(AAB[(32 + r32) * 65 + 2 * kk + hi], TM[(2 * kk + hi) * 65 + r32], x, 0, 0, 0);
#pragma unroll
              for (int rr = 0; rr < 16; ++rr) TMP[crow32(rr, hi) * 32 + r32] = x[rr]; }
            asm volatile("s_waitcnt lgkmcnt(0)" ::: "memory");
            { f32x16 x = {};
#pragma unroll
              for (int kk = 0; kk < 16; ++kk) x = __builtin_amdgcn_mfma_f32_32x32x2f32(TM[(32 + r32) * 65 + 32 + 2 * kk + hi], TMP[(2 * kk + hi) * 32 + r32], x, 0, 0, 0);
#pragma unroll
              for (int rr = 0; rr < 16; ++rr) TM[(32 + crow32(rr, hi)) * 65 + r32] = x[rr]; }
        }
        __syncthreads();
        { const int t = tid >> 3, s8 = (tid & 7) * 8; const LAS float* tp = TM + t * 65 + s8; u32x4 w4;
          w4.x = cvt_pk_bf16(tp[0], tp[1]); w4.y = cvt_pk_bf16(tp[2], tp[3]); w4.z = cvt_pk_bf16(tp[4], tp[5]); w4.w = cvt_pk_bf16(tp[6], tp[7]); *(LAS u32x4*)(ITB + t * RP + s8) = w4; }
        __syncthreads();
        { const int t0 = (wave >> 1) & 1, t1 = wave & 1; f32x16 acc = {}; acc = gla_mma64(acc, ((wave < 4) ? IAT : IX1) + 32 * t0 * RP, ITB + 32 * t1 * RP, r32, hi);
          LAS bf16_t* dst = (wave < 4) ? IWT : IU0;
#pragma unroll
          for (int rr = 0; rr < 16; ++rr) dst[(32 * t0 + crow32(rr, hi)) * RP + 32 * t1 + r32] = (bf16_t)f2bf(acc[rr]); }
        __syncthreads();
        { const int t0 = (wave >> 1) & 1, t1 = wave & 1, tile = t0 * 2 + t1;
          if (wave < 4) {
              f32x16 g = {}; g = gla_mma64(g, IBH + 32 * t0 * RP, IWT + 32 * t1 * RP, r32, hi);
#pragma unroll
              for (int rr = 0; rr < 16; ++rr) { const int kr = 32 * t0 + crow32(rr, hi), kc = 32 * t1 + r32; IGI[kr * RP + kc] = (bf16_t)f2bf(g[rr] + ((kr == kc) ? ELC[kr] : 0.f)); }
              f32x16 j = {}; j = gla_mma64(j, IBH + 32 * t0 * RP, IU0 + 32 * t1 * RP, r32, hi); j = gla_mma64(j, IKH + 32 * t0 * RP, IVT + 32 * t1 * RP, r32, hi);
              u32x4 w0, w1; w0.x = cvt_pk_c(j[0], j[1]); w0.y = cvt_pk_c(j[2], j[3]); w0.z = cvt_pk_c(j[4], j[5]); w0.w = cvt_pk_c(j[6], j[7]);
              w1.x = cvt_pk_c(j[8], j[9]); w1.y = cvt_pk_c(j[10], j[11]); w1.z = cvt_pk_c(j[12], j[13]); w1.w = cvt_pk_c(j[14], j[15]);
              const int o = tile * 2048 + lane * 16; *(u32x4*)(WAG1 + wag_fp(m0, h, o)) = w0; *(u32x4*)(WAG1 + wag_fp(m0, h, o + 1024)) = w1;
          } else {
              f32x16 q = {}; q = gla_mma64(q, IMB + 32 * t0 * RP, IWT + 32 * t1 * RP, r32, hi);
#pragma unroll
              for (int rr = 0; rr < 16; ++rr) { const int tr = 32 * t0 + crow32(rr, hi), kc = 32 * t1 + r32; IQI[tr * RP + kc] = (bf16_t)f2bf(q[rr] + bf2f(IR[tr * RP + kc])); }
              f32x16 y = {}; if (!((DBG_SKIP) & 8192)) y = gla_mma64(y, IMB + 32 * t0 * RP, IU0 + 32 * t1 * RP, r32, hi); if (!((DBG_SKIP) & 16384)) y = gla_mma64(y, IMK + 32 * t0 * RP, IVT + 32 * t1 * RP, r32, hi);
              if ((DBG_SKIP) & 65536) { for (int rr = 0; rr < 16; ++rr) y[rr] = 0.5f; }
              if ((DBG_SKIP) & 131072) { for (int rr = 0; rr < 16; ++rr) y[rr] = bf2f(IVT[(32 * t1 + r32) * RP + 32 * t0 + crow32(rr, hi)]); }
              if ((DBG_SKIP) & 262144) { for (int rr = 0; rr < 16; ++rr) y[rr] = bf2f(IMK[(32 * t0 + crow32(rr, hi)) * RP + 32 * t1 + r32]); }
              u32x4 w0, w1; w0.x = cvt_pk_c(y[0], y[1]); w0.y = cvt_pk_c(y[2], y[3]); w0.z = cvt_pk_c(y[4], y[5]); w0.w = cvt_pk_c(y[6], y[7]);
              w1.x = cvt_pk_c(y[8], y[9]); w1.y = cvt_pk_c(y[10], y[11]); w1.z = cvt_pk_c(y[12], y[13]); w1.w = cvt_pk_c(y[14], y[15]);
              const int o = 8192 + tile * 2048 + lane * 16; *(u32x4*)(WAG1 + wag_fp(m0, h, o)) = w0; *(u32x4*)(WAG1 + wag_fp(m0, h, o + 1024)) = w1;
          } }
        __syncthreads();
#pragma unroll
        for (int p = 0; p < 2; ++p) { const int o = tid + 512 * p, which = o >> 9, row = (o >> 3) & 63, c8 = (o & 7) * 8;
            const u32x4 val = *(const LAS u32x4*)((which ? IQI : IGI) + row * RP + c8);
            *(u32x4*)(WAG0 + wag_fp(m0, h, ((which * 2 + (row >> 5)) * 4 + (c8 >> 4)) * 1024 + ((row & 31) + 32 * ((c8 >> 3) & 1)) * 16)) = val; }
        __syncthreads();
    }
}

constexpr int RS_HT0 = 0, RS_HT1 = 9216;
__device__ __forceinline__ void rwkv_cscan_phase(Frame& F, const Args& A, int bh, int probe = 0) {
    F.tid = fresh_tid(); F.lane = F.tid & 63; (void)A;
    const int tid = F.tid, lane = F.lane, wave = F.wave, r32 = lane & 31, hi = lane >> 5;
    const int b = bh >> 3, h = bh & 7, t0 = (wave >> 1) & 1, t1 = wave & 1, tile = t0 * 2 + t1; const bool stw = wave < 4;
    const unsigned char* WAG0 = F.ws + WS_WAG; const unsigned char* WAG1 = F.ws + WS_WAG + (size_t)M * 512 * 4; bf16_t* YR = (bf16_t*)(F.ws + (probe ? WS_WE2T + ((size_t)32 << 20) : WS_YRAW));
    LAS bf16_t* HT[2] = {(LAS bf16_t*)(F.lds + RS_HT0), (LAS bf16_t*)(F.lds + RS_HT1)};
    LAS bf16_t* YS = (LAS bf16_t*)(F.lds + 18432 + (wave & 3) * 2560);
    for (int i = tid; i < 2 * 64 * RP / 2; i += NTHR) ((LAS unsigned*)F.lds)[i] = 0u;
    __syncthreads();
    f32x16 acc = {};
    bf16x8 afq[4][4]; u32x4 c0q[4], c1q[4];
#define CS_LOAD(q_, n_) do { const int m0_ = b * T + (n_) * 64; \
        _Pragma("unroll") for (int s_ = 0; s_ < 4; ++s_) afq[q_][s_] = *(const bf16x8*)(WAG0 + wag_fp(m0_, h, (((stw ? 0 : 2) + t0) * 4 + s_) * 1024 + lane * 16)); \
        const int o_ = (stw ? 0 : 8192) + tile * 2048 + lane * 16; c0q[q_] = *(const u32x4*)(WAG1 + wag_fp(m0_, h, o_)); c1q[q_] = *(const u32x4*)(WAG1 + wag_fp(m0_, h, o_ + 1024)); } while (0)
#pragma unroll
    for (int q = 0; q < 4; ++q) CS_LOAD(q, q);
#ifdef SCAN_PROBE
#define CS_LOAD2(q_, n_) do { if (!probe) CS_LOAD(q_, n_); } while (0)
#else
#define CS_LOAD2(q_, n_) CS_LOAD(q_, n_)
#endif
    for (int n0 = 0; n0 < 32; n0 += 4) {
#pragma unroll
      for (int j = 0; j < 4; ++j) { const int n = n0 + j;
        const LAS bf16_t* Hc = HT[n & 1]; LAS bf16_t* Hn = HT[(n + 1) & 1];
        bf16x8 a_[4]; const u32x4 d0 = c0q[j], d1 = c1q[j];
#pragma unroll
        for (int s = 0; s < 4; ++s) a_[s] = afq[j][s];
        CS_LOAD2(j, (n + 4 < 32) ? n + 4 : 31);
        f32x16 o;
        o[0] = bflo(d0.x); o[1] = bfhi(d0.x); o[2] = bflo(d0.y); o[3] = bfhi(d0.y); o[4] = bflo(d0.z); o[5] = bfhi(d0.z); o[6] = bflo(d0.w); o[7] = bfhi(d0.w);
        o[8] = bflo(d1.x); o[9] = bfhi(d1.x); o[10] = bflo(d1.y); o[11] = bfhi(d1.y); o[12] = bflo(d1.z); o[13] = bfhi(d1.z); o[14] = bflo(d1.w); o[15] = bfhi(d1.w);
#pragma unroll
        for (int s = 0; s < 4; ++s) { const bf16x8 bfr = *(const LAS bf16x8*)(Hc + (32 * t1 + r32) * RP + 16 * s + 8 * hi); o = __builtin_amdgcn_mfma_f32_32x32x16_bf16(a_[s], bfr, o, 0, 0, 0); }
        if (stw) {
            acc = o;
#pragma unroll
            for (int g = 0; g < 4; ++g) { u32x2 w; w.x = cvt_pk_c(o[4 * g], o[4 * g + 1]); w.y = cvt_pk_c(o[4 * g + 2], o[4 * g + 3]);
                *(LAS u32x2*)(Hn + (32 * t1 + r32) * RP + 32 * t0 + 8 * g + 4 * hi) = w; }
        } else {
            const int m0 = b * T + n * 64;
#pragma unroll
            for (int rr = 0; rr < 16; ++rr) YS[crow32(rr, hi) * 40 + r32] = (bf16_t)f2bf(o[rr]);
            LDS_WAIT(); asm volatile("" ::: "memory");
#pragma unroll
            for (int i = 0; i < 2; ++i) { const int sg = lane + 64 * i, tk = sg >> 2, vs = sg & 3; const u32x4 w = *(const LAS u32x4*)(YS + tk * 40 + vs * 8);
                *(u32x4*)(YR + (size_t)(m0 + 32 * t0 + tk) * 512 + h * 64 + 32 * t1 + 8 * vs) = w; }
        }
        __syncthreads();
      }
    }
    if ((DBG_SKIP) & 1024) { for (int i = tid; i < T * 64; i += NTHR) YR[(size_t)(b * T + (i >> 6)) * 512 + h * 64 + (i & 63)] = (bf16_t)0; }
    (void)acc;
#undef CS_LOAD
}

__device__ __forceinline__ void rwkv_post2_phase(Frame& F, const Args& A) {
    F.tid = fresh_tid(); F.lane = F.tid & 63;
    const int gw = F.vcu * NWAVES + F.wave, NGW = F.G * NWAVES, lane = F.lane;
    const bf16_t* P1 = (const bf16_t*)(F.ws + WS_P1); const float* WAG = (const float*)(F.ws + WS_WAG); const bf16_t* YR = (const bf16_t*)(F.ws + WS_YRAW); bf16_t* YC = (bf16_t*)(F.ws + WS_YC1); const float* BON = (const float*)(F.ws + WS_BON);
    const float* mu = A.in[16];
    const int hq = gw & 1, hd = hq * 4 + (lane >> 4), hc = hd * 64 + (lane & 15) * 4;
    const f32x4 muv = *(const f32x4*)(mu + R_V + hc), lg = *(const f32x4*)(A.in[25] + hc), lb = *(const f32x4*)(A.in[26] + hc);
#define UNP4(dst, w) do { dst[0] = bflo((w).x); dst[1] = bfhi((w).x); dst[2] = bflo((w).y); dst[3] = bfhi((w).y); } while (0)
    for (int it0 = gw; it0 < M * 2; it0 += 2 * NGW) {
        u32x2 cv[2], pv[2], yw[2]; f32x4 g4[2]; float bo[2]; int mm[2]; bool ok[2];
#pragma unroll
        for (int j = 0; j < 2; ++j) { const int it = it0 + j * NGW; ok[j] = it < M * 2; const int m = ok[j] ? (it >> 1) : 0; mm[j] = m; const bf16_t* rp = P1 + (size_t)m * N1P; const bool hp = (m % T) > 0;
            cv[j] = *(const u32x2*)(rp + R_V + hc); pv[j] = hp ? *(const u32x2*)(rp - N1P + R_V + hc) : (u32x2){0u, 0u};
            { const u32x2 gb = *(const u32x2*)((const unsigned char*)(WAG + (size_t)2 * M * 512) + (size_t)m * 1024 + hc * 2); g4[j] = (f32x4){bflo(gb.x), bfhi(gb.x), bflo(gb.y), bfhi(gb.y)}; } yw[j] = ((DBG_SKIP) & 256) ? (u32x2){0u, 0u} : *(const u32x2*)(YR + (size_t)m * 512 + hc); bo[j] = ((DBG_SKIP) & 128) ? 0.f : BON[(size_t)m * 8 + hd]; }
#pragma unroll
        for (int j = 0; j < 2; ++j) { f32x4 v, v0, y; UNP4(v, cv[j]); UNP4(v0, pv[j]); UNP4(y, yw[j]);
            v = v + (v0 - v) * muv;
            const float mean = dpp_sum16((y[0] + y[1]) + (y[2] + y[3])) * (1.0f / 64.0f); const f32x4 d = y - mean;
            const float var = dpp_sum16((d[0] * d[0] + d[1] * d[1]) + (d[2] * d[2] + d[3] * d[3])) * (1.0f / 64.0f); const float rstd = rsqrtf(var + 64e-5f);
            const f32x4 o = (d * rstd * lg + lb + v * bo[j]) * g4[j];
            if (ok[j]) { u32x2 w; w.x = cvt_pk_bf16(o[0], o[1]); w.y = cvt_pk_bf16(o[2], o[3]); *(u32x2*)(YC + (size_t)mm[j] * D + hc) = w; } }
    }
#undef UNP4
}
constexpr int N_PHASES = 19;
#ifndef MK_N_LAUNCHES
#define MK_N_LAUNCHES 1
#endif
__global__ void __launch_bounds__(NTHR, 2) trunk_fwd(Args args) {
    extern __shared__ __attribute__((aligned(16))) unsigned char lds_raw[];
    Frame F;
    F.lds = (LAS unsigned char*)lds_raw;
    F.tid = fresh_tid(); F.lane = F.tid & 63; F.wave = __builtin_amdgcn_readfirstlane(F.tid >> 6);
    F.G = gridDim.x; { const int bx = blockIdx.x; F.vcu = (F.G % 8 == 0) ? (bx % 8) * (F.G / 8) + bx / 8 : bx; }
    F.ws = args.ws; F.ctl = (unsigned*)(args.ws + WS_CTL);
    unsigned char* ws = args.ws; float* H = args.out;
    for (int u = F.tid; u < (LDS_BYTES - LDSCTL_OFF) / 4; u += NTHR) ((LAS unsigned*)(F.lds + LDSCTL_OFF))[u] = 0u;
    __syncthreads();
    const int lo = args.ph_lo, hi = args.ph_hi;
    XcdBarrier bar; bar.bar = (unsigned*)(F.ctl + CW_BAR); bar.x = 0; bar.st = nullptr;
    if (hi - lo > 1) bar = xcd_barrier_post((unsigned*)(F.ctl + CW_BAR), (volatile LAS unsigned*)(F.lds + MISC_OFF) + 8);
#ifndef DBG_SKIP
#define DBG_SKIP 0
#endif
#ifndef DBL_MASK
#define DBL_MASK 0
#endif
#define REP(k) for (int rep_ = 0; rep_ < (((DBL_MASK) >> (k)) & 1) + 1; ++rep_)
#ifndef PH_MASK
#define PH_MASK 0x7FFFF
#endif
#define IN(k) ((((PH_MASK) >> (k)) & 1) && lo <= (k) && (k) < hi)
#define SEAM(k) do { if (IN(k) && IN((k) + 1)) xcd_barrier(bar); } while (0)
    constexpr int CV_G1 = 0, CV_G3 = CV_G1 + 64 * 8 * 8, CV_G5 = CV_G3 + 128 * 8 * 11, CV_LORA = CV_G5 + 128 * 8 * 11, CV_SCAN = CV_LORA + 128 * 8 * 3, CV_P11 = CV_SCAN + 192 * 8 * 0;
    typedef pg8::u64 u64; const u64* ssq0 = (const u64*)(F.ctl + CW_SSQ0); u64* ssq1 = (u64*)(F.ctl + CW_SSQ1); u64* ssq2 = (u64*)(F.ctl + CW_SSQ2); u64* ssq3 = (u64*)(F.ctl + CW_SSQ3);

    if (IN(0)) REP(0) { if (rep_) xcd_barrier(bar); p0_prologue(F, args); } SEAM(0);
#ifdef XBAR_PROBE
    for (int xb_ = 0; xb_ < XBAR_PROBE; ++xb_) XBAR_FN(bar);
#endif
    if (IN(1)) REP(1) { if (rep_) xcd_barrier(bar);
        pg8::StaticOrder S; S.init(M, N0P, F.G, (int)blockIdx.x);
        pg8::EpiRowScale E{(bf16_t*)(ws + WS_P0), N0P, ssq0, -1, -1, 1.0f, nullptr, -1};
        pg8::gemm_phase<pg8::EpiRowScale, pg8::StaticOrder, false>(F.lds, (const bf16_t*)(ws + WS_XB), (const bf16_t*)(ws + WS_W0T), D, S, E);
        if (!rep_ && (int)blockIdx.x >= 192) { __syncthreads(); moe_convert(F, args, ((int)blockIdx.x - 192) * NWAVES + F.wave, 64 * NWAVES, CV_G1, CV_G3); }
    } SEAM(1);
    if (IN(2)) REP(2) { if (rep_) xcd_barrier(bar); conv_phase(F, args); gla_x_phase(F, args); } SEAM(2);
    if (IN(3)) REP(3) { if (rep_) xcd_barrier(bar); gla_carry_phase(F, args); } SEAM(3);
    if (IN(4)) REP(4) { if (rep_) xcd_barrier(bar); gla_z_phase(F, args); } SEAM(4);
    if (IN(5)) REP(5) { if (rep_) xcd_barrier(bar);
        pg8::StaticOrder S; S.init(M, D, F.G, (int)blockIdx.x);
        pg8::EpiResid<false> E{(const bf16_t*)(ws + WS_XB), (bf16_t*)(ws + WS_H1B), nullptr, ssq1, rep_ == 0};
        pg8::gemm_phase<pg8::EpiResid<false>, pg8::StaticOrder, false>(F.lds, (const bf16_t*)(ws + WS_YC0), (const bf16_t*)(ws + WS_WO0T), D, S, E);
    } SEAM(5);
    if (IN(6)) REP(6) { if (rep_) xcd_barrier(bar);
        pg8::StaticOrder S; S.init(M, 2 * FF, F.G, (int)blockIdx.x);
        pg8::EpiSwiGLU<false> E{(bf16_t*)(ws + WS_ACT), FF, ssq1, nullptr, nullptr};
        pg8::gemm_phase<pg8::EpiSwiGLU<false>, pg8::StaticOrder, false>(F.lds, (const bf16_t*)(ws + WS_H1B), (const bf16_t*)(ws + WS_W13T), D, S, E);
        if (!rep_ && (int)blockIdx.x >= 128) { __syncthreads(); moe_convert(F, args, ((int)blockIdx.x - 128) * NWAVES + F.wave, 128 * NWAVES, CV_G3, CV_G5); }
    } SEAM(6);
    if (IN(7)) REP(7) { if (rep_) xcd_barrier(bar);
        pg8::StaticOrder S; S.init(M, D, F.G, (int)blockIdx.x);
        pg8::EpiResid<false> E{(const bf16_t*)(ws + WS_H1B), (bf16_t*)(ws + WS_H2B), nullptr, ssq2, rep_ == 0};
        pg8::gemm_phase<pg8::EpiResid<false>, pg8::StaticOrder, false>(F.lds, (const bf16_t*)(ws + WS_ACT), (const bf16_t*)(ws + WS_W2T), FF, S, E);
    } SEAM(7);
    if (IN(8)) REP(8) { if (rep_) xcd_barrier(bar);
        pg8::StaticOrder S; S.init(M, N1P, F.G, (int)blockIdx.x);
        pg8::EpiRowScale E{(bf16_t*)(ws + WS_P1), N1P, ssq2, F_Q, F_K, C2LOG, (float*)(ws + WS_FL32), F_L};
        pg8::gemm_phase<pg8::EpiRowScale, pg8::StaticOrder, false>(F.lds, (const bf16_t*)(ws + WS_H2B), (const bf16_t*)(ws + WS_W1IN), D, S, E);
        if (!rep_ && (int)blockIdx.x >= 128) { __syncthreads(); moe_convert(F, args, ((int)blockIdx.x - 128) * NWAVES + F.wave, 128 * NWAVES, CV_G5, CV_P11); }
    } SEAM(8);
    if (IN(9)) REP(9) { if (rep_) xcd_barrier(bar); lora_prep_phase(F, args); } SEAM(9);
    if (IN(10)) REP(10) { if (rep_) xcd_barrier(bar);
        pg8::StaticOrder S; S.init(M, 1536, F.G, (int)blockIdx.x);
        pg8::EpiLora E{(float*)(ws + WS_WAG), args.in[18], args.in[20], M};
        int k256 = 256; asm volatile("" : "+s"(k256));
        pg8::gemm_phase<pg8::EpiLora, pg8::StaticOrder, false>(F.lds, (const bf16_t*)(ws + WS_ALORA), (const bf16_t*)(ws + WS_LORA), k256, S, E);
        if (!rep_ && (int)blockIdx.x >= 128) { __syncthreads(); moe_convert(F, args, ((int)blockIdx.x - 128) * NWAVES + F.wave, 128 * NWAVES, CV_LORA, CV_SCAN); }
    } SEAM(10);
    if (IN(11)) REP(11) { if (rep_) xcd_barrier(bar);
        const int half_ = (int)blockIdx.x & 1, cwi_ = ((int)blockIdx.x >> 1) * NWAVES + F.wave, cnw_ = (F.G / 2) * NWAVES;
        if (half_) { moe_convert(F, args, 2 * cwi_ + 1, 2 * cnw_, CV_P11); __syncthreads(); }
        rwkv_pre_phase(F, args);
        __syncthreads();
        { const attn_body::AttnTensors AT{(const attn_body::bf16*)(ws + WS_P1) + F_Q, (const attn_body::bf16*)(ws + WS_P1) + F_K, (const attn_body::bf16*)(ws + WS_P1) + F_V, (attn_body::bf16*)(ws + WS_YC1) + 512, (const unsigned long long*)(ws + WS_CAUG)};
          const attn_body::StaticOrder S(256, (int)F.vcu);
          attn_body::attn_phase<attn_body::StaticOrder, 32>((char*)lds_raw, AT, S); }
        __syncthreads();
        if (!half_) moe_convert(F, args, 2 * cwi_, 2 * cnw_, CV_P11);
    } SEAM(11);
    if (IN(12)) REP(12) { if (rep_) xcd_barrier(bar); if (blockIdx.x < 64) rwkv_cscan_phase(F, args, (int)blockIdx.x, rep_); else if (!rep_) moe_convert(F, args, ((int)blockIdx.x - 64) * NWAVES + F.wave, 192 * NWAVES, CV_SCAN, CV_P11); } SEAM(12);
    if (IN(13)) REP(13) { if (rep_) xcd_barrier(bar); rwkv_post2_phase(F, args); } SEAM(13);
    if (IN(14)) REP(14) { if (rep_) xcd_barrier(bar);
        pg8::StaticOrder S; S.init(M, D, F.G, (int)blockIdx.x);
        pg8::EpiResid<true> E{(const bf16_t*)(ws + WS_H2B), (bf16_t*)(ws + WS_H3), ws + WS_H3B, ssq3, rep_ == 0};
        pg8::gemm_phase<pg8::EpiResid<true>, pg8::StaticOrder, false>(F.lds, (const bf16_t*)(ws + WS_YC1), (const bf16_t*)(ws + WS_WO1T), D, S, E);
    } SEAM(14);
    if (IN(15)) REP(15) { if (rep_) xcd_barrier(bar); router_phase(F, args, (const bf16_t*)(ws + WS_H3)); } SEAM(15);
    if (IN(16)) REP(16) { if (rep_) xcd_barrier(bar);
        MoeOrder S; { const unsigned* cp = F.ctl + CW_CNT; for (int e = 0; e < 8; ++e) S.cn[e] = __builtin_amdgcn_readfirstlane((int)cp[e]); } S.NT = 2 * FE / 256; S.G = F.G; S.c = (int)blockIdx.x; S.down = false; S.kdiv = 2; S.lists = (const int*)(ws + WS_LIST); S.glists = (const float*)(ws + WS_GLIST);
        pg8::EpiSwiGLU<true, true> E{(bf16_t*)(ws + WS_ACTE), FE, ssq3, (const float*)(ws + WS_RLIST), (const int*)(ws + WS_LIST)};
        pg8::gemm_phase<pg8::EpiSwiGLU<true, true>, MoeOrder, true, true>(F.lds, (const bf16_t*)(ws + WS_H3B), (const bf16_t*)(ws + WS_WE13T), D / 2, S, E);
    } SEAM(16);
    if (IN(17)) REP(17) { if (rep_) xcd_barrier(bar);
        MoeOrder S; { const unsigned* cp = F.ctl + CW_CNT; for (int e = 0; e < 8; ++e) S.cn[e] = __builtin_amdgcn_readfirstlane((int)cp[e]); } S.NT = D / 256; S.G = F.G; S.c = (int)blockIdx.x; S.down = true; S.kdiv = 2; S.lists = (const int*)(ws + WS_LIST); S.glists = (const float*)(ws + WS_GLIST);
        pg8::EpiMoeDown E{(bf16_t*)(ws + WS_OUTS), (bf16_t*)(ws + WS_OUTP), S.split_tail() ? S.tail_row0() : 0, MOE_TAIL_ROWS, 1.0f / (pg8::Q8_ACT * pg8::Q8_W)};
        pg8::gemm_phase<pg8::EpiMoeDown, MoeOrder, false, true>(F.lds, (const bf16_t*)(ws + WS_ACTE), (const bf16_t*)(ws + WS_WE2T), FE / 2, S, E);
    } SEAM(17);
    if (IN(18)) REP(18) { if (rep_) xcd_barrier(bar); final_phase(F, args, (const bf16_t*)(ws + WS_H3), H); }
#undef IN
#undef SEAM
}

extern "C" void kernel_launch(void* const* d_in, const int* in_sizes, int n_in, void* d_out, int out_size, void* d_ws, size_t ws_size, hipStream_t stream) {
    static int grid = 0;
    if (grid == 0) {
        if (n_in != 34 || out_size != M * D || ws_size < WS_END) { fprintf(stderr, "kernel_launch: unexpected problem (n_in %d out %d ws %zu need %zu)\n", n_in, out_size, ws_size, (size_t)WS_END); grid = -1; return; }
        int dev = 0, cus = 0, per_cu = 0;
        if (hipGetDevice(&dev) != hipSuccess || hipDeviceGetAttribute(&cus, hipDeviceAttributeMultiprocessorCount, dev) != hipSuccess) { grid = -1; return; }
        if (hipFuncSetAttribute((const void*)trunk_fwd, hipFuncAttributeMaxDynamicSharedMemorySize, LDS_BYTES) != hipSuccess) { fprintf(stderr, "kernel_launch: hipFuncSetAttribute failed\n"); grid = -1; return; }
        if (hipOccupancyMaxActiveBlocksPerMultiprocessor(&per_cu, (const void*)trunk_fwd, NTHR, LDS_BYTES) != hipSuccess || per_cu < 1) fprintf(stderr, "kernel_launch: occupancy query reports %d\n", per_cu);
        (void)hipGetLastError();
        grid = 256;
        if (cus < 256) { fprintf(stderr, "kernel_launch: device has %d CUs, need 256\n", cus); grid = -1; return; }
    }
    if (grid < 0) return;
    (void)in_sizes;
    (void)hipMemsetAsync((char*)d_ws + WS_CTL, 0, CTL_BYTES, stream);
    Args a{};
    for (int i = 0; i < 34; ++i) a.in[i] = (const float*)d_in[i];
    a.out = (float*)d_out; a.ws = (unsigned char*)d_ws;
    for (int li = 0; li < MK_N_LAUNCHES; ++li) {
        a.ph_lo = (MK_N_LAUNCHES == 1) ? 0 : li; a.ph_hi = (MK_N_LAUNCHES == 1) ? N_PHASES : li + 1;
        hipLaunchKernelGGL(trunk_fwd, dim3(grid), dim3(NTHR), LDS_BYTES, stream, a);
    }
}
```

```cpp
#include <hip/hip_runtime.h>
#include <hip/hip_bf16.h>
#include <cstdio>
#include <cstdint>
#include <cmath>

#define LAS __attribute__((address_space(3)))
#define GAS __attribute__((address_space(1)))
typedef unsigned short bf16_t;
typedef short bf16x8 __attribute__((ext_vector_type(8)));
typedef float f32x4 __attribute__((ext_vector_type(4)));
typedef float f32x2 __attribute__((ext_vector_type(2)));
typedef unsigned u32x4 __attribute__((ext_vector_type(4)));
typedef unsigned u32x2 __attribute__((ext_vector_type(2)));
typedef float f32x16 __attribute__((ext_vector_type(16)));
typedef int v8i32 __attribute__((ext_vector_type(8)));
__device__ __forceinline__ unsigned pk_fp8x4(float a, float b, float c, float d) { a = fminf(fmaxf(a, -448.f), 448.f); b = fminf(fmaxf(b, -448.f), 448.f); c = fminf(fmaxf(c, -448.f), 448.f); d = fminf(fmaxf(d, -448.f), 448.f);
    int w = __builtin_amdgcn_cvt_pk_fp8_f32(a, b, 0, false); w = __builtin_amdgcn_cvt_pk_fp8_f32(c, d, w, true); return (unsigned)w; }

__device__ __forceinline__ unsigned cvt_pk_bf16(float lo, float hi) { unsigned r; asm volatile("v_cvt_pk_bf16_f32 %0, %1, %2" : "=v"(r) : "v"(lo), "v"(hi)); return r; }
__device__ __forceinline__ float bf2f(bf16_t b) { return __uint_as_float(((unsigned)b) << 16); }
__device__ __forceinline__ float bflo(unsigned w) { return __uint_as_float(w << 16); }
__device__ __forceinline__ float bfhi(unsigned w) { return __uint_as_float(w & 0xffff0000u); }
__device__ __forceinline__ unsigned f2bf(float f) { unsigned u = __float_as_uint(f); return (u + 0x7fffu + ((u >> 16) & 1u)) >> 16; }
__device__ __forceinline__ unsigned pk2(float lo, float hi) { return f2bf(lo) | (f2bf(hi) << 16); }
__device__ __forceinline__ float sigmoidf_(float x) { return __builtin_amdgcn_rcpf(1.0f + __expf(-x)); }
__device__ __forceinline__ float siluf_(float x) { return x * __builtin_amdgcn_rcpf(1.0f + __expf(-x)); }
__device__ __forceinline__ float logsigmoidf_(float x) { return fminf(x, 0.f) - log1pf(__expf(-fabsf(x))); }
__device__ __forceinline__ int fresh_tid() { int t = (int)threadIdx.x; asm volatile("" : "+v"(t)); return t; }
__device__ __forceinline__ float rows_sum(float v) {
    { const auto r = __builtin_amdgcn_permlane16_swap(__float_as_uint(v), __float_as_uint(v), false, false); v = __uint_as_float(r[0]) + __uint_as_float(r[1]); }
    { const auto r = __builtin_amdgcn_permlane32_swap(__float_as_uint(v), __float_as_uint(v), false, false); v = __uint_as_float(r[0]) + __uint_as_float(r[1]); }
    return v;
}
__device__ __forceinline__ float wave_sum(float v) {
    v += __int_as_float(__builtin_amdgcn_update_dpp(0, __float_as_int(v), 0xB1, 0xF, 0xF, false));
    v += __int_as_float(__builtin_amdgcn_update_dpp(0, __float_as_int(v), 0x4E, 0xF, 0xF, false));
    v += __int_as_float(__builtin_amdgcn_update_dpp(0, __float_as_int(v), 0x141, 0xF, 0xF, false));
    v += __int_as_float(__builtin_amdgcn_update_dpp(0, __float_as_int(v), 0x140, 0xF, 0xF, false));
    return rows_sum(v);
}

#define WT_RSRC(p) __builtin_amdgcn_make_buffer_rsrc((void*)(p), 0, 0x7fffffff, 0x27000)
__device__ __forceinline__ void wt_store16(__amdgpu_buffer_rsrc_t r, unsigned off, u32x4 v) { __builtin_amdgcn_raw_buffer_store_b128(v, r, (int)off, 0, 16); }
__device__ __forceinline__ void wt_store8(__amdgpu_buffer_rsrc_t r, unsigned off, u32x2 v) { __builtin_amdgcn_raw_buffer_store_b64(v, r, (int)off, 0, 16); }
namespace pg8 {
constexpr int BM = 256, BK = 64, HALF = 128, HTB = HALF * BK * 2, STAGE_BYTES = 8 * HTB, NXCD = 8, WGM = 8;
__host__ __device__ __forceinline__ int lds_byte(int r, int c) { const int st = (r >> 4) * 2 + (c >> 5), rr = r & 15, cc = c & 31, ob = rr * 64 + cc * 2; return st * 1024 + (ob ^ (((ob >> 9) & 1) << 5)); }
__host__ __device__ __forceinline__ void stage_rc(int b, int& R, int& C) { const int st = b / 1024, sb = b % 1024, swz = sb ^ (((sb >> 9) & 1) << 5); R = (st >> 1) * 16 + swz / 64; C = (st & 1) * 32 + (swz % 64) / 2; }
__host__ __device__ __forceinline__ int perm32(int rho) { const int n = rho >> 4, i = rho & 15; return 8 * (i >> 2) + 4 * n + (i & 3); }

struct Unit { int arow; int brow; int orow; int ocol; int nrows; int ex; const int* rows; int koff; int nt; };

struct StaticOrder {
    int nM, nN, nwg, G, c;
    __device__ void init(int M, int N, int G_, int c_) { nM = M / BM; nN = N / BM; nwg = nM * nN; G = G_; c = c_; }
    __device__ bool next(int i, Unit& u) const {
        const long L = (long)i * G + c; if (L >= nwg) return false;
        int wgid = (int)L; { const int q = nwg / NXCD, r = nwg % NXCD, xcd = wgid % NXCD, off = wgid / NXCD; wgid = (xcd < r ? xcd * (q + 1) : r * (q + 1) + (xcd - r) * q) + off; }
        const int nig = WGM * nN, gid = wgid / nig, fm = gid * WGM, gsz = (nM - fm) < WGM ? (nM - fm) : WGM;
        const int pm = fm + ((wgid % nig) % gsz), pn = (wgid % nig) / gsz;
        u.arow = pm * BM; u.brow = pn * BM; u.orow = pm * BM; u.ocol = pn * BM; u.nrows = BM; u.ex = 0; u.rows = nullptr; u.koff = 0; u.nt = 0; return true;
    }
};

template <class Epi, class Sched, bool GATHER, bool FP8 = false>
__device__ __forceinline__ void gemm_phase(LAS unsigned char* lds, const bf16_t* Ab, const bf16_t* Btb, const int K, const Sched& S, const Epi& E) {
    const int tid = fresh_tid(), wid = __builtin_amdgcn_readfirstlane(tid >> 6), lane = tid & 63, wr = wid >> 2, wc = wid & 3, fr = lane & 15, fq = lane >> 4;
    const int nt = K / BK;
    int Rs[2], Cs[2]; unsigned voffB[2];
#pragma unroll
    for (int i = 0; i < 2; ++i) { int R, C; stage_rc(tid * 16 + i * 8192, R, C); const int Rb = Epi::PERM ? ((R & ~31) + perm32(R & 31)) : R; Rs[i] = R; Cs[i] = C; voffB[i] = (unsigned)(Rb * K + C) * 2u; }
    const size_t kstep = (size_t)(BK * 2);
    const size_t hstep = (size_t)HALF * K * 2;
    const unsigned ldsw = (unsigned)wid * 1024u;
    const int aoff = lds_byte(wr * 64 + fr, fq * 8), boff = lds_byte(wc * 32 + fr, fq * 8);
#define PG8_SA(b, h) (((b) * 2 + (h)) * HTB)
#define PG8_SB(b, h) ((4 + (b) * 2 + (h)) * HTB)
#define PG8_STAGE(bufoff, gbase, voff) do { _Pragma("unroll") for (int _i = 0; _i < 2; ++_i) \
        __builtin_amdgcn_global_load_lds((const unsigned*)((const char*)(gbase) + (voff)[_i]), (LAS unsigned*)(lds + (bufoff) + ldsw + _i * 8192), 16, 0, 0); } while (0)
#define PG8_LD8(dst, idx, addr0, addr1) do { const u32x4 lo_ = *(const LAS u32x4*)(addr0), hi_ = *(const LAS u32x4*)(addr1); dst[idx] = (v8i32){(int)lo_[0], (int)lo_[1], (int)lo_[2], (int)lo_[3], (int)hi_[0], (int)hi_[1], (int)hi_[2], (int)hi_[3]}; } while (0)
#define PG8_LDA(dst, b, h) do { if constexpr (FP8) { _Pragma("unroll") for (int m = 0; m < 4; ++m) PG8_LD8(dst##8, m, lds + PG8_SA(b, h) + aoff + m * 2048, lds + PG8_SA(b, h) + aoff + m * 2048 + 1024); } \
        else { _Pragma("unroll") for (int m = 0; m < 4; ++m) _Pragma("unroll") for (int k = 0; k < 2; ++k) dst[m][k] = *(const LAS bf16x8*)(lds + PG8_SA(b, h) + aoff + m * 2048 + k * 1024); } } while (0)
#define PG8_LDB(dst, b, h) do { if constexpr (FP8) { _Pragma("unroll") for (int n = 0; n < 2; ++n) PG8_LD8(dst##8, n, lds + PG8_SB(b, h) + boff + n * 2048, lds + PG8_SB(b, h) + boff + n * 2048 + 1024); } \
        else { _Pragma("unroll") for (int n = 0; n < 2; ++n) _Pragma("unroll") for (int k = 0; k < 2; ++k) dst[n][k] = *(const LAS bf16x8*)(lds + PG8_SB(b, h) + boff + n * 2048 + k * 1024); } } while (0)
#define PG8_MMA(ai, bj, At, Bt) do { __builtin_amdgcn_s_setprio(1); \
        if constexpr (FP8) { _Pragma("unroll") for (int m = 0; m < 4; ++m) _Pragma("unroll") for (int n = 0; n < 2; ++n) \
            asm volatile("v_mfma_scale_f32_16x16x128_f8f6f4 %0, %1, %2, %0, %3, %3 op_sel_hi:[0,0,0]" : "+v"(acc[ai][bj][m][n]) : "v"(Bt##8[n]), "v"(At##8[m]), "v"(one8)); } \
        else { _Pragma("unroll") for (int m = 0; m < 4; ++m) _Pragma("unroll") for (int n = 0; n < 2; ++n) _Pragma("unroll") for (int k = 0; k < 2; ++k) \
            acc[ai][bj][m][n] = __builtin_amdgcn_mfma_f32_16x16x32_bf16(Bt[n][k], At[m][k], acc[ai][bj][m][n], 0, 0, 0); } \
        __builtin_amdgcn_s_setprio(0); } while (0)
#define PG8_WAIT_V(n) asm volatile("s_waitcnt vmcnt(" #n ")" ::: "memory")
#define PG8_WAIT_L(n) asm volatile("s_waitcnt lgkmcnt(" #n ")" ::: "memory")
#define PG8_BAR __builtin_amdgcn_s_barrier()
#define PG8_SCHED __builtin_amdgcn_sched_barrier(0)
#define PG8_UNIT_A(u, base, vA) do { if constexpr (GATHER) { base = (const char*)Ab + (size_t)(u).koff * 2; \
            _Pragma("unroll") for (int _h = 0; _h < 2; ++_h) _Pragma("unroll") for (int _i = 0; _i < 2; ++_i) { const int _r = _h * HALF + Rs[_i]; const int _row = (u).rows[_r < (u).nrows ? _r : (u).nrows - 1]; vA[_h][_i] = (unsigned)(_row * K + Cs[_i]) * 2u; } } \
        else { base = (const char*)Ab + ((size_t)(u).arow * K + (u).koff) * 2; \
            _Pragma("unroll") for (int _h = 0; _h < 2; ++_h) _Pragma("unroll") for (int _i = 0; _i < 2; ++_i) vA[_h][_i] = (unsigned)((_h * HALF + Rs[_i]) * K + Cs[_i]) * 2u; } } while (0)
    Unit cur, nxt; int ui = 0;
    if (!S.next(0, cur)) return;
    f32x4 acc[2][2][4][2];
#pragma unroll
    for (int a = 0; a < 2; ++a)
#pragma unroll
        for (int b = 0; b < 2; ++b)
#pragma unroll
            for (int m = 0; m < 4; ++m)
#pragma unroll
                for (int n = 0; n < 2; ++n) acc[a][b][m][n] = (f32x4){0.f, 0.f, 0.f, 0.f};
    const int one8 = 0x7F7F7F7F;
    bf16x8 At[4][2], B0[2][2], B1[2][2]; v8i32 At8[4], B08[2], B18[2];
    const char* cA; unsigned vAc[2][2], vAn[2][2];
    PG8_UNIT_A(cur, cA, vAc);
    const char* cB = (const char*)Btb + ((size_t)cur.brow * K + cur.koff) * 2;
    typename Epi::Pre pre = E.prefetch(cur, wr, fr);
    PG8_STAGE(PG8_SB(0, 0), cB, voffB); PG8_STAGE(PG8_SB(0, 1), cB + hstep, voffB); PG8_STAGE(PG8_SA(0, 0), cA, vAc[0]); PG8_STAGE(PG8_SA(0, 1), cA, vAc[1]);
    if (wr == 1) PG8_BAR;
    PG8_WAIT_V(2); PG8_BAR;
    PG8_STAGE(PG8_SB(1, 0), cB + kstep, voffB); PG8_STAGE(PG8_SA(1, 0), cA + kstep, vAc[0]); PG8_STAGE(PG8_SB(1, 1), cB + hstep + kstep, voffB);
    PG8_WAIT_V(6); PG8_BAR;
    for (;;) {
        const bool has_next = S.next(ui + 1, nxt);
        const char* nA = cA; const char* nB = cB;
#pragma unroll
        for (int h = 0; h < 2; ++h)
#pragma unroll
            for (int i = 0; i < 2; ++i) vAn[h][i] = vAc[h][i];
        if (has_next) { PG8_UNIT_A(nxt, nA, vAn); nB = (const char*)Btb + ((size_t)nxt.brow * K + nxt.koff) * 2; }
        const int ntc = cur.nt ? cur.nt : nt;
        for (int t = 0; t < ntc; t += 2) {
            const bool last = (t == ntc - 2);
            const char* a1 = cA + (size_t)(t + 1) * kstep;
            const char* a2 = last ? nA : cA + (size_t)(t + 2) * kstep; const char* b2 = last ? nB : cB + (size_t)(t + 2) * kstep;
            const char* a3 = a2 + kstep; const char* b3 = b2 + kstep;
            unsigned vs0[2], vs1[2];
#pragma unroll
            for (int i = 0; i < 2; ++i) { vs0[i] = last ? vAn[0][i] : vAc[0][i]; vs1[i] = last ? vAn[1][i] : vAc[1][i]; }
            PG8_LDB(B0, 0, 0); PG8_LDB(B1, 0, 1); PG8_SCHED; PG8_LDA(At, 0, 0); PG8_STAGE(PG8_SA(1, 1), a1, vAc[1]);
            PG8_WAIT_V(8); PG8_WAIT_L(0); PG8_BAR; PG8_MMA(0, 0, At, B0); PG8_MMA(0, 1, At, B1); PG8_BAR; PG8_SCHED;
            PG8_LDA(At, 0, 1); PG8_STAGE(PG8_SB(0, 0), b2, voffB); PG8_STAGE(PG8_SB(0, 1), b2 + hstep, voffB); PG8_STAGE(PG8_SA(0, 0), a2, vs0);
            PG8_WAIT_V(8); PG8_WAIT_L(0); PG8_BAR; PG8_MMA(1, 0, At, B0); PG8_MMA(1, 1, At, B1); PG8_BAR; PG8_SCHED;
            PG8_LDB(B0, 1, 0); PG8_LDB(B1, 1, 1); PG8_SCHED; PG8_LDA(At, 1, 0); PG8_STAGE(PG8_SA(0, 1), a2, vs1);
            PG8_WAIT_V(8); PG8_WAIT_L(0); PG8_BAR; PG8_MMA(0, 0, At, B0); PG8_MMA(0, 1, At, B1); PG8_BAR; PG8_SCHED;
            PG8_LDA(At, 1, 1); PG8_STAGE(PG8_SB(1, 0), b3, voffB); PG8_STAGE(PG8_SB(1, 1), b3 + hstep, voffB); PG8_STAGE(PG8_SA(1, 0), a3, vs0);
            PG8_WAIT_V(8); PG8_WAIT_L(0); PG8_BAR; PG8_MMA(1, 0, At, B0); PG8_MMA(1, 1, At, B1); PG8_BAR; PG8_SCHED;
        }
        if constexpr (FP8) asm volatile("s_nop 15\n\ts_nop 7" ::: "memory");
        if (wr == 0) PG8_BAR;
        E(acc, cur, wr, wc, fr, fq, pre);
        if (!has_next) break;
#pragma unroll
        for (int a = 0; a < 2; ++a)
#pragma unroll
            for (int b = 0; b < 2; ++b)
#pragma unroll
                for (int m = 0; m < 4; ++m)
#pragma unroll
                    for (int n = 0; n < 2; ++n) acc[a][b][m][n] = (f32x4){0.f, 0.f, 0.f, 0.f};
        cur = nxt; cA = nA; cB = nB; ++ui;
        pre = E.prefetch(cur, wr, fr);
#pragma unroll
        for (int h = 0; h < 2; ++h)
#pragma unroll
            for (int i = 0; i < 2; ++i) vAc[h][i] = vAn[h][i];
        if (wr == 1) PG8_BAR;
    }
    PG8_WAIT_V(0);
    PG8_BAR;
#undef PG8_SA
#undef PG8_SB
#undef PG8_STAGE
#undef PG8_LD8
#undef PG8_LDA
#undef PG8_LDB
#undef PG8_MMA
#undef PG8_WAIT_V
#undef PG8_WAIT_L
#undef PG8_BAR
#undef PG8_SCHED
#undef PG8_UNIT_A
}
}
namespace pg8 {
constexpr float NORM_EPS = 1e-6f;
typedef unsigned u64;
constexpr float SSQ_SCALE = 1024.0f;
struct PreNone {}; struct PreU64 { u64 v[2][4]; }; struct PreF32 { float v[2][4]; };
__device__ __forceinline__ float rs_from(u64 v) { return rsqrtf((float)v * (1.0f / (1024.0f * 1024.0f)) + NORM_EPS); }
struct EpiRowScale {
    static constexpr bool PERM = true;
    bf16_t* O; int ldc; const u64* ssq; int q_lo, q_hi; float qscale; float* side; int side_col;
    typedef PreU64 Pre;
    __device__ __forceinline__ Pre prefetch(const Unit& u, int wr, int fr) const { Pre p; const int row0 = u.orow + wr * 64 + fr;
#pragma unroll
        for (int ai = 0; ai < 2; ++ai)
#pragma unroll
            for (int m = 0; m < 4; ++m) p.v[ai][m] = ssq[row0 + ai * HALF + m * 16];
        return p; }
    __device__ __forceinline__ void operator()(const f32x4 (&acc)[2][2][4][2], const Unit& u, int wr, int wc, int fr, int fq, const Pre& pre) const {
        const int row0 = u.orow + wr * 64 + fr, col0 = u.ocol + wc * 32 + 8 * fq;
        const float cs = (u.ocol >= q_lo && u.ocol < q_hi) ? qscale : 1.0f;
        const bool do_side = (side != nullptr) && (u.ocol == side_col) && (wc == 0) && (fq == 0);
        const __amdgpu_buffer_rsrc_t orsrc = WT_RSRC(O);
#pragma unroll
        for (int ai = 0; ai < 2; ++ai)
#pragma unroll
            for (int m = 0; m < 4; ++m) { const int row = row0 + ai * HALF + m * 16; const float rs = rs_from(pre.v[ai][m]) * cs;
                const unsigned rowo = (unsigned)(((size_t)row * ldc + col0) * 2);
#pragma unroll
                for (int bj = 0; bj < 2; ++bj) { const f32x4 v0 = acc[ai][bj][m][0] * rs, v1 = acc[ai][bj][m][1] * rs;
                    u32x4 w; w.x = cvt_pk_bf16(v0[0], v0[1]); w.y = cvt_pk_bf16(v0[2], v0[3]); w.z = cvt_pk_bf16(v1[0], v1[1]); w.w = cvt_pk_bf16(v1[2], v1[3]);
                    wt_store16(orsrc, rowo + bj * HALF * 2, w);
                    if (bj == 0 && do_side) { *(f32x4*)(side + (size_t)row * 8) = v0; *(f32x4*)(side + (size_t)row * 8 + 4) = v1; } } }
    }
};
constexpr float Q8_H = 8.0f, Q8_W = 256.0f, Q8_ACT = 16.0f;
template <bool Q8> struct EpiResid {
    static constexpr bool PERM = false;
    const bf16_t* resid; bf16_t* Hb; unsigned char* H8; u64* ssq_out; bool do_ssq;
    typedef PreNone Pre;
    __device__ __forceinline__ Pre prefetch(const Unit&, int, int) const { return Pre{}; }
    __device__ __forceinline__ void operator()(const f32x4 (&acc)[2][2][4][2], const Unit& u, int wr, int wc, int fr, int fq, const Pre&) const {
        const int row0 = u.orow + wr * 64 + fr, col0 = u.ocol + wc * 32 + 4 * fq;
#pragma unroll
        for (int ai = 0; ai < 2; ++ai) {
            u32x2 rv[4][2][2];
#pragma unroll
            for (int m = 0; m < 4; ++m)
#pragma unroll
                for (int bj = 0; bj < 2; ++bj)
#pragma unroll
                    for (int n = 0; n < 2; ++n) rv[m][bj][n] = *(const u32x2*)(resid + (size_t)(row0 + ai * HALF + m * 16) * 1024 + col0 + bj * HALF + n * 16);
#pragma unroll
            for (int m = 0; m < 4; ++m) { const int row = row0 + ai * HALF + m * 16; const size_t off = (size_t)row * 1024 + col0; float s = 0.f;
#pragma unroll
                for (int bj = 0; bj < 2; ++bj)
#pragma unroll
                    for (int n = 0; n < 2; ++n) { const size_t o = off + bj * HALF + n * 16; const u32x2 r2 = rv[m][bj][n];
                        const f32x4 v = acc[ai][bj][m][n] + (f32x4){bflo(r2.x), bfhi(r2.x), bflo(r2.y), bfhi(r2.y)};
                        { u32x2 w; w.x = cvt_pk_bf16(v[0], v[1]); w.y = cvt_pk_bf16(v[2], v[3]); *(u32x2*)(Hb + o) = w; }
                        s += (v[0] * v[0] + v[1] * v[1]) + (v[2] * v[2] + v[3] * v[3]); }
                s = rows_sum(s);
                if (fq == 0 && do_ssq) atomicAdd(ssq_out + row, (u64)(s * SSQ_SCALE + 0.5f)); } }
    }
};
template <bool GATHER, bool Q8 = false> struct EpiSwiGLU {
    static constexpr bool PERM = true;
    bf16_t* O; int ldo; const u64* ssq; const float* rsl; const int* lists0;
    typedef PreU64 Pre;
    __device__ __forceinline__ Pre prefetch(const Unit& u, int wr, int fr) const { Pre p;
#pragma unroll
        for (int ai = 0; ai < 2; ++ai)
#pragma unroll
            for (int m = 0; m < 4; ++m) { const int r = ai * HALF + wr * 64 + m * 16 + fr;
                if constexpr (GATHER) p.v[ai][m] = (u64)__float_as_uint(rsl[(u.rows - lists0) + (r < u.nrows ? r : u.nrows - 1)]); else p.v[ai][m] = ssq[u.orow + r]; }
        return p; }
    __device__ __forceinline__ void operator()(const f32x4 (&acc)[2][2][4][2], const Unit& u, int wr, int wc, int fr, int fq, const Pre& pre) const {
        const int col0 = (u.ocol >> 1) + wc * 32 + 8 * fq;
        const __amdgpu_buffer_rsrc_t orsrc = WT_RSRC(O);
#pragma unroll
        for (int ai = 0; ai < 2; ++ai)
#pragma unroll
            for (int m = 0; m < 4; ++m) { const int r = ai * HALF + wr * 64 + m * 16 + fr;
                if (r < u.nrows) { const int orow = u.orow + r; const float rs = (GATHER ? __uint_as_float((unsigned)pre.v[ai][m]) : rs_from(pre.v[ai][m])) * (Q8 ? 1.0f / (Q8_H * Q8_W) : 1.0f);
                    const float c1 = -1.4426950408889634f * rs, ic2 = __builtin_amdgcn_rcpf(rs * rs * (Q8 ? Q8_ACT : 1.0f));
                    const f32x2 c1v = {c1, c1}, ic2v = {ic2, ic2};
                    f32x2 o[4];
#pragma unroll
                    for (int n = 0; n < 2; ++n)
#pragma unroll
                        for (int i = 0; i < 2; ++i) { const f32x4 ga = acc[ai][0][m][n], ua = acc[ai][1][m][n];
                            const f32x2 g = i ? __builtin_shufflevector(ga, ga, 2, 3) : __builtin_shufflevector(ga, ga, 0, 1), up = i ? __builtin_shufflevector(ua, ua, 2, 3) : __builtin_shufflevector(ua, ua, 0, 1);
                            const f32x2 t = g * up, x = g * c1v; f32x2 e; e.x = __builtin_amdgcn_exp2f(x.x); e.y = __builtin_amdgcn_exp2f(x.y);
                            const f32x2 d = e * ic2v + ic2v; f32x2 rr; rr.x = __builtin_amdgcn_rcpf(d.x); rr.y = __builtin_amdgcn_rcpf(d.y);
                            o[n * 2 + i] = t * rr; }
                    if constexpr (Q8) { u32x2 w; w.x = pk_fp8x4(o[0].x, o[0].y, o[1].x, o[1].y); w.y = pk_fp8x4(o[2].x, o[2].y, o[3].x, o[3].y); *(u32x2*)((unsigned char*)O + (size_t)orow * ldo + col0) = w; }
                    else { u32x4 w; w.x = cvt_pk_bf16(o[0].x, o[0].y); w.y = cvt_pk_bf16(o[1].x, o[1].y); w.z = cvt_pk_bf16(o[2].x, o[2].y); w.w = cvt_pk_bf16(o[3].x, o[3].y);
                        wt_store16(orsrc, (unsigned)(((size_t)orow * ldo + col0) * 2), w); } } }
    }
};
struct EpiMoeDown {
    static constexpr bool PERM = true;
    bf16_t* O; bf16_t* OP; int tail_row0; int tail_rows; float oscale;
    typedef PreF32 Pre;
    __device__ __forceinline__ Pre prefetch(const Unit& u, int wr, int fr) const { Pre p; const float* gl = (const float*)u.rows;
#pragma unroll
        for (int ai = 0; ai < 2; ++ai)
#pragma unroll
            for (int m = 0; m < 4; ++m) { const int r = ai * HALF + wr * 64 + m * 16 + fr; p.v[ai][m] = gl[r < u.nrows ? r : u.nrows - 1]; }
        return p; }
    __device__ __forceinline__ void operator()(const f32x4 (&acc)[2][2][4][2], const Unit& u, int wr, int wc, int fr, int fq, const Pre& pre) const {
        asm volatile("" : "+v"(fr), "+v"(fq));
        const int col0 = u.ocol + wc * 32 + 8 * fq;
        bf16_t* base = (u.ex == 0) ? O + (size_t)u.orow * 1024 : OP + ((size_t)(u.ex - 1) * tail_rows + (u.orow - tail_row0)) * 1024;
        const __amdgpu_buffer_rsrc_t orsrc = WT_RSRC(base);
#pragma unroll
        for (int ai = 0; ai < 2; ++ai)
#pragma unroll
            for (int m = 0; m < 4; ++m) { const int r = ai * HALF + wr * 64 + m * 16 + fr;
                if (r < u.nrows) { const float gs = pre.v[ai][m] * oscale; const unsigned rowo = (unsigned)(((size_t)r * 1024 + col0) * 2);
#pragma unroll
                    for (int bj = 0; bj < 2; ++bj) { const f32x4 v0 = acc[ai][bj][m][0] * gs, v1 = acc[ai][bj][m][1] * gs;
                        u32x4 w; w.x = cvt_pk_bf16(v0[0], v0[1]); w.y = cvt_pk_bf16(v0[2], v0[3]); w.z = cvt_pk_bf16(v1[0], v1[1]); w.w = cvt_pk_bf16(v1[2], v1[3]);
                        wt_store16(orsrc, rowo + bj * HALF * 2, w); } } }
    }
};
struct EpiLora {
    static constexpr bool PERM = false;
    float* WAG; const float* w0; const float* a0; int M;
    typedef PreNone Pre;
    __device__ __forceinline__ Pre prefetch(const Unit&, int, int) const { return Pre{}; }
    __device__ __forceinline__ void operator()(const f32x4 (&acc)[2][2][4][2], const Unit& u, int wr, int wc, int fr, int fq, const Pre&) const {
        const int type = u.ocol >> 9, colt = (u.ocol & 511) + wc * 32 + 4 * fq, row0 = u.orow + wr * 64 + fr;
        float* base = WAG + (size_t)type * M * 512;
        const __amdgpu_buffer_rsrc_t orsrc = WT_RSRC(base);
        f32x4 bv[2][2];
#pragma unroll
        for (int bj = 0; bj < 2; ++bj)
#pragma unroll
            for (int n = 0; n < 2; ++n) { const int c = colt + bj * HALF + n * 16; bv[bj][n] = type == 0 ? *(const f32x4*)(w0 + c) : (type == 1 ? *(const f32x4*)(a0 + c) : (f32x4){0.f, 0.f, 0.f, 0.f}); }
#pragma unroll
        for (int ai = 0; ai < 2; ++ai)
#pragma unroll
            for (int m = 0; m < 4; ++m) { const int row = row0 + ai * HALF + m * 16;
#pragma unroll
                for (int bj = 0; bj < 2; ++bj)
#pragma unroll
                    for (int n = 0; n < 2; ++n) { f32x4 v = acc[ai][bj][m][n] + bv[bj][n];
                        if (type == 0) {
#pragma unroll
                            for (int i = 0; i < 4; ++i) v[i] = -0.606531f * __builtin_amdgcn_rcpf(1.0f + __expf(-v[i])); }
                        else if (type == 1) {
#pragma unroll
                            for (int i = 0; i < 4; ++i) v[i] = __builtin_amdgcn_rcpf(1.0f + __expf(-v[i])); }
                        wt_store16(orsrc, (unsigned)(((size_t)row * 512 + colt + bj * HALF + n * 16) * 4), __builtin_bit_cast(u32x4, v)); } }
    }
};
}
#ifndef DBL_MASK
#define DBL_MASK 0
#endif
#ifndef DBG_SKIP
#define DBG_SKIP 0
#endif
constexpr int NB = 8, T = 2048, M = NB * T, D = 1024;
constexpr int N0 = 2576, N0P = 2816;
constexpr int C_VAL = 0, C_GATE = 512, C_GQ = 1024, C_GK = 1280, C_GV = 1536, C_GG = 2048, C_ALR = 2560;
constexpr int N1 = 3336, N1P = 3584;
constexpr int R_R = 0, R_K = 512, R_V = 1024, R_XW = 1536, R_XA = 1600, R_XG = 1664, F_Q = 1792, F_K = 2304, F_V = 2816, F_L = 3328;
constexpr int FF = 2816, FE = 3584, NE = 8;
constexpr float C2LOG = 0.125f * 1.4426950408889634f;
constexpr int NWAVES = 8, NTHR = 512;

constexpr size_t WS_CTL = 0, CTL_BYTES = 1u << 20;
constexpr size_t WS_WO1T = CTL_BYTES;
constexpr size_t WS_W0T = WS_WO1T + (size_t)D * D * 2;
constexpr size_t WS_WO0T = WS_W0T + (size_t)N0P * D * 2;
constexpr size_t WS_W13T = WS_WO0T + (size_t)D * D * 2;
constexpr size_t WS_W2T = WS_W13T + (size_t)2 * FF * D * 2;
constexpr size_t WS_W1IN = WS_W2T + (size_t)D * FF * 2;
constexpr size_t WS_LORA = WS_W1IN + (size_t)N1P * D * 2;
constexpr size_t WS_WE13T = WS_LORA + (size_t)1536 * 256 * 2;
constexpr size_t WS_WE2T = WS_WE13T + (size_t)NE * 2 * FE * D * 2;
constexpr size_t RB = WS_WE2T + (size_t)NE * D * FE * 2;
constexpr size_t MB335 = (size_t)M * D * 2;
constexpr size_t WS_XB = RB;
constexpr size_t WS_P0 = RB + MB335;
constexpr size_t WS_YC0 = WS_P0 + (size_t)M * N0P * 2;
constexpr size_t WS_H1B = WS_YC0 + MB335;
constexpr size_t WS_GLT = WS_H1B + MB335;
constexpr size_t WS_GST = WS_GLT + (size_t)1024 * 8192 * 4;
constexpr size_t WS_GDEC = WS_GST + (size_t)1024 * 8192 * 2;
constexpr size_t WS_ACT = RB;
constexpr size_t WS_H2B = WS_WE13T + ((size_t)60 << 20);
static_assert((size_t)NE * 2 * FE * D <= ((size_t)60 << 20) && WS_H2B + MB335 <= WS_WE2T, "h2 fits above the fp8 up-weights");
constexpr size_t WS_H3 = WS_H1B;
constexpr size_t WS_P1 = RB;
constexpr size_t WS_FL32 = RB + (size_t)120 * 1000000;
constexpr size_t WS_CFOX = RB + (size_t)121 * 1000000;
constexpr size_t WS_BON = RB + (size_t)118 * 1000000;
constexpr size_t WS_CAUG = RB + (size_t)122 * 1000000;
constexpr size_t WS_YRAW = WS_W0T;
constexpr size_t WS_ALORA = WS_H1B;
constexpr size_t WS_WAG = WS_H1B + (size_t)M * 256 * 2;
constexpr size_t WS_YC1 = WS_YC0;
constexpr size_t WS_ACTE = RB;
constexpr size_t WS_H3B = RB + (size_t)(32768 + 256) * FE * 2;
constexpr size_t WS_LIST = WS_H3B + MB335;
constexpr size_t WS_GLIST = WS_LIST + (size_t)NE * M * 4;
constexpr size_t WS_RLIST = WS_GLIST + (size_t)NE * M * 4;
constexpr size_t WS_TOKI = WS_RLIST + (size_t)NE * M * 4;
constexpr size_t WS_OUTS = WS_WE13T;
constexpr int MOE_KS = 7, MOE_TAIL_ROWS = 2304;
constexpr size_t WS_OUTP = WS_OUTS + (size_t)32768 * D * 2;
static_assert(WS_OUTP + (size_t)MOE_KS * MOE_TAIL_ROWS * D * 2 <= WS_WE2T, "tail slabs fit over the dead up-weights");
constexpr size_t WS_END = WS_TOKI + (size_t)M * 16;
static_assert(WS_P1 + (size_t)M * N1P * 2 <= WS_BON && WS_BON + (size_t)M * 8 * 4 <= WS_FL32, "bonus map");
static_assert(WS_P1 + (size_t)M * N1P * 2 <= WS_FL32 && WS_CFOX + 64 * 2048 * 4 <= WS_CAUG && WS_CAUG + 64 * 2048 * 8 <= WS_YC0, "layer-1 map");
static_assert(WS_GDEC + 1024 * 64 * 4 <= WS_END, "gla map");
static_assert(WS_YRAW + (size_t)M * 512 * 2 <= WS_W2T && WS_WAG + (size_t)3 * M * 512 * 4 <= WS_END && WS_END <= 487325728ull, "ws map");
constexpr int CW_BAR = 4096, CW_CNT = 8192, CW_SSQ1 = 16384, CW_SSQ2 = 49152, CW_SSQ3 = 81920, CW_SSQ0 = 114688;

constexpr int RING_BYTES = 131072, LDSCTL_OFF = RING_BYTES, MISC_OFF = LDSCTL_OFF + 320, LDS_BYTES = 147456;

#define RLX_AGENT __ATOMIC_RELAXED, __HIP_MEMORY_SCOPE_AGENT
#define LDS_WAIT() asm volatile("s_waitcnt lgkmcnt(0)" ::: "memory")
#define VM_WAIT() asm volatile("s_waitcnt vmcnt(0)" ::: "memory")
#define XB_TMO      128
#define XB_XCNT(j)  (256  + 64 * (j))
#define XB_XSUB(j)  (1280 + 64 * (j))
#define XB_XGEN(j)  (2304 + 64 * (j))
#define XB_TOP      3328
#define XB_TOPGEN   3392
#define XCD_BAR_WORDS 3456
#define XB_SPIN_CAP (1u << 18)

__device__ __forceinline__ unsigned xb_ld(unsigned* p)              { return __hip_atomic_load(p, __ATOMIC_RELAXED, __HIP_MEMORY_SCOPE_AGENT); }
__device__ __forceinline__ unsigned xb_add(unsigned* p, unsigned v) { return __hip_atomic_fetch_add(p, v, __ATOMIC_RELAXED, __HIP_MEMORY_SCOPE_AGENT); }
__device__ __forceinline__ unsigned xb_xcc_id() { return (unsigned)__builtin_amdgcn_s_getreg((3 << 11) | 20) & 0xFu; }
#define XB_SPIN(cond, bar) do { unsigned _sp = 0; while (cond) { __builtin_amdgcn_s_sleep(1); \
    if ((++_sp & 255u) == 0u) { if (xb_ld(&(bar)[XB_TMO])) break; if (_sp > XB_SPIN_CAP) { atomicAdd(&(bar)[XB_TMO], 1u); break; } } } } while (0)

struct XcdBarrier {
    unsigned* bar; unsigned x;
    volatile LAS unsigned* st;
};

__device__ __forceinline__ XcdBarrier xcd_barrier_post(unsigned* bar, volatile LAS unsigned* st) {
    XcdBarrier b; b.bar = bar; b.x = xb_xcc_id(); b.st = st;
    if (threadIdx.x == 0) (void)xb_add(&bar[XB_XCNT(b.x)], 1u);
    return b;
}
__device__ __forceinline__ void xcd_barrier_complete(unsigned* bar, unsigned x, unsigned& nloc, unsigned& nx) {
    const unsigned G = gridDim.x * gridDim.y * gridDim.z;
    unsigned sum, cnt, mine, sp = 0u;
    for (;;) {
        sum = 0u; cnt = 0u; mine = 0u;
#pragma unroll
        for (unsigned j = 0; j < 16; ++j) { const unsigned c = xb_ld(&bar[XB_XCNT(j)]); sum += c; cnt += (c > 0u) ? 1u : 0u; mine = (j == x) ? c : mine; }
        if (sum == G) break;
        __builtin_amdgcn_s_sleep(1);
        if ((++sp & 255u) == 0u) { if (xb_ld(&bar[XB_TMO])) break; if (sp > XB_SPIN_CAP) { atomicAdd(&bar[XB_TMO], 1u); break; } }
    }
    nloc = mine > 0u ? mine : 1u; nx = cnt > 0u ? cnt : 1u;
}

__device__ __forceinline__ void xcd_barrier(const XcdBarrier& b) {
    asm volatile("s_waitcnt vmcnt(0)" ::: "memory");
    __syncthreads();
    if (threadIdx.x == 0) {
        unsigned* bar = b.bar;
        __builtin_amdgcn_s_waitcnt(0);
        unsigned nloc = b.st[0], nx = b.st[1];
        if (nloc == 0u) { xcd_barrier_complete(bar, b.x, nloc, nx); b.st[0] = nloc; b.st[1] = nx; }
        const unsigned old = xb_add(&bar[XB_XSUB(b.x)], 1u);
        const unsigned gen = old / nloc;
        if (old + 1u == (gen + 1u) * nloc) {
            __builtin_amdgcn_fence(__ATOMIC_RELEASE, "agent");
            asm volatile("s_waitcnt vmcnt(0)" ::: "memory");
            const unsigned og = xb_add(&bar[XB_TOP], 1u);
            const unsigned tg = og / nx;
            if (og + 1u == (tg + 1u) * nx) xb_add(&bar[XB_TOPGEN], 1u);
            else XB_SPIN(xb_ld(&bar[XB_TOPGEN]) == tg, bar);
            __builtin_amdgcn_fence(__ATOMIC_ACQUIRE, "agent");
            xb_add(&bar[XB_XGEN(b.x)], 1u);
            asm volatile("s_waitcnt vmcnt(0)" ::: "memory");
        } else {
            XB_SPIN(xb_ld(&bar[XB_XGEN(b.x)]) == gen, bar);
            __builtin_amdgcn_fence(__ATOMIC_ACQUIRE, "agent");
            asm volatile("s_waitcnt vmcnt(0)" ::: "memory");
        }
    }
    __syncthreads();
}
namespace attn_body {
using bf16=__hip_bfloat16;
using bf16x8=__attribute__((ext_vector_type(8)))short;
using s16x4=__attribute__((ext_vector_type(4)))short;
using f32x16=__attribute__((ext_vector_type(16)))float;
using u32x4=__attribute__((ext_vector_type(4)))unsigned;
constexpr int BATCH=8,NHEAD=8,SEQ=2048,D=64,DM=3584,DMO=1024;
constexpr int NW=8,QBLK=32,QB=QBLK*NW,KVBLK=64,NQB=SEQ/QB;
constexpr int ATTN_PITCH=DM, ATTN_UNIT_ROWS=QB;
__device__ __forceinline__ int crow(int r,int hi){return (r&3)+8*(r>>2)+4*hi;}
#define SBAR() __builtin_amdgcn_sched_barrier(0)
__device__ __forceinline__ void cmask(f32x16&p0,f32x16&p1,int jb,int qrel,int hi){
  const float NEG=-INFINITY; int kb=64*jb+4*hi;
  #pragma unroll
  for(int r=0;r<16;++r){int kv=kb+(r&3)+8*(r>>2); if(kv>qrel)p0[r]=NEG; if(kv+32>qrel)p1[r]=NEG;}
}

constexpr int NSLOT=3, SLOTB=8192;
constexpr int LDS_K=0, LDS_V=NSLOT*SLOTB, LDS_WS=2*NSLOT*SLOTB, LDS_OST=LDS_WS+NW*64*4, LDS_AUG=LDS_OST+NW*4096, LDS_BYTES=LDS_AUG+SEQ*8+64;
constexpr float C2=0.125f*1.4426950408889634f;
__device__ __forceinline__ void glds16(const void*gsrc,unsigned lds_dst){unsigned keep;
  asm volatile("s_mov_b32 %0, m0\n\ts_mov_b32 m0, %2\n\ts_nop 0\n\tglobal_load_lds_dwordx4 %1, off\n\ts_mov_b32 m0, %0":"=&s"(keep):"v"(gsrc),"s"(lds_dst):"memory");}
__device__ __forceinline__ float max3f(float a,float b,float c){float r;asm("v_max3_f32 %0, %1, %2, %3":"=v"(r):"v"(a),"v"(b),"v"(c));return r;}
__device__ __forceinline__ float max2f(float a,float b){float r;asm("v_max_f32_e32 %0, %1, %2":"=v"(r):"v"(a),"v"(b));return r;}
__device__ __forceinline__ float fadd_s(float a,float b){float r;asm("v_add_f32_e32 %0, %1, %2":"=v"(r):"v"(a),"v"(b));return r;}
__device__ __forceinline__ float fsub_s(float a,float b){float r;asm("v_sub_f32_e32 %0, %1, %2":"=v"(r):"v"(a),"v"(b));return r;}
typedef float f32x2_t __attribute__((ext_vector_type(2))); typedef __bf16 bf16x2_t __attribute__((ext_vector_type(2)));
__device__ __forceinline__ unsigned cvtpk_s(float lo,float hi){f32x2_t v={lo,hi};bf16x2_t b=__builtin_convertvector(v,bf16x2_t);return __builtin_bit_cast(unsigned,b);}
#define WAIT_BAR(N) asm volatile("s_waitcnt vmcnt(" #N ") lgkmcnt(0)\n\ts_barrier":::"memory")

__device__ __forceinline__ void qkt(f32x16&p0,f32x16&p1,const char*Kslot,const bf16x8*qr,int r32,int hi,bf16x8 ka0,bf16x8 ka1,bf16x8 qa){ const f32x16 negm=f32x16{};
  const char*kb=Kslot+hi*1024+r32*16;
  p0=__builtin_amdgcn_mfma_f32_32x32x16_bf16(ka0,qa,negm,0,0,0);p1=__builtin_amdgcn_mfma_f32_32x32x16_bf16(ka1,qa,negm,0,0,0);
  #pragma unroll
  for(int d0=0;d0<4;++d0){
    const bf16x8 b0=*reinterpret_cast<const bf16x8*>(kb+d0*2048);
    const bf16x8 b1=*reinterpret_cast<const bf16x8*>(kb+d0*2048+512);
    p0=__builtin_amdgcn_mfma_f32_32x32x16_bf16(b0,qr[d0],p0,0,0,0);p1=__builtin_amdgcn_mfma_f32_32x32x16_bf16(b1,qr[d0],p1,0,0,0);}
}
typedef __attribute__((address_space(3))) const char* lds_cptr;
typedef short v4i16_t __attribute__((ext_vector_type(4)));
__device__ __forceinline__ void kload8(bf16x8*kf,lds_cptr kp){
  kf[0]=*(const __attribute__((address_space(3))) bf16x8*)(kp);      kf[1]=*(const __attribute__((address_space(3))) bf16x8*)(kp+512);
  kf[2]=*(const __attribute__((address_space(3))) bf16x8*)(kp+2048); kf[3]=*(const __attribute__((address_space(3))) bf16x8*)(kp+2560);
  kf[4]=*(const __attribute__((address_space(3))) bf16x8*)(kp+4096); kf[5]=*(const __attribute__((address_space(3))) bf16x8*)(kp+4608);
  kf[6]=*(const __attribute__((address_space(3))) bf16x8*)(kp+6144); kf[7]=*(const __attribute__((address_space(3))) bf16x8*)(kp+6656);
}
__device__ __forceinline__ void kload2(bf16x8*kf,lds_cptr kp,int j){ kf[2*j]=*(const __attribute__((address_space(3))) bf16x8*)(kp+j*2048); kf[2*j+1]=*(const __attribute__((address_space(3))) bf16x8*)(kp+j*2048+512); }
__device__ __forceinline__ s16x4 vtr(lds_cptr p){ return __builtin_bit_cast(s16x4,__builtin_amdgcn_ds_read_tr16_b64_v4i16((__attribute__((address_space(3))) v4i16_t*)p)); }
__device__ __forceinline__ float rowmax(const f32x16&p0,const f32x16&p1){
  float a=max3f(p0[0],p0[1],p1[0]),b=max3f(p0[2],p0[3],p1[1]);a=max3f(a,p1[2],p1[3]);
  #pragma unroll
  for(int r=4;r<16;r+=4){a=max3f(a,p0[r],p0[r+1]);b=max3f(b,p0[r+2],p0[r+3]);a=max3f(a,p1[r],p1[r+1]);b=max3f(b,p1[r+2],p1[r+3]);}
  const float m=max2f(a,b);
  auto rr=__builtin_amdgcn_permlane32_swap(__float_as_uint(m),__float_as_uint(m),false,false);
  return max2f(__uint_as_float(rr[0]),__uint_as_float(rr[1]));
}
__device__ __forceinline__ void pv(f32x16*o,int vb,bf16x8 pa0,bf16x8 pa1,bf16x8 pa2,bf16x8 pa3){
  #pragma unroll
  for(int d0=0;d0<2;++d0){s16x4 lo[4],hi[4];
    #pragma unroll
    for(int ks=0;ks<4;++ks){
      asm volatile("ds_read_b64_tr_b16 %0,%1 offset:%c2":"=&v"(lo[ks]):"v"(vb),"i"(d0*4096+ks*1024):"memory");
      asm volatile("ds_read_b64_tr_b16 %0,%1 offset:%c2":"=&v"(hi[ks]):"v"(vb),"i"(d0*4096+ks*1024+512):"memory");}
    asm volatile("s_waitcnt lgkmcnt(0)":::"memory");SBAR();
    #define PK(k) (bf16x8){lo[k][0],lo[k][1],lo[k][2],lo[k][3],hi[k][0],hi[k][1],hi[k][2],hi[k][3]}
    o[d0]=__builtin_amdgcn_mfma_f32_32x32x16_bf16(pa0,PK(0),o[d0],0,0,0);
    o[d0]=__builtin_amdgcn_mfma_f32_32x32x16_bf16(pa1,PK(1),o[d0],0,0,0);
    o[d0]=__builtin_amdgcn_mfma_f32_32x32x16_bf16(pa2,PK(2),o[d0],0,0,0);
    o[d0]=__builtin_amdgcn_mfma_f32_32x32x16_bf16(pa3,PK(3),o[d0],0,0,0);
    #undef PK
  }
}

#ifndef ATTN_STORE16
#define ATTN_STORE16(p,v) (*(u32x4*)(p)=(v))
#endif
template<int THRL> __device__ __forceinline__ void attn_unit(int b,int h,int qb,const bf16*Q,const bf16*__restrict__ K,const bf16*__restrict__ V,bf16*O,const unsigned long long*__restrict__ AUG,char*shm){
  const int tid=fresh_tid(),lane=tid&63,r32=lane&31,hi=lane>>5; const int wid=__builtin_amdgcn_readfirstlane(tid>>6);
  const long rowbase=(long)b*SEQ; const int q0=qb*QB; unsigned long long augq_;
  const bf16*Qw=Q+(rowbase+q0+wid*QBLK)*DM+h*D;
  const bf16*Kh=K+rowbase*DM+h*D,*Vh=V+rowbase*DM+h*D;
  const unsigned lds0=(unsigned)(uintptr_t)shm;
  float*wsf=(float*)(shm+LDS_WS)+wid*64;
  const bf16*ksrc=Kh+(long)lane*DM+wid*8;
  const bf16*vsrc=Vh+(long)(16*(wid&3)+(lane>>2))*DM+(wid>>2)*32+(lane&3)*8;
  const unsigned kdst=lds0+LDS_K+wid*1024, vdst=lds0+LDS_V+wid*1024;
  #define DMA_K(t,slot) glds16(ksrc+(long)(t)*KVBLK*DM,(unsigned)__builtin_amdgcn_readfirstlane(kdst+(slot)))
  #define DMA_V(t,slot) glds16(vsrc+(long)(t)*KVBLK*DM,(unsigned)__builtin_amdgcn_readfirstlane(vdst+(slot)))
  const int vb0=(int)(lds0+LDS_V)+((lane>>4)&1)*32+(lane&3)*8+(4*hi+((lane&15)>>2))*64;
  const char*Kbase=shm+LDS_K; bf16x8 kf[8];
  const lds_cptr shm3=(lds_cptr)shm; const lds_cptr kp0=shm3+LDS_K+hi*1024+r32*16; const lds_cptr vp0=shm3+LDS_V+((lane>>4)&1)*32+(lane&3)*8+(4*hi+((lane&15)>>2))*64;
  const int NT=(q0+QB)/KVBLK;
  const unsigned long long*augb=AUG+(long)(b*NHEAD+h)*SEQ;
  { const int nk=q0+QB; unsigned long long t_[4];
    _Pragma("unroll") for(int i=0;i<4;++i){const int k_=tid+512*i; t_[i]=(k_<nk)?augb[k_]:0ull;}
    const unsigned long long qw_=augb[q0+wid*QBLK+r32];
    asm volatile("s_waitcnt vmcnt(0)":::"memory");
    _Pragma("unroll") for(int i=0;i<4;++i){const int k_=tid+512*i; if(k_<nk)*(unsigned long long*)(shm+LDS_AUG+k_*8)=t_[i];}
    augq_=qw_; }
  bf16x8 qa=__builtin_bit_cast(bf16x8,(u32x4){hi?0u:0x3F803F80u,hi?0u:(0x3F80u|((unsigned)augq_<<16)),hi?0u:(((unsigned)augq_>>16)|((unsigned)(augq_>>32)<<16)),0u});
  #define SETQA() do{ const float nm_=-mhat; const unsigned a1_=cvtpk_s(nm_,0.f)&0xffffu; const float r1_=nm_-__uint_as_float(a1_<<16); const unsigned a2_=cvtpk_s(r1_,0.f)&0xffffu; const float r2_=r1_-__uint_as_float(a2_<<16); const unsigned a3_=cvtpk_s(r2_,0.f)&0xffffu; \
      u32x4 q4_=__builtin_bit_cast(u32x4,qa); q4_[0]=hi?(a1_|(a2_<<16)):q4_[0]; q4_[1]=hi?a3_:q4_[1]; qa=__builtin_bit_cast(bf16x8,q4_); }while(0)
  const lds_cptr augp=(lds_cptr)shm+LDS_AUG+r32*8;
  #define KAUG(t,half) ({ const unsigned long long w_=*(const __attribute__((address_space(3))) unsigned long long*)(augp+((t)*64+(half)*32)*8); \
      __builtin_bit_cast(bf16x8,(u32x4){hi?0x3F803F80u:(((unsigned)w_)^0x80008000u),hi?0x3F80u:(((((unsigned)(w_>>32))&0xffffu)^0x8000u)|0x3F800000u),hi?0u:0x3F803F80u,0u}); })
  DMA_K(0,0);DMA_V(0,0);DMA_K(1,SLOTB);
  bf16x8 qr[4];
  #pragma unroll
  for(int d0=0;d0<4;++d0)qr[d0]=*reinterpret_cast<const bf16x8*>(&Qw[(long)r32*DM+d0*16+hi*8]);
  float mhat=0.f,l_reg=0.f;f32x16 o[2];o[0]=f32x16{};o[1]=f32x16{};const f32x16 zero16=f32x16{};
  const int qrel=wid*QBLK+r32;
  #define CMASK(P0,P1,t) do{int jb_=(t)-(NT-4); if(jb_>=0)cmask(P0,P1,jb_,qrel,hi);}while(0)
  bool resc=false;
  #define START(P0,P1) do{ const float rm=rowmax(P0,P1); resc=false; \
    { const float dl=rm; mhat=fadd_s(mhat,dl); \
      _Pragma("unroll") for(int r=0;r<16;++r){P0[r]=fsub_s(P0[r],dl);P1[r]=fsub_s(P1[r],dl);} \
      SETQA(); } \
    _Pragma("unroll") for(int r=0;r<16;++r)P0[r]=__builtin_amdgcn_exp2f(P0[r]); }while(0)
  #define RESC() do{ if(resc){ asm volatile("s_waitcnt lgkmcnt(0)":::"memory"); \
      _Pragma("unroll") for(int d_=0;d_<2;++d_) _Pragma("unroll") for(int r=0;r<16;++r)o[d_][r]*=wsf[crow(r,hi)]; } }while(0)
  f32x16 pA0,pA1,pB0,pB1;
  int sl_prev=0,sl_cur=0,sl_next=SLOTB;
  #define ROT() do{sl_prev=sl_cur;sl_cur=sl_next;sl_next=(sl_next==(NSLOT-1)*SLOTB)?0:sl_next+SLOTB;}while(0)
  DMA_K(2,2*SLOTB);
  WAIT_BAR(3);
  qkt(pA0,pA1,Kbase,qr,r32,hi,KAUG(0,0),KAUG(0,1),qa);asm volatile("s_nop 15\n\ts_nop 7":"+v"(pA0),"+v"(pA1));CMASK(pA0,pA1,0);
  START(pA0,pA1);
  _Pragma("unroll") for(int r=0;r<16;++r)pA1[r]=__builtin_amdgcn_exp2f(pA1[r]);
  WAIT_BAR(0);
  DMA_K(3,0);DMA_V(1,SLOTB);
  ROT();
  kload8(kf,kp0+sl_cur);
  WAIT_BAR(2);
  s16x4 vlo[8],vhi[8]; u32x4 pw0,pw1,pw2,pw3;
  #define PKW(P,B) cvtpk_s(P[B],P[B+1])
  #define PAF(k) __builtin_bit_cast(bf16x8,pw##k)
  #define VFR(i) (bf16x8){vlo[i][0],vlo[i][1],vlo[i][2],vlo[i][3],vhi[i][0],vhi[i][1],vhi[i][2],vhi[i][3]}
  #define PIN(x) asm volatile("":"+v"(x))
  #define MX3(a,b,c) __builtin_fmaxf(__builtin_fmaxf((a),(b)),(c))
  #define GAPA(MF,A0,A1,A2,A3,W0,W1,PW) do{ MF; sacc+=A0; sacc+=A1; sacc+=A2; sacc+=A3; PIN(sacc); W0; W1; PIN(PW); SBAR(); }while(0)
  #define EX(v) __builtin_amdgcn_exp2f(v)
  #define GAPB(MF,X,B) do{ MF; X[B]=EX(X[B]); X[B+1]=EX(X[B+1]); X[B+2]=EX(X[B+2]); X[B+3]=EX(X[B+3]); PIN(X); SBAR(); }while(0)
  #define VRD(i) do{ vlo[i]=vtr(vp_+(((i)>>2)*4096+((i)&3)*1024)); vhi[i]=vtr(vp_+(((i)>>2)*4096+((i)&3)*1024+512)); }while(0)
  #define KRD(G,j) do{ if(G){ kload2(kf,kp0+sl_next,j); SBAR(); } }while(0)
  #define STEP(C0,C1,P0,P1,t,GK,GV,GL) do{ SBAR(); \
    const lds_cptr vp_=vp0+sl_prev; \
    { const bf16x8 ka0_=KAUG(t,0), ka1_=KAUG(t,1); C0=__builtin_amdgcn_mfma_f32_32x32x16_bf16(ka0_,qa,zero16,0,0,0); C1=__builtin_amdgcn_mfma_f32_32x32x16_bf16(ka1_,qa,zero16,0,0,0); } SBAR(); \
    VRD(0); SBAR(); float sacc=(P0[0]+P0[1]); \
    GAPA(C0=__builtin_amdgcn_mfma_f32_32x32x16_bf16(kf[0],qr[0],C0,0,0,0), P0[2],P0[3],P0[4],P0[5],     pw0[0]=PKW(P0,0), pw0[1]=PKW(P0,2), pw0); \
    VRD(4); SBAR(); GAPA(C1=__builtin_amdgcn_mfma_f32_32x32x16_bf16(kf[1],qr[0],C1,0,0,0), P0[6],P0[7],P0[8],P0[9],     pw0[2]=PKW(P0,4), pw0[3]=PKW(P0,6), pw0); \
    VRD(1); SBAR(); GAPA(C0=__builtin_amdgcn_mfma_f32_32x32x16_bf16(kf[2],qr[1],C0,0,0,0),   P0[10],P0[11],P0[12],P0[13], pw1[0]=PKW(P0,8), pw1[1]=PKW(P0,10), pw1); \
    VRD(5); SBAR(); GAPA(C1=__builtin_amdgcn_mfma_f32_32x32x16_bf16(kf[3],qr[1],C1,0,0,0),   P0[14],P0[15],P1[0],P1[1],   pw1[2]=PKW(P0,12),pw1[3]=PKW(P0,14), pw1); \
    VRD(2); SBAR(); GAPA(C0=__builtin_amdgcn_mfma_f32_32x32x16_bf16(kf[4],qr[2],C0,0,0,0),   P1[2],P1[3],P1[4],P1[5],     pw2[0]=PKW(P1,0), pw2[1]=PKW(P1,2), pw2); \
    VRD(6); SBAR(); GAPA(C1=__builtin_amdgcn_mfma_f32_32x32x16_bf16(kf[5],qr[2],C1,0,0,0),   P1[6],P1[7],P1[8],P1[9],     pw2[2]=PKW(P1,4), pw2[3]=PKW(P1,6), pw2); \
    VRD(3); SBAR(); GAPA(C0=__builtin_amdgcn_mfma_f32_32x32x16_bf16(kf[6],qr[3],C0,0,0,0),   P1[10],P1[11],P1[12],P1[13], pw3[0]=PKW(P1,8), pw3[1]=PKW(P1,10), pw3); \
    VRD(7); SBAR(); GAPA(C1=__builtin_amdgcn_mfma_f32_32x32x16_bf16(kf[7],qr[3],C1,0,0,0),   P1[14],P1[15],0.f,0.f,       pw3[2]=PKW(P1,12),pw3[3]=PKW(P1,14), pw3); \
    l_reg+=sacc; \
    if(GK){DMA_K((t)+3,sl_cur);} if(GV){DMA_V((t)+1,sl_next);} \
    CMASK(C0,C1,t); \
    { float a=MX3(C0[0],C0[1],C1[0]),b=MX3(C0[2],C0[3],C1[1]); a=MX3(a,C1[2],C1[3]); \
      _Pragma("unroll") for(int r=4;r<16;r+=4){a=MX3(a,C0[r],C0[r+1]);b=MX3(b,C0[r+2],C0[r+3]);a=MX3(a,C1[r],C1[r+1]);b=MX3(b,C1[r+2],C1[r+3]);} \
      float rm=__builtin_fmaxf(a,b); { auto rr=__builtin_amdgcn_permlane32_swap(__float_as_uint(rm),__float_as_uint(rm),false,false); rm=__builtin_fmaxf(__uint_as_float(rr[0]),__uint_as_float(rr[1])); } \
      resc=false; \
      if(__builtin_expect(__any(rm>(float)THRL),0)){ const float dl=__builtin_fmaxf(rm,0.f); mhat+=dl; \
        _Pragma("unroll") for(int r=0;r<16;++r){C0[r]-=dl;C1[r]-=dl;} \
        SETQA(); \
        const float f=__builtin_amdgcn_exp2f(-dl); l_reg*=f; if(hi==0)wsf[r32]=f; resc=true; } } \
    SBAR(); \
    GAPB(o[0]=__builtin_amdgcn_mfma_f32_32x32x16_bf16(PAF(0),VFR(0),o[0],0,0,0), C0,0); \
    GAPB(o[1]=__builtin_amdgcn_mfma_f32_32x32x16_bf16(PAF(0),VFR(4),o[1],0,0,0), C0,4); \
    KRD(GL,0); GAPB(o[0]=__builtin_amdgcn_mfma_f32_32x32x16_bf16(PAF(1),VFR(1),o[0],0,0,0), C0,8); \
    KRD(GL,1); GAPB(o[1]=__builtin_amdgcn_mfma_f32_32x32x16_bf16(PAF(1),VFR(5),o[1],0,0,0), C0,12); \
    KRD(GL,2); GAPB(o[0]=__builtin_amdgcn_mfma_f32_32x32x16_bf16(PAF(2),VFR(2),o[0],0,0,0), C1,0); \
    KRD(GL,3); GAPB(o[1]=__builtin_amdgcn_mfma_f32_32x32x16_bf16(PAF(2),VFR(6),o[1],0,0,0), C1,4); \
    GAPB(o[0]=__builtin_amdgcn_mfma_f32_32x32x16_bf16(PAF(3),VFR(3),o[0],0,0,0), C1,8); \
    GAPB(o[1]=__builtin_amdgcn_mfma_f32_32x32x16_bf16(PAF(3),VFR(7),o[1],0,0,0), C1,12); \
    }while(0)
  int t=1;
  #undef CMASK
  #define CMASK(P0,P1,t) do{}while(0)
  for(;t+5<NT;t+=2){
    STEP(pB0,pB1,pA0,pA1,t,true,true,true);     WAIT_BAR(2); RESC(); ROT();
    STEP(pA0,pA1,pB0,pB1,t+1,true,true,true);   WAIT_BAR(2); RESC(); ROT();
  }
  #undef CMASK
  #define CMASK(P0,P1,t) do{int jb_=(t)-(NT-4); if(jb_>=0)cmask(P0,P1,jb_,qrel,hi);}while(0)
  #define ENDW(tt) do{ if((tt)+3<NT){WAIT_BAR(2);} else if((tt)+2<NT){WAIT_BAR(1);} else {WAIT_BAR(0);} }while(0)
  for(;t+1<NT;t+=2){
    STEP(pB0,pB1,pA0,pA1,t,(t+3<NT),(t+1<NT),(t+1<NT));       ENDW(t);   RESC(); ROT();
    STEP(pA0,pA1,pB0,pB1,t+1,(t+4<NT),(t+2<NT),(t+2<NT));     ENDW(t+1); RESC(); ROT();
  }
  STEP(pB0,pB1,pA0,pA1,NT-1,false,false,false); RESC();
  { float sacc=pB0[0]+pB0[1]; _Pragma("unroll") for(int r=2;r<16;++r)sacc+=pB0[r]; _Pragma("unroll") for(int r=0;r<16;++r)sacc+=pB1[r]; l_reg+=sacc;
    pw0=(u32x4){PKW(pB0,0),PKW(pB0,2),PKW(pB0,4),PKW(pB0,6)};pw1=(u32x4){PKW(pB0,8),PKW(pB0,10),PKW(pB0,12),PKW(pB0,14)};pw2=(u32x4){PKW(pB1,0),PKW(pB1,2),PKW(pB1,4),PKW(pB1,6)};pw3=(u32x4){PKW(pB1,8),PKW(pB1,10),PKW(pB1,12),PKW(pB1,14)};
    SBAR(); pv(o,vb0+sl_cur,PAF(0),PAF(1),PAF(2),PAF(3)); }
  #undef PKW
  #undef PAF
  #undef VFR
  #undef PIN
  #undef MX3
  #undef GAPA
  #undef GAPB
  #undef EX
  #undef VRD
  #undef KRD
  #undef STEP
  #undef ENDW
  {auto rr=__builtin_amdgcn_permlane32_swap(__float_as_uint(l_reg),__float_as_uint(l_reg),false,false);l_reg=__uint_as_float(rr[0])+__uint_as_float(rr[1]);}
  if(hi==0)wsf[32+r32]=l_reg;asm volatile("s_waitcnt lgkmcnt(0)":::"memory");
  float rli[16];
  #pragma unroll
  for(int r=0;r<16;++r)rli[r]=__builtin_amdgcn_rcpf(wsf[32+crow(r,hi)]);
  bf16*Ow=O+(rowbase+q0+wid*QBLK)*DMO+h*D;
  { bf16*stg=(bf16*)(shm+LDS_OST)+wid*2048;
    #pragma unroll
    for(int r=0;r<16;++r){const int orow=crow(r,hi);
      #pragma unroll
      for(int d0=0;d0<2;++d0)stg[orow*64+d0*32+r32]=__float2bfloat16(o[d0][r]*rli[r]);}
    asm volatile("s_waitcnt lgkmcnt(0)":::"memory");
    #pragma unroll
    for(int i=0;i<4;++i){const int row=i*8+(lane>>3),ch=lane&7; const u32x4 v=*(const u32x4*)(stg+row*64+ch*8); ATTN_STORE16(Ow+(long)row*DMO+ch*8,v);} }
  asm volatile("s_waitcnt lgkmcnt(0)\n\ts_barrier":::"memory");
  #undef KAUG
  #undef SETQA
  #undef DMA_K
  #undef DMA_V
  #undef CMASK
  #undef START
  #undef RESC
  #undef ROT
}
constexpr int ATTN_LDS_BYTES=LDS_BYTES;
struct AttnTensors { const bf16* Q; const bf16* K; const bf16* V; bf16* O; const unsigned long long* AUG; };
struct AttnUnit { int bh; int qb; };
struct StaticOrder {
  int fb, nb;
  __device__ __forceinline__ explicit StaticOrder(int nblk,int idx):fb(idx),nb(nblk){}
  __device__ __forceinline__ bool next(int i,AttnUnit&u)const{
    if(nb==256){ if(i>=2)return false; const int s=fb&3; u.bh=fb>>2; u.qb=(i==0)?7-s:s; return true; }
    if(i>=4)return false; const int s=(fb&1)*2+(i>>1); u.bh=fb>>1; u.qb=(i&1)?s:7-s; return true; }
  __device__ __forceinline__ void a_ready(const AttnUnit&)const{}
  __device__ __forceinline__ void done(const AttnUnit&)const{}
};
template<class Sched,int THRL=8> __device__ __forceinline__ void attn_phase(char*lds,const AttnTensors&T,const Sched&S){
  AttnUnit u;
  for(int i=0;S.next(i,u);++i){ S.a_ready(u); attn_unit<THRL>(u.bh/NHEAD,u.bh%NHEAD,u.qb,T.Q,T.K,T.V,T.O,T.AUG,lds); S.done(u); }
}
#undef SBAR
#undef WAIT_BAR
}
struct Frame {
    LAS unsigned char* lds;
    unsigned* ctl;
    unsigned char* ws;
    int tid, lane, wave, vcu, G;
};
struct Args { const float* in[34]; float* out; unsigned char* ws; int ph_lo, ph_hi; };

__device__ __forceinline__ void tr_item(const float* W, int K, int N, int NP, bf16_t* WT, int ldk, int kcol_off, int mode, int row_off, const float* gk, LAS float* scr, int item, int lane) {
    const int nblk = NP / 32, kb = item / nblk, nb = item % nblk, k0 = 64 * kb, n0 = 32 * nb;
    (void)K;
    { const int n4 = (lane & 7) * 4, kr = lane >> 3; f32x4 v[8];
#pragma unroll
      for (int i = 0; i < 8; ++i) { const int kk = 8 * i + kr; v[i] = (n0 + n4 < N) ? *(const f32x4*)(W + (size_t)(k0 + kk) * N + n0 + n4) : (f32x4){0.f, 0.f, 0.f, 0.f}; }
#pragma unroll
      for (int i = 0; i < 8; ++i) { const int kk = 8 * i + kr; const float g = gk ? gk[k0 + kk] : 1.0f; LAS float* d = scr + kk * 33 + n4; d[0] = v[i].x * g; d[1] = v[i].y * g; d[2] = v[i].z * g; d[3] = v[i].w * g; } }
    LDS_WAIT(); asm volatile("" ::: "memory");
    const int c = lane & 7;
#pragma unroll
    for (int j = 0; j < 4; ++j) { const int n = (lane >> 3) + 8 * j; const LAS float* s = scr + (8 * c) * 33 + n; const int ng = n0 + n;
        const int drow = row_off + (mode ? ((ng >> 7) * 256 + (ng & 127)) : ng);
        u32x4 o; o.x = pk2(s[0 * 33], s[1 * 33]); o.y = pk2(s[2 * 33], s[3 * 33]); o.z = pk2(s[4 * 33], s[5 * 33]); o.w = pk2(s[6 * 33], s[7 * 33]);
        *(u32x4*)(WT + (size_t)drow * ldk + kcol_off + k0 + 8 * c) = o; }
    LDS_WAIT(); asm volatile("" ::: "memory");
}
__device__ __forceinline__ void tr_item8(const float* W, int N, unsigned char* WT, int ldk, int mode, int row_off, const float* gk, float scale, LAS float* scr, int item, int lane) {
    const int nblk = N / 32, kb = item / nblk, nb = item % nblk, k0 = 64 * kb, n0 = 32 * nb;
    { const int n4 = (lane & 7) * 4, kr = lane >> 3; f32x4 v[8];
#pragma unroll
      for (int i = 0; i < 8; ++i) { const int kk = 8 * i + kr; v[i] = *(const f32x4*)(W + (size_t)(k0 + kk) * N + n0 + n4); }
#pragma unroll
      for (int i = 0; i < 8; ++i) { const int kk = 8 * i + kr; const float g = (gk ? gk[k0 + kk] : 1.0f) * scale; LAS float* d = scr + kk * 33 + n4; d[0] = v[i].x * g; d[1] = v[i].y * g; d[2] = v[i].z * g; d[3] = v[i].w * g; } }
    LDS_WAIT(); asm volatile("" ::: "memory");
    const int c = lane & 3;
#pragma unroll
    for (int j = 0; j < 2; ++j) { const int n = (lane >> 2) + 16 * j; const LAS float* s = scr + (16 * c) * 33 + n; const int ng = n0 + n;
        const int drow = row_off + (mode ? ((ng >> 7) * 256 + (ng & 127)) : ng);
        u32x4 o; o.x = pk_fp8x4(s[0 * 33], s[1 * 33], s[2 * 33], s[3 * 33]); o.y = pk_fp8x4(s[4 * 33], s[5 * 33], s[6 * 33], s[7 * 33]);
        o.z = pk_fp8x4(s[8 * 33], s[9 * 33], s[10 * 33], s[11 * 33]); o.w = pk_fp8x4(s[12 * 33], s[13 * 33], s[14 * 33], s[15 * 33]);
        *(u32x4*)(WT + (size_t)drow * ldk + k0 + 16 * c) = o; }
    LDS_WAIT(); asm volatile("" ::: "memory");
}
__device__ __forceinline__ void p0_prologue(Frame& F, const Args& A) {
    F.tid = fresh_tid(); F.lane = F.tid & 63;
    LAS float* scr = (LAS float*)(F.lds + F.wave * 16384);
    const int gw = F.vcu * NWAVES + F.wave, NGW = F.G * NWAVES, lane = F.lane;
    unsigned char* ws = F.ws;
    const float* g_mix = A.in[1]; const float* g_ffn = A.in[2];
    constexpr int I_IN0 = 16 * (N0P / 32), I_SQ = 16 * 32, I_F13 = 16 * (FF / 32), I_F2 = (FF / 64) * 32, I_IN1 = 16 * (N1P / 32);
    constexpr int I_L1 = 1 * 16, I_L2 = 1 * 16, I_L3 = 2 * 16;
    constexpr int NITEMS = I_IN0 + I_SQ + 2 * I_F13 + I_F2 + I_IN1 + I_SQ + I_L1 + I_L2 + I_L3;
    for (int it = gw; it < NITEMS; it += NGW) {
        int r = it;
        if (r < I_IN0) { tr_item(A.in[3], D, N0, N0P, (bf16_t*)(ws + WS_W0T), D, 0, 0, 0, g_mix, scr, r, lane); continue; } r -= I_IN0;
        if (r < I_SQ) { tr_item(A.in[11], D, D, D, (bf16_t*)(ws + WS_WO0T), D, 0, 0, 0, nullptr, scr, r, lane); continue; } r -= I_SQ;
        if (r < I_F13) { tr_item(A.in[12], D, FF, FF, (bf16_t*)(ws + WS_W13T), D, 0, 1, 0, g_ffn, scr, r, lane); continue; } r -= I_F13;
        if (r < I_F13) { tr_item(A.in[13], D, FF, FF, (bf16_t*)(ws + WS_W13T), D, 0, 1, 128, g_ffn, scr, r, lane); continue; } r -= I_F13;
        if (r < I_F2) { tr_item(A.in[14], FF, D, D, (bf16_t*)(ws + WS_W2T), FF, 0, 0, 0, nullptr, scr, r, lane); continue; } r -= I_F2;
        if (r < I_IN1) { tr_item(A.in[15], D, N1, N1P, (bf16_t*)(ws + WS_W1IN), D, 0, 0, 0, g_mix + D, scr, r, lane); continue; } r -= I_IN1;
        if (r < I_SQ) { tr_item(A.in[28], D, D, D, (bf16_t*)(ws + WS_WO1T), D, 0, 0, 0, nullptr, scr, r, lane); continue; } r -= I_SQ;
        if (r < I_L1) { tr_item(A.in[17], 64, 512, 512, (bf16_t*)(ws + WS_LORA), 256, 0, 0, 0, nullptr, scr, r, lane); continue; } r -= I_L1;
        if (r < I_L2) { tr_item(A.in[19], 64, 512, 512, (bf16_t*)(ws + WS_LORA), 256, 64, 0, 512, nullptr, scr, r, lane); continue; } r -= I_L2;
        tr_item(A.in[21], 128, 512, 512, (bf16_t*)(ws + WS_LORA), 256, 128, 0, 1024, nullptr, scr, r, lane);
    }
    { bf16_t* L = (bf16_t*)(ws + WS_LORA);
      for (int i = (F.vcu * NTHR + F.tid); i < 1536 * 256 / 8; i += F.G * NTHR) { const int row = i >> 5, c8 = (i & 31) * 8; const int type = row >> 9;
          const bool diag = (type == 0) ? (c8 < 64) : (type == 1) ? (c8 >= 64 && c8 < 128) : (c8 >= 128);
          if (!diag) *(u32x4*)(L + (size_t)row * 256 + c8) = (u32x4){0u, 0u, 0u, 0u}; } }
    { const float* x = A.in[0]; bf16_t* xb = (bf16_t*)(ws + WS_XB); pg8::u64* ssq0 = (pg8::u64*)(F.ctl + CW_SSQ0);
      for (int m = gw; m < M; m += NGW) { const f32x4* xr = (const f32x4*)(x + (size_t)m * D) + lane; f32x4 v[4]; float s = 0.f;
#pragma unroll
          for (int j = 0; j < 4; ++j) { v[j] = xr[64 * j]; s += (v[j].x * v[j].x + v[j].y * v[j].y) + (v[j].z * v[j].z + v[j].w * v[j].w); }
          s = wave_sum(s); if (lane == 0) ssq0[m] = (pg8::u64)(s * pg8::SSQ_SCALE + 0.5f);
          u32x2* o8 = (u32x2*)(xb + (size_t)m * D) + lane;
#pragma unroll
          for (int j = 0; j < 4; ++j) { u32x2 w; w.x = cvt_pk_bf16(v[j].x, v[j].y); w.y = cvt_pk_bf16(v[j].z, v[j].w); o8[64 * j] = w; } } }
}
__device__ __forceinline__ void moe_convert(Frame& F, const Args& A, int wi, int nw, int lo = 0, int hi = 0x7fffffff) {
    F.tid = fresh_tid(); F.lane = F.tid & 63;
    LAS float* scr = (LAS float*)(F.lds + F.wave * 16384); unsigned char* ws = F.ws; const float* g_ffn = A.in[2]; const int lane = F.lane;
    constexpr int I_E13 = 16 * (FE / 32), I_E2 = (FE / 64) * 32, NITEMS = NE * (2 * I_E13 + I_E2);
    for (int it = lo + wi; it < (hi < NITEMS ? hi : NITEMS); it += nw) {
        int r = it;
        if (r < NE * I_E13) { const int e = r / I_E13; tr_item8(A.in[30] + (size_t)e * D * FE, FE, ws + WS_WE13T + (size_t)e * 2 * FE * D, D, 1, 0, g_ffn + D, pg8::Q8_W, scr, r % I_E13, lane); continue; } r -= NE * I_E13;
        if (r < NE * I_E13) { const int e = r / I_E13; tr_item8(A.in[31] + (size_t)e * D * FE, FE, ws + WS_WE13T + (size_t)e * 2 * FE * D, D, 1, 128, g_ffn + D, pg8::Q8_W, scr, r % I_E13, lane); continue; } r -= NE * I_E13;
        const int e = r / I_E2; tr_item8(A.in[32] + (size_t)e * FE * D, D, ws + WS_WE2T + (size_t)e * D * FE, FE, 0, 0, nullptr, pg8::Q8_W, scr, r % I_E2, lane);
    }
}

__device__ __forceinline__ void conv_phase(Frame& F, const Args& A) {
    F.tid = fresh_tid(); F.lane = F.tid & 63;
    const bf16_t* P0 = (const bf16_t*)(F.ws + WS_P0); bf16_t* YC = (bf16_t*)(F.ws + WS_YC0);
    const float* cw = A.in[4]; const float* cb = A.in[5]; const float* lg = A.in[6]; const float* lb = A.in[7];
    LAS bf16_t* U = (LAS bf16_t*)F.lds; LAS float* Y = (LAS float*)(F.lds + 65536);
    const int c = F.tid;
    float w[31];
#pragma unroll
    for (int j = 0; j < 31; ++j) w[j] = cw[j * 512 + c];
    const float bias = cb[c];
    for (int unit = blockIdx.x; unit < M / 32; unit += F.G) {
        const int m0 = unit * 32, t0 = m0 % T;
        { u32x4 va[8], ga[8];
#pragma unroll
          for (int j = 0; j < 8; ++j) { const int it = F.tid + NTHR * j, i = it >> 6, c8 = (it & 63) * 8; const bool ok = (it < 62 * 64) && (t0 - 30 + i >= 0);
              const bf16_t* rp = P0 + (size_t)(ok ? (m0 - 30 + i) : m0) * N0P; va[j] = *(const u32x4*)(rp + C_VAL + c8); ga[j] = *(const u32x4*)(rp + C_GATE + c8); }
#pragma unroll
          for (int j = 0; j < 8; ++j) { const int it = F.tid + NTHR * j, i = it >> 6, c8 = (it & 63) * 8; const bool ok = (t0 - 30 + i >= 0);
              if (it < 62 * 64) { u32x4 o = (u32x4){0u, 0u, 0u, 0u};
                  if (ok) { float r[8];
#pragma unroll
                      for (int q = 0; q < 4; ++q) { r[2 * q] = bflo(va[j][q]) * sigmoidf_(bflo(ga[j][q])); r[2 * q + 1] = bfhi(va[j][q]) * sigmoidf_(bfhi(ga[j][q])); }
                      o.x = cvt_pk_bf16(r[0], r[1]); o.y = cvt_pk_bf16(r[2], r[3]); o.z = cvt_pk_bf16(r[4], r[5]); o.w = cvt_pk_bf16(r[6], r[7]); }
                  *(LAS u32x4*)(U + i * 512 + c8) = o; } } }
        __syncthreads();
        { float y[32];
#pragma unroll
          for (int t = 0; t < 32; ++t) y[t] = bias;
#pragma unroll
          for (int i = 0; i < 62; ++i) { const float uv = bf2f(U[i * 512 + c]);
#pragma unroll
              for (int t = 0; t < 32; ++t) { if (i - t >= 0 && i - t <= 30) y[t] += uv * w[i - t]; } }
#pragma unroll
          for (int t = 0; t < 32; ++t) Y[t * 512 + c] = y[t]; }
        __syncthreads();
        for (int t = F.wave; t < 32; t += NWAVES) { const LAS f32x4* yr = (const LAS f32x4*)(Y + t * 512 + F.lane * 8); const f32x4 a = yr[0], b = yr[1];
            float s = (a.x + a.y) + (a.z + a.w) + (b.x + b.y) + (b.z + b.w); const float mean = wave_sum(s) * (1.0f / 512.0f);
            const f32x4 da = a - mean, db = b - mean; float q = (da.x * da.x + da.y * da.y) + (da.z * da.z + da.w * da.w) + (db.x * db.x + db.y * db.y) + (db.z * db.z + db.w * db.w);
            const float rstd = rsqrtf(wave_sum(q) * (1.0f / 512.0f) + 1e-5f);
            const f32x4 g0 = *(const f32x4*)(lg + F.lane * 8), g1 = *(const f32x4*)(lg + F.lane * 8 + 4), b0 = *(const f32x4*)(lb + F.lane * 8), b1 = *(const f32x4*)(lb + F.lane * 8 + 4);
            float o[8];
#pragma unroll
            for (int i = 0; i < 4; ++i) { o[i] = siluf_(da[i] * rstd * g0[i] + b0[i]); o[4 + i] = siluf_(db[i] * rstd * g1[i] + b1[i]); }
            u32x4 wv; wv.x = cvt_pk_bf16(o[0], o[1]); wv.y = cvt_pk_bf16(o[2], o[3]); wv.z = cvt_pk_bf16(o[4], o[5]); wv.w = cvt_pk_bf16(o[6], o[7]);
            *(u32x4*)(YC + (size_t)(m0 + t) * D + F.lane * 8) = wv; }
        __syncthreads();
    }
}

__device__ __forceinline__ float rdl(float x, int l) { return __int_as_float(__builtin_amdgcn_readlane(__float_as_int(x), l)); }

constexpr int GL_LD = 72;
constexpr int GL_QD = 0, GL_KD = 9216, GL_VT = 18432, GL_ST = 36864, GL_AT = 55296, GL_O = 64512, GL_OLD = 132;
__device__ __forceinline__ int crow32(int r, int hi) { return (r & 3) + 8 * (r >> 2) + 4 * hi; }
constexpr int GL_LA = 98304;
constexpr int GL_WA = GL_LA + 16384, GL_BA = GL_WA + 4096;
__device__ __forceinline__ void gla_bcum(const u32x4 a0, const u32x4 a1, const LAS float* WAl, const LAS float* BAl, int lane, LAS float* LA, int kw, float (&bc)[8], float (&bl)[8]) {
    float al[16];
#pragma unroll
    for (int q = 0; q < 4; ++q) { al[2 * q] = bflo(a0[q]); al[2 * q + 1] = bfhi(a0[q]); al[8 + 2 * q] = bflo(a1[q]); al[8 + 2 * q + 1] = bfhi(a1[q]); }
    float la[8];
    { const f32x4 b0 = *(const LAS f32x4*)(BAl + kw), b1 = *(const LAS f32x4*)(BAl + kw + 4);
#pragma unroll
      for (int j = 0; j < 4; ++j) { la[j] = b0[j]; la[4 + j] = b1[j]; }
#pragma unroll
      for (int r = 0; r < 16; ++r) { const f32x4 w0 = *(const LAS f32x4*)(WAl + r * 64 + kw), w1 = *(const LAS f32x4*)(WAl + r * 64 + kw + 4);
#pragma unroll
          for (int j = 0; j < 4; ++j) { la[j] += al[r] * w0[j]; la[4 + j] += al[r] * w1[j]; } }
#pragma unroll
      for (int j = 0; j < 8; ++j) { const float lg = la[j]; la[j] = (fminf(lg, 0.f) - __logf(1.0f + __expf(-fabsf(lg)))) * (1.0f / 16.0f); } }
    *(LAS f32x4*)(LA + lane * 64 + kw) = (f32x4){la[0], la[1], la[2], la[3]}; *(LAS f32x4*)(LA + lane * 64 + kw + 4) = (f32x4){la[4], la[5], la[6], la[7]};
    asm volatile("s_waitcnt lgkmcnt(0)" ::: "memory");
    if (lane < 8) { float xs[64];
#pragma unroll
        for (int t = 0; t < 64; ++t) xs[t] = LA[t * 64 + kw + lane];
#pragma unroll
        for (int t = 1; t < 64; ++t) xs[t] += xs[t - 1];
#pragma unroll
        for (int t = 0; t < 64; ++t) LA[t * 64 + kw + lane] = xs[t]; }
    asm volatile("s_waitcnt lgkmcnt(0)" ::: "memory");
    const f32x4 b0 = *(const LAS f32x4*)(LA + lane * 64 + kw), b1 = *(const LAS f32x4*)(LA + lane * 64 + kw + 4), e0 = *(const LAS f32x4*)(LA + 63 * 64 + kw), e1 = *(const LAS f32x4*)(LA + 63 * 64 + kw + 4);
#pragma unroll
    for (int j = 0; j < 4; ++j) { bc[j] = b0[j]; bc[4 + j] = b1[j]; bl[j] = e0[j]; bl[4 + j] = e1[j]; }
}
__device__ __forceinline__ void gla_load_v(u32x4 (&vr)[2], const bf16_t* P0, size_t m0, int h, int tid) {
#pragma unroll
    for (int i = 0; i < 2; ++i) { const int it = tid + 512 * i, t = it & 63, d8 = (it >> 6) * 8; vr[i] = *(const u32x4*)(P0 + (m0 + t) * N0P + C_GV + h * 128 + d8); }
}
__device__ __forceinline__ void gla_stage_vt(LAS bf16_t* VT, const u32x4 (&vr)[2], int tid) {
#pragma unroll
    for (int i = 0; i < 2; ++i) { const int it = tid + 512 * i, t = it & 63, d8 = (it >> 6) * 8; const u32x4 v = vr[i];
#pragma unroll
        for (int q = 0; q < 4; ++q) { VT[(d8 + 2 * q) * GL_LD + t] = (bf16_t)(v[q] & 0xffffu); VT[(d8 + 2 * q + 1) * GL_LD + t] = (bf16_t)(v[q] >> 16); } }
}
__device__ __forceinline__ f32x16 gla_mma64(f32x16 acc, const LAS bf16_t* A, const LAS bf16_t* Bt, int r32, int hi) {
#pragma unroll
    for (int s = 0; s < 4; ++s) { const bf16x8 a = *(const LAS bf16x8*)(A + r32 * GL_LD + 16 * s + 8 * hi), b = *(const LAS bf16x8*)(Bt + r32 * GL_LD + 16 * s + 8 * hi);
        acc = __builtin_amdgcn_mfma_f32_32x32x16_bf16(a, b, acc, 0, 0, 0); }
    return acc;
}
__device__ __forceinline__ void gla_x_phase(Frame& F, const Args& A) {
    F.tid = fresh_tid(); F.lane = F.tid & 63;
    const int tid = F.tid, lane = F.lane, wave = F.wave, r32 = lane & 31, hi = lane >> 5;
    const bf16_t* P0 = (const bf16_t*)(F.ws + WS_P0); float* LT = (float*)(F.ws + WS_GLT); float* DEC = (float*)(F.ws + WS_GDEC);
    LAS bf16_t* KET = (LAS bf16_t*)(F.lds + GL_QD); LAS bf16_t* VT = (LAS bf16_t*)(F.lds + GL_VT);
    { const int hh = ((int)blockIdx.x >> 5) & 3; LAS float* WAl = (LAS float*)(F.lds + GL_WA); LAS float* BAl = (LAS float*)(F.lds + GL_BA);
      for (int i = tid; i < 1024; i += NTHR) WAl[i] = A.in[8][(i >> 6) * 256 + hh * 64 + (i & 63)];
      if (tid < 64) BAl[tid] = A.in[9][hh * 64 + tid];
      __syncthreads(); }
    u32x4 n_a0, n_a1, n_kv, n_vr[2];
#define GX_LOAD(c_) do { const int bh_ = (c_) >> 5, n_ = (c_) & 31, b_ = bh_ >> 2, h_ = bh_ & 3; const size_t m0_ = (size_t)b_ * T + n_ * 64; const bf16_t* rp_ = P0 + (m0_ + lane) * N0P; \
        n_a0 = *(const u32x4*)(rp_ + C_ALR); n_a1 = *(const u32x4*)(rp_ + C_ALR + 8); n_kv = *(const u32x4*)(rp_ + C_GK + h_ * 64 + wave * 8); gla_load_v(n_vr, P0, m0_, h_, tid); } while (0)
    GX_LOAD((int)blockIdx.x);
    for (int c = blockIdx.x; c < 1024; c += F.G) { const int bh = c >> 5, n = c & 31, b = bh >> 2, h = bh & 3; const size_t m0 = (size_t)b * T + n * 64;
        float bc[8], bl[8];
        const u32x4 a0 = n_a0, a1 = n_a1, kv = n_kv; u32x4 vr[2] = {n_vr[0], n_vr[1]};
        if (c + F.G < 1024) GX_LOAD(c + F.G);
        gla_bcum(a0, a1, (const LAS float*)(F.lds + GL_WA), (const LAS float*)(F.lds + GL_BA), lane, (LAS float*)(F.lds + GL_LA), wave * 8, bc, bl);
        {
#pragma unroll
          for (int q = 0; q < 4; ++q) { KET[(wave * 8 + 2 * q) * GL_LD + lane] = (bf16_t)f2bf(bflo(kv[q]) * __expf(bl[2 * q] - bc[2 * q])); KET[(wave * 8 + 2 * q + 1) * GL_LD + lane] = (bf16_t)f2bf(bfhi(kv[q]) * __expf(bl[2 * q + 1] - bc[2 * q + 1])); }
          if (lane < 8) { float d = bl[0];
#pragma unroll
              for (int j = 1; j < 8; ++j) d = (lane == j) ? bl[j] : d;
              DEC[(size_t)c * 64 + wave * 8 + lane] = __expf(d); } }
        gla_stage_vt(VT, vr, tid);
        __syncthreads();
        { const int tv = wave >> 1, tk = wave & 1; f32x16 acc = {}; acc = gla_mma64(acc, VT + 32 * tv * GL_LD, KET + 32 * tk * GL_LD, r32, hi);
          float* lp = LT + (size_t)c * 8192 + 32 * tk + r32;
#pragma unroll
          for (int r = 0; r < 16; ++r) lp[(32 * tv + crow32(r, hi)) * 64] = acc[r]; }
        __syncthreads();
    }
#undef GX_LOAD
}
__device__ __forceinline__ void gla_carry_phase(Frame& F, const Args& A) {
    F.tid = fresh_tid(); (void)A;
    const float* LT = (const float*)(F.ws + WS_GLT); const float* DEC = (const float*)(F.ws + WS_GDEC); bf16_t* ST = (bf16_t*)(F.ws + WS_GST);
    const int gid = F.vcu * NTHR + F.tid; if (gid >= 32 * 8192 / 2) return;
    const int e = gid * 2, bh = e >> 13, rem = e & 8191, dk = rem & 63; float S0 = 0.f, S1 = 0.f;
#pragma unroll 8
    for (int n = 0; n < 32; ++n) { const size_t c = (size_t)bh * 32 + n; *(unsigned*)(ST + c * 8192 + rem) = cvt_pk_bf16(S0, S1);
        const f32x2 l = *(const f32x2*)(LT + c * 8192 + rem), d = *(const f32x2*)(DEC + c * 64 + dk); S0 = S0 * d.x + l.x; S1 = S1 * d.y + l.y; }
}
__device__ __forceinline__ void gla_z_phase(Frame& F, const Args& A) {
    F.tid = fresh_tid(); F.lane = F.tid & 63;
    const int tid = F.tid, lane = F.lane, wave = F.wave, r32 = lane & 31, hi = lane >> 5;
    const bf16_t* P0 = (const bf16_t*)(F.ws + WS_P0); const bf16_t* STg = (const bf16_t*)(F.ws + WS_GST); bf16_t* YC = (bf16_t*)(F.ws + WS_YC0); const float* ng = A.in[10];
    LAS bf16_t* QD = (LAS bf16_t*)(F.lds + GL_QD); LAS bf16_t* KD = (LAS bf16_t*)(F.lds + GL_KD); LAS bf16_t* VT = (LAS bf16_t*)(F.lds + GL_VT); LAS bf16_t* STl = (LAS bf16_t*)(F.lds + GL_ST);
    LAS bf16_t* AT = (LAS bf16_t*)(F.lds + GL_AT); LAS float* OL = (LAS float*)(F.lds + GL_O);
    { const int hh = ((int)blockIdx.x >> 5) & 3; LAS float* WAl = (LAS float*)(F.lds + GL_WA); LAS float* BAl = (LAS float*)(F.lds + GL_BA);
      for (int i = tid; i < 1024; i += NTHR) WAl[i] = A.in[8][(i >> 6) * 256 + hh * 64 + (i & 63)];
      if (tid < 64) BAl[tid] = A.in[9][hh * 64 + tid];
      __syncthreads(); }
    u32x4 n_a0, n_a1, n_qv, n_kv, n_vr[2], n_sr[2], n_g0, n_g1;
#define GZ_LOAD(c_) do { const int bh_ = (c_) >> 5, n_ = (c_) & 31, b_ = bh_ >> 2, h_ = bh_ & 3; const size_t m0_ = (size_t)b_ * T + n_ * 64; const bf16_t* rp_ = P0 + (m0_ + lane) * N0P; \
        n_a0 = *(const u32x4*)(rp_ + C_ALR); n_a1 = *(const u32x4*)(rp_ + C_ALR + 8); n_qv = *(const u32x4*)(rp_ + C_GQ + h_ * 64 + wave * 8); n_kv = *(const u32x4*)(rp_ + C_GK + h_ * 64 + wave * 8); \
        gla_load_v(n_vr, P0, m0_, h_, tid); \
        _Pragma("unroll") for (int i_ = 0; i_ < 2; ++i_) { const int it_ = tid + 512 * i_, dv_ = it_ >> 3, c8_ = (it_ & 7) * 8; n_sr[i_] = *(const u32x4*)(STg + (size_t)(c_) * 8192 + dv_ * 64 + c8_); } \
        const bf16_t* gp_ = P0 + (m0_ + (tid >> 3)) * N0P + C_GG + h_ * 128 + (tid & 7) * 16; n_g0 = *(const u32x4*)gp_; n_g1 = *(const u32x4*)(gp_ + 8); } while (0)
    GZ_LOAD((int)blockIdx.x);
    for (int c = blockIdx.x; c < 1024; c += F.G) { const int bh = c >> 5, n = c & 31, b = bh >> 2, h = bh & 3; const size_t m0 = (size_t)b * T + n * 64;
        float bc[8], bl[8];
        const u32x4 a0 = n_a0, a1 = n_a1, qv = n_qv, kv = n_kv, g0 = n_g0, g1 = n_g1; u32x4 vr[2] = {n_vr[0], n_vr[1]}, sr[2] = {n_sr[0], n_sr[1]};
        if (c + F.G < 1024) GZ_LOAD(c + F.G);
        gla_bcum(a0, a1, (const LAS float*)(F.lds + GL_WA), (const LAS float*)(F.lds + GL_BA), lane, (LAS float*)(F.lds + GL_LA), wave * 8, bc, bl);
        { u32x4 qo, ko;
#pragma unroll
          for (int q = 0; q < 4; ++q) { const float e0 = __expf(bc[2 * q]), e1 = __expf(bc[2 * q + 1]);
              qo[q] = cvt_pk_bf16(bflo(qv[q]) * 0.125f * e0, bfhi(qv[q]) * 0.125f * e1); ko[q] = cvt_pk_bf16(bflo(kv[q]) * __builtin_amdgcn_rcpf(e0), bfhi(kv[q]) * __builtin_amdgcn_rcpf(e1)); }
          *(LAS u32x4*)(QD + lane * GL_LD + wave * 8) = qo; *(LAS u32x4*)(KD + lane * GL_LD + wave * 8) = ko; }
        gla_stage_vt(VT, vr, tid);
#pragma unroll
        for (int i = 0; i < 2; ++i) { const int it = tid + 512 * i, dv = it >> 3, c8 = (it & 7) * 8; *(LAS u32x4*)(STl + dv * GL_LD + c8) = sr[i]; }
        __syncthreads();
        if (wave < 4) { const int ti = wave >> 1, tj = wave & 1; f32x16 acc = {};
            if (tj <= ti) acc = gla_mma64(acc, QD + 32 * ti * GL_LD, KD + 32 * tj * GL_LD, r32, hi);
#pragma unroll
            for (int r = 0; r < 16; ++r) { const int il = crow32(r, hi); float v = acc[r]; if (ti == tj && r32 > il) v = 0.f; AT[(32 * ti + il) * GL_LD + 32 * tj + r32] = (bf16_t)f2bf(v); } }
        __syncthreads();
        { const int ti = wave >> 2, tn = wave & 3; f32x16 acc = {};
          acc = gla_mma64(acc, AT + 32 * ti * GL_LD, VT + 32 * tn * GL_LD, r32, hi);
          acc = gla_mma64(acc, QD + 32 * ti * GL_LD, STl + 32 * tn * GL_LD, r32, hi);
#pragma unroll
          for (int r = 0; r < 16; ++r) OL[(32 * ti + crow32(r, hi)) * GL_OLD + 32 * tn + r32] = acc[r]; }
        __syncthreads();
        { const int i = tid >> 3, seg = (tid & 7) * 16; const LAS f32x4* op = (const LAS f32x4*)(OL + i * GL_OLD + seg); f32x4 o[4]; float ss = 0.f;
#pragma unroll
          for (int q = 0; q < 4; ++q) { o[q] = op[q]; ss += (o[q].x * o[q].x + o[q].y * o[q].y) + (o[q].z * o[q].z + o[q].w * o[q].w); }
          ss += __int_as_float(__builtin_amdgcn_update_dpp(0, __float_as_int(ss), 0xB1, 0xF, 0xF, false));
          ss += __int_as_float(__builtin_amdgcn_update_dpp(0, __float_as_int(ss), 0x4E, 0xF, 0xF, false));
          ss += __int_as_float(__builtin_amdgcn_update_dpp(0, __float_as_int(ss), 0x141, 0xF, 0xF, false));
          const float rs = rsqrtf(ss * (1.0f / 128.0f) + 1e-6f);
          float res[16];
#pragma unroll
          for (int q = 0; q < 4; ++q) { const f32x4 nv = *(const f32x4*)(ng + h * 128 + seg + 4 * q); const unsigned gw0 = (q < 2) ? g0[2 * q] : g1[2 * q - 4], gw1 = (q < 2) ? g0[2 * q + 1] : g1[2 * q - 3];
              res[4 * q] = o[q].x * rs * nv.x * siluf_(bflo(gw0)); res[4 * q + 1] = o[q].y * rs * nv.y * siluf_(bfhi(gw0)); res[4 * q + 2] = o[q].z * rs * nv.z * siluf_(bflo(gw1)); res[4 * q + 3] = o[q].w * rs * nv.w * siluf_(bfhi(gw1)); }
          u32x4 w0, w1; w0.x = cvt_pk_bf16(res[0], res[1]); w0.y = cvt_pk_bf16(res[2], res[3]); w0.z = cvt_pk_bf16(res[4], res[5]); w0.w = cvt_pk_bf16(res[6], res[7]);
          w1.x = cvt_pk_bf16(res[8], res[9]); w1.y = cvt_pk_bf16(res[10], res[11]); w1.z = cvt_pk_bf16(res[12], res[13]); w1.w = cvt_pk_bf16(res[14], res[15]);
          bf16_t* yp = YC + (m0 + i) * D + 512 + h * 128 + seg; *(u32x4*)yp = w0; *(u32x4*)(yp + 8) = w1; }
        __syncthreads();
    }
#undef GZ_LOAD
}

__device__ __forceinline__ void lora_prep_phase(Frame& F, const Args& A) {
    F.tid = fresh_tid(); F.lane = F.tid & 63;
    const bf16_t* P1 = (const bf16_t*)(F.ws + WS_P1); bf16_t* AL = (bf16_t*)(F.ws + WS_ALORA); const float* mu = A.in[16];
    {
      const int gt = F.vcu * NTHR + F.tid, c8 = (gt & 31) * 8; const f32x4 mu0 = *(const f32x4*)(mu + R_XW + c8), mu1 = *(const f32x4*)(mu + R_XW + c8 + 4);
      u32x4 cur[4], prv[4];
#pragma unroll
      for (int j = 0; j < 4; ++j) { const int m = (gt >> 5) + j * (F.G * NTHR / 32); cur[j] = *(const u32x4*)(P1 + (size_t)m * N1P + R_XW + c8);
          prv[j] = ((m % T) > 0) ? *(const u32x4*)(P1 + (size_t)(m - 1) * N1P + R_XW + c8) : (u32x4){0u, 0u, 0u, 0u}; }
#pragma unroll
      for (int j = 0; j < 4; ++j) { const int m = (gt >> 5) + j * (F.G * NTHR / 32); float r[8];
#pragma unroll
          for (int q = 0; q < 4; ++q) { const float c0 = bflo(cur[j][q]), c1 = bfhi(cur[j][q]), p0 = bflo(prv[j][q]), p1 = bfhi(prv[j][q]); const float m0_ = (q < 2) ? mu0[2 * q] : mu1[2 * q - 4], m1_ = (q < 2) ? mu0[2 * q + 1] : mu1[2 * q - 3];
              r[2 * q] = c0 + (p0 - c0) * m0_; r[2 * q + 1] = c1 + (p1 - c1) * m1_; }
          if (c8 < 64) {
#pragma unroll
              for (int q = 0; q < 8; ++q) r[q] = 1.0f - 2.0f * __builtin_amdgcn_rcpf(1.0f + __expf(2.0f * r[q])); }
          else if (c8 >= 128) {
#pragma unroll
              for (int q = 0; q < 8; ++q) r[q] = sigmoidf_(r[q]); }
          u32x4 o; o.x = cvt_pk_bf16(r[0], r[1]); o.y = cvt_pk_bf16(r[2], r[3]); o.z = cvt_pk_bf16(r[4], r[5]); o.w = cvt_pk_bf16(r[6], r[7]);
          *(u32x4*)(AL + (size_t)m * 256 + c8) = o; } }
    const int gw = F.vcu * NWAVES + F.wave;
    if (gw < 64) { const int b = gw >> 3, h = gw & 7; const float* fl = (const float*)(F.ws + WS_FL32); unsigned long long* ca = (unsigned long long*)(F.ws + WS_CAUG) + (size_t)gw * T; const float bf = A.in[27][h];
        float ls[32];
#pragma unroll
        for (int i = 0; i < 32; ++i) ls[i] = fl[((size_t)b * T + F.lane * 32 + i) * 8 + h];
        float s = 0.f;
#pragma unroll
        for (int i = 0; i < 32; ++i) { const float xg = ls[i] + bf; ls[i] = fminf(xg, 0.f) - __logf(1.0f + __expf(-fabsf(xg))); s += ls[i]; }
        float inc = s;
#pragma unroll
        for (int o = 1; o < 64; o <<= 1) { const float n = __shfl_up(inc, o); if (F.lane >= o) inc += n; }
        float run = inc - s;
#pragma unroll
        for (int i = 0; i < 32; ++i) { run += ls[i];
            const float c2 = run * 1.4426950408889634f; const unsigned p1 = f2bf(c2); const float r1 = c2 - __uint_as_float(p1 << 16); const unsigned p2 = f2bf(r1); const float r2 = r1 - __uint_as_float(p2 << 16); const unsigned p3 = f2bf(r2);
            ca[F.lane * 32 + i] = (unsigned long long)(p1 | (p2 << 16)) | ((unsigned long long)p3 << 32); } }
}


__device__ __forceinline__ float dpp_sum16(float x) {
    x += __int_as_float(__builtin_amdgcn_update_dpp(0, __float_as_int(x), 0xB1, 0xF, 0xF, false));
    x += __int_as_float(__builtin_amdgcn_update_dpp(0, __float_as_int(x), 0x4E, 0xF, 0xF, false));
    x += __int_as_float(__builtin_amdgcn_update_dpp(0, __float_as_int(x), 0x141, 0xF, 0xF, false));
    x += __int_as_float(__builtin_amdgcn_update_dpp(0, __float_as_int(x), 0x140, 0xF, 0xF, false));
    return x;
}
constexpr int RW_TS = 32;
__device__ __forceinline__ void rwkv_scan_phase(Frame& F, const Args& A, int rb) {
    F.tid = fresh_tid(); F.lane = F.tid & 63;
    const int tid = F.tid, lane = F.lane, wave = F.wave;
    const int bh = rb >> 1, half = rb & 1, b = bh >> 3, h = bh & 7;
    const bf16_t* P1 = (const bf16_t*)(F.ws + WS_P1); const float* WAG = (const float*)(F.ws + WS_WAG); bf16_t* YR = (bf16_t*)(F.ws + WS_YRAW);
    const float* mu = A.in[16];
    LAS float* LW = (LAS float*)F.lds; LAS float* LKK = LW + 2048; LAS float* LBB = LKK + 2048; LAS float* LKM = LBB + 2048; LAS float* LRR = LKM + 2048; LAS float* LV = LRR + 2048; LAS float* LY = LV + 1024;
    const int ps = tid >> 4, pq = tid & 15, kc = h * 64 + pq * 4, vc = h * 64 + half * 32 + pq * 2;
    f32x4 mur, muk, kkc, kac; float muv[2];
#pragma unroll
    for (int i = 0; i < 4; ++i) { mur[i] = mu[R_R + kc + i]; muk[i] = mu[R_K + kc + i]; kkc[i] = A.in[22][kc + i]; kac[i] = A.in[23][kc + i]; }
    muv[0] = mu[R_V + vc]; muv[1] = mu[R_V + vc + 1];
    const int sq = lane & 15, vl = wave * 4 + (lane >> 4);
    f32x2 S01 = {0.f, 0.f}, S23 = {0.f, 0.f}; const bool b3 = (sq & 8) != 0, b2 = (sq & 4) != 0, b1 = (sq & 2) != 0, b0 = (sq & 1) != 0;
    u32x2 g_r, g_k, g_pr, g_pk; unsigned g_v, g_pv; f32x4 g_w, g_a;
#define RW_LOAD(t0) do { const size_t m_ = (size_t)b * T + (t0) + ps; const bf16_t* rp_ = P1 + m_ * N1P; const bool hp_ = ((t0) + ps) > 0; \
        g_r = *(const u32x2*)(rp_ + R_R + kc); g_k = *(const u32x2*)(rp_ + R_K + kc); g_v = *(const unsigned*)(rp_ + R_V + vc); \
        g_pr = hp_ ? *(const u32x2*)(rp_ - N1P + R_R + kc) : (u32x2){0u, 0u}; g_pk = hp_ ? *(const u32x2*)(rp_ - N1P + R_K + kc) : (u32x2){0u, 0u}; g_pv = hp_ ? *(const unsigned*)(rp_ - N1P + R_V + vc) : 0u; \
        g_w = *(const f32x4*)(WAG + m_ * 512 + kc); g_a = *(const f32x4*)(WAG + (size_t)M * 512 + m_ * 512 + kc); } while (0)
#define RW_PREP() do { f32x4 r_, k_, pr_, pk_; \
        r_[0] = bflo(g_r.x); r_[1] = bfhi(g_r.x); r_[2] = bflo(g_r.y); r_[3] = bfhi(g_r.y); k_[0] = bflo(g_k.x); k_[1] = bfhi(g_k.x); k_[2] = bflo(g_k.y); k_[3] = bfhi(g_k.y); \
        pr_[0] = bflo(g_pr.x); pr_[1] = bfhi(g_pr.x); pr_[2] = bflo(g_pr.y); pr_[3] = bfhi(g_pr.y); pk_[0] = bflo(g_pk.x); pk_[1] = bfhi(g_pk.x); pk_[2] = bflo(g_pk.y); pk_[3] = bfhi(g_pk.y); \
        r_ = r_ + (pr_ - r_) * mur; k_ = k_ + (pk_ - k_) * muk; \
        f32x4 kk_ = k_ * kkc; const float ss_ = dpp_sum16((kk_[0] * kk_[0] + kk_[1] * kk_[1]) + (kk_[2] * kk_[2] + kk_[3] * kk_[3])); \
        kk_ = kk_ * (1.0f / fmaxf(sqrtf(ss_), 1e-12f)); const f32x4 km_ = k_ * (1.0f + (g_a - 1.0f) * kac), bb_ = kk_ * g_a; \
        *(LAS f32x4*)(LW + ps * 64 + pq * 4) = g_w; *(LAS f32x4*)(LKK + ps * 64 + pq * 4) = kk_; *(LAS f32x4*)(LBB + ps * 64 + pq * 4) = bb_; \
        *(LAS f32x4*)(LKM + ps * 64 + pq * 4) = km_; *(LAS f32x4*)(LRR + ps * 64 + pq * 4) = r_; \
        const float v0_ = bflo(g_v), v1_ = bfhi(g_v), pv0_ = bflo(g_pv), pv1_ = bfhi(g_pv); \
        LV[ps * 32 + pq * 2] = v0_ + (pv0_ - v0_) * muv[0]; LV[ps * 32 + pq * 2 + 1] = v1_ + (pv1_ - v1_) * muv[1]; } while (0)
    RW_LOAD(0); RW_PREP();
    for (int t0 = 0; t0 < T; t0 += RW_TS) {
        __syncthreads();
        if (t0 + RW_TS < T) RW_LOAD(t0 + RW_TS);
        f32x4 wv = *(const LAS f32x4*)(LW + sq * 4), kkv = *(const LAS f32x4*)(LKK + sq * 4), bbv = *(const LAS f32x4*)(LBB + sq * 4), kmv = *(const LAS f32x4*)(LKM + sq * 4), rrv = *(const LAS f32x4*)(LRR + sq * 4); float vv = LV[vl];
        float yp[16];
#pragma unroll
        for (int s = 0; s < RW_TS; ++s) {
            f32x4 wn = wv, kkn = kkv, bbn = bbv, kmn = kmv, rrn = rrv; float vn = vv;
            if (s + 1 < RW_TS) { wn = *(const LAS f32x4*)(LW + (s + 1) * 64 + sq * 4); kkn = *(const LAS f32x4*)(LKK + (s + 1) * 64 + sq * 4); bbn = *(const LAS f32x4*)(LBB + (s + 1) * 64 + sq * 4);
                kmn = *(const LAS f32x4*)(LKM + (s + 1) * 64 + sq * 4); rrn = *(const LAS f32x4*)(LRR + (s + 1) * 64 + sq * 4); vn = LV[(s + 1) * 32 + vl]; }
            const f32x2 d2 = S01 * (f32x2){kkv[0], kkv[1]} + S23 * (f32x2){kkv[2], kkv[3]};
            const float sa = dpp_sum16(d2.x + d2.y);
            const f32x2 sa2 = {sa, sa}, v2 = {vv, vv};
            const f32x2 t01 = v2 * (f32x2){kmv[0], kmv[1]} - sa2 * (f32x2){bbv[0], bbv[1]}, t23 = v2 * (f32x2){kmv[2], kmv[3]} - sa2 * (f32x2){bbv[2], bbv[3]};
            S01 = S01 * (f32x2){wv[0], wv[1]} + t01; S23 = S23 * (f32x2){wv[2], wv[3]} + t23;
            const f32x2 e2 = S01 * (f32x2){rrv[0], rrv[1]} + S23 * (f32x2){rrv[2], rrv[3]};
            yp[s & 15] = e2.x + e2.y;
            if ((s & 15) == 15) {
                float t8[8], u4[4], w2[2];
#pragma unroll
                for (int i = 0; i < 8; ++i) { const float keep = b3 ? yp[i + 8] : yp[i], give = b3 ? yp[i] : yp[i + 8]; t8[i] = keep + __int_as_float(__builtin_amdgcn_update_dpp(0, __float_as_int(give), 0x140, 0xF, 0xF, false)); }
#pragma unroll
                for (int i = 0; i < 4; ++i) { const float keep = b2 ? t8[i + 4] : t8[i], give = b2 ? t8[i] : t8[i + 4]; u4[i] = keep + __int_as_float(__builtin_amdgcn_update_dpp(0, __float_as_int(give), 0x141, 0xF, 0xF, false)); }
#pragma unroll
                for (int i = 0; i < 2; ++i) { const float keep = b1 ? u4[i + 2] : u4[i], give = b1 ? u4[i] : u4[i + 2]; w2[i] = keep + __int_as_float(__builtin_amdgcn_update_dpp(0, __float_as_int(give), 0x1B, 0xF, 0xF, false)); }
                const float keep = b0 ? w2[1] : w2[0], give = b0 ? w2[0] : w2[1];
                LY[((s & ~15) + sq) * 32 + vl] = keep + __int_as_float(__builtin_amdgcn_update_dpp(0, __float_as_int(give), 0xB1, 0xF, 0xF, false));
            }
            wv = wn; kkv = kkn; bbv = bbn; kmv = kmn; rrv = rrn; vv = vn;
        }
        __syncthreads();
        { const float y0 = LY[ps * 32 + pq * 2], y1 = LY[ps * 32 + pq * 2 + 1];
          *(unsigned*)(YR + ((size_t)b * T + t0 + ps) * 512 + vc) = cvt_pk_bf16(y0, y1); }
        if (t0 + RW_TS < T) RW_PREP();
    }
#undef RW_LOAD
#undef RW_PREP
}
__device__ __forceinline__ void rwkv_post_phase(Frame& F, const Args& A) {
    F.tid = fresh_tid(); F.lane = F.tid & 63;
    const int gw = F.vcu * NWAVES + F.wave, NGW = F.G * NWAVES, lane = F.lane;
    const bf16_t* P1 = (const bf16_t*)(F.ws + WS_P1); const float* WAG = (const float*)(F.ws + WS_WAG); const bf16_t* YR = (const bf16_t*)(F.ws + WS_YRAW); bf16_t* YC = (bf16_t*)(F.ws + WS_YC1);
    const float* mu = A.in[16];
    const int hq = gw & 1, hc = (hq * 4 + (lane >> 4)) * 64 + (lane & 15) * 4;
    const f32x4 mur = *(const f32x4*)(mu + R_R + hc), muk = *(const f32x4*)(mu + R_K + hc), muv = *(const f32x4*)(mu + R_V + hc);
    const f32x4 ka = *(const f32x4*)(A.in[23] + hc), rk = *(const f32x4*)(A.in[24] + hc), lg = *(const f32x4*)(A.in[25] + hc), lb = *(const f32x4*)(A.in[26] + hc);
#define UNP4(dst, w) do { dst[0] = bflo((w).x); dst[1] = bfhi((w).x); dst[2] = bflo((w).y); dst[3] = bfhi((w).y); } while (0)
    for (int it0 = gw; it0 < M * 2; it0 += 2 * NGW) {
        u32x2 cr[2], ck[2], cv[2], pr[2], pk[2], pv[2], yw[2]; f32x4 a4[2], g4[2]; int mm[2]; bool ok[2];
#pragma unroll
        for (int j = 0; j < 2; ++j) { const int it = it0 + j * NGW; ok[j] = it < M * 2; const int m = ok[j] ? (it >> 1) : 0; mm[j] = m; const bf16_t* rp = P1 + (size_t)m * N1P; const bool hp = (m % T) > 0;
            cr[j] = *(const u32x2*)(rp + R_R + hc); ck[j] = *(const u32x2*)(rp + R_K + hc); cv[j] = *(const u32x2*)(rp + R_V + hc);
            pr[j] = hp ? *(const u32x2*)(rp - N1P + R_R + hc) : (u32x2){0u, 0u}; pk[j] = hp ? *(const u32x2*)(rp - N1P + R_K + hc) : (u32x2){0u, 0u}; pv[j] = hp ? *(const u32x2*)(rp - N1P + R_V + hc) : (u32x2){0u, 0u};
            a4[j] = *(const f32x4*)(WAG + (size_t)M * 512 + (size_t)m * 512 + hc); g4[j] = *(const f32x4*)(WAG + (size_t)2 * M * 512 + (size_t)m * 512 + hc); yw[j] = *(const u32x2*)(YR + (size_t)m * 512 + hc); }
#pragma unroll
        for (int j = 0; j < 2; ++j) { f32x4 r, k, v, r0, k0, v0, y;
            UNP4(r, cr[j]); UNP4(k, ck[j]); UNP4(v, cv[j]); UNP4(r0, pr[j]); UNP4(k0, pk[j]); UNP4(v0, pv[j]); UNP4(y, yw[j]);
            r = r + (r0 - r) * mur; k = k + (k0 - k) * muk; v = v + (v0 - v) * muv;
            const f32x4 km = k * (1.0f + (a4[j] - 1.0f) * ka);
            const float mean = dpp_sum16((y[0] + y[1]) + (y[2] + y[3])) * (1.0f / 64.0f); const f32x4 d = y - mean;
            const float var = dpp_sum16((d[0] * d[0] + d[1] * d[1]) + (d[2] * d[2] + d[3] * d[3])) * (1.0f / 64.0f); const float rstd = rsqrtf(var + 64e-5f);
            const f32x4 t = r * km * rk; const float bsum = dpp_sum16((t[0] + t[1]) + (t[2] + t[3]));
            const f32x4 o = (d * rstd * lg + lb + v * bsum) * g4[j];
            if (ok[j]) { u32x2 w; w.x = cvt_pk_bf16(o[0], o[1]); w.y = cvt_pk_bf16(o[2], o[3]); *(u32x2*)(YC + (size_t)mm[j] * D + hc) = w; } }
    }
#undef UNP4
}

__device__ __forceinline__ void router_phase(Frame& F, const Args& A, const bf16_t* H) {
    F.tid = fresh_tid(); F.lane = F.tid & 63;
    LAS float* RW = (LAS float*)F.lds;
    LAS int* LC = (LAS int*)(F.lds + 32768);
    LAS float* LG = (LAS float*)(F.lds + 36864);
    const float* rt = A.in[29]; const float* gf = A.in[2] + D; const pg8::u64* ssq = (const pg8::u64*)(F.ctl + CW_SSQ3);
    unsigned* cnt = F.ctl + CW_CNT; int* lists = (int*)(F.ws + WS_LIST); float* glists = (float*)(F.ws + WS_GLIST); float* rlists = (float*)(F.ws + WS_RLIST); int* toki = (int*)(F.ws + WS_TOKI);
    for (int i = F.tid; i < 8192; i += NTHR) { const int k = i >> 3, e = i & 7; RW[((e * 4 + ((k >> 2) & 3)) * 64 + (k >> 4)) * 4 + (k & 3)] = rt[i] * gf[k]; }
    __syncthreads();
    unsigned char* h8 = F.ws + WS_H3B;
    for (int blk = blockIdx.x; blk < M / 64; blk += F.G) {
        if (F.tid < 8) LC[F.tid] = 0;
        __syncthreads();
        for (int j = 0; j < 8; ++j) { const int tl = F.wave * 8 + j, m = blk * 64 + tl; const u32x4* hr = (const u32x4*)(H + (size_t)m * D) + 2 * F.lane;
            float acc[8];
#pragma unroll
            for (int e = 0; e < 8; ++e) acc[e] = 0.f;
            const u32x4 xb0 = hr[0], xb1 = hr[1]; f32x4 x[4];
            x[0] = (f32x4){bflo(xb0.x), bfhi(xb0.x), bflo(xb0.y), bfhi(xb0.y)}; x[1] = (f32x4){bflo(xb0.z), bfhi(xb0.z), bflo(xb0.w), bfhi(xb0.w)};
            x[2] = (f32x4){bflo(xb1.x), bfhi(xb1.x), bflo(xb1.y), bfhi(xb1.y)}; x[3] = (f32x4){bflo(xb1.z), bfhi(xb1.z), bflo(xb1.w), bfhi(xb1.w)};
            { u32x4 w;
              w.x = pk_fp8x4(x[0].x * pg8::Q8_H, x[0].y * pg8::Q8_H, x[0].z * pg8::Q8_H, x[0].w * pg8::Q8_H); w.y = pk_fp8x4(x[1].x * pg8::Q8_H, x[1].y * pg8::Q8_H, x[1].z * pg8::Q8_H, x[1].w * pg8::Q8_H);
              w.z = pk_fp8x4(x[2].x * pg8::Q8_H, x[2].y * pg8::Q8_H, x[2].z * pg8::Q8_H, x[2].w * pg8::Q8_H); w.w = pk_fp8x4(x[3].x * pg8::Q8_H, x[3].y * pg8::Q8_H, x[3].z * pg8::Q8_H, x[3].w * pg8::Q8_H);
              *(u32x4*)(h8 + (size_t)m * D + F.lane * 16) = w; }
#pragma unroll
            for (int q = 0; q < 4; ++q) {
#pragma unroll
                for (int e = 0; e < 8; ++e) { const f32x4 wv = *(const LAS f32x4*)(RW + ((e * 4 + q) * 64 + F.lane) * 4); acc[e] += (x[q].x * wv.x + x[q].y * wv.y) + (x[q].z * wv.z + x[q].w * wv.w); } }
            const float rs = pg8::rs_from(ssq[m]);
#pragma unroll
            for (int e = 0; e < 8; ++e) acc[e] = wave_sum(acc[e]) * rs;
            int e1 = 0; float v1 = acc[0];
#pragma unroll
            for (int e = 1; e < 8; ++e) if (acc[e] > v1) { v1 = acc[e]; e1 = e; }
            int e2 = (e1 == 0) ? 1 : 0; float v2 = -INFINITY;
#pragma unroll
            for (int e = 0; e < 8; ++e) if (e != e1 && acc[e] > v2) { v2 = acc[e]; e2 = e; }
            const float g2 = 1.0f / (1.0f + __expf(v1 - v2)), g1 = 1.0f - g2;
            if (F.lane == 0) { const int lp1 = atomicAdd((int*)&LC[e1], 1), lp2 = atomicAdd((int*)&LC[e2], 1);
                LC[16 + tl * 4 + 0] = e1; LC[16 + tl * 4 + 1] = e2; LC[16 + tl * 4 + 2] = lp1; LC[16 + tl * 4 + 3] = lp2; LG[16 + tl * 2] = g1; LG[16 + tl * 2 + 1] = g2; } }
        __syncthreads();
        if (F.tid < 8) LC[8 + F.tid] = (int)atomicAdd(cnt + F.tid, (unsigned)LC[F.tid]);
        __syncthreads();
        if (F.tid < 64) { const int tl = F.tid, m = blk * 64 + tl; const int e1 = LC[16 + tl * 4], e2 = LC[16 + tl * 4 + 1]; const int p1 = LC[8 + e1] + LC[16 + tl * 4 + 2], p2 = LC[8 + e2] + LC[16 + tl * 4 + 3];
            lists[e1 * M + p1] = m; lists[e2 * M + p2] = m; glists[e1 * M + p1] = LG[16 + tl * 2]; glists[e2 * M + p2] = LG[16 + tl * 2 + 1];
            { const float rsm = pg8::rs_from(ssq[m]); rlists[e1 * M + p1] = rsm; rlists[e2 * M + p2] = rsm; }
            *(int4*)(toki + (size_t)m * 4) = make_int4(e1, p1, e2, p2); }
        __syncthreads();
    }
}

struct MoeOrder {
    int cn[8]; int NT, G, c; bool down; const int* lists; const float* glists; int kdiv;
    __device__ __forceinline__ int total_units() const { int P = 0;
#pragma unroll
        for (int q = 0; q < 8; ++q) P += (cn[q] + 255) >> 8;
        return P * NT; }
    __device__ __forceinline__ bool split_tail() const { const int U = total_units(); return down && U > 512 && U <= 548; }
    __device__ __forceinline__ int tail_row0() const { int gp = 0, seg = 0, r0 = 0; bool f = false;
#pragma unroll
        for (int q = 0; q < 8; ++q) { const int nq = (cn[q] + 255) >> 8; if (!f && gp + nq > 128) { r0 = seg + (128 - gp) * 256; f = true; } gp += nq; seg += cn[q]; }
        return r0; }
    __device__ bool next(int i, pg8::Unit& u) const {
        const int cp = (c % 8) * (G / 8) + c / 8; int L = i * G + cp, ks = -1;
        if (split_tail() && i >= 2) { const int sub = (i - 2) * G + cp; if (sub >= MOE_KS * (total_units() - 512)) return false; L = 512 + sub / MOE_KS; ks = sub % MOE_KS; }
        int seg = 0, e = 8, np = 0, ce = 0; bool found = false;
#pragma unroll
        for (int q = 0; q < 8; ++q) { if (!found) { const int cq = cn[q], nq = (cq + 255) >> 8, ne = nq * NT; if (L < ne) { found = true; e = q; ce = cq; np = nq; } else { L -= ne; seg += cq; } } }
        if (!found) return false;
        const int full = NT >> 3, remt = NT & 7; int p, tile;
        if (L < full * np * 8) { const int tg = L / (np * 8), rem = L % (np * 8); p = rem >> 3; tile = tg * 8 + (rem & 7); }
        else { const int l2 = L - full * np * 8; p = l2 / remt; tile = full * 8 + l2 % remt; }
        u.nrows = min(256, ce - p * 256); u.orow = seg + p * 256; u.ocol = tile * 256; u.ex = 0; u.arow = seg + p * 256; u.koff = 0; u.nt = 0;
        if (ks >= 0) { u.ex = 1 + ks; u.koff = ks * (FE / MOE_KS) / kdiv; u.nt = FE / MOE_KS / 64 / kdiv; }
        if (!down) { u.brow = e * 2 * FE + tile * 256; u.rows = lists + e * M + p * 256; }
        else { u.brow = e * D + tile * 256; u.rows = (const int*)(glists + e * M + p * 256); }
        return true;
    }
};

__device__ __forceinline__ void final_phase(Frame& F, const Args& A, const bf16_t* H3, float* H) {
    F.tid = fresh_tid(); F.lane = F.tid & 63;
    const int gw = F.vcu * NWAVES + F.wave, NGW = F.G * NWAVES, lane = F.lane; const unsigned* cnt = F.ctl + CW_CNT; const int* toki = (const int*)(F.ws + WS_TOKI);
    const bf16_t* OS = (const bf16_t*)(F.ws + WS_OUTS); const bf16_t* OP = (const bf16_t*)(F.ws + WS_OUTP); const float* fg = A.in[33];
    int seg[8]; MoeOrder MO; { int s = 0;
#pragma unroll
        for (int e = 0; e < 8; ++e) { seg[e] = s; MO.cn[e] = (int)cnt[e]; s += (int)cnt[e]; } }
    MO.NT = D / 256; MO.down = true; MO.kdiv = 2; const bool split = MO.split_tail(); const int tr0 = split ? MO.tail_row0() : 0x7fffffff;
    f32x4 gv[4];
#pragma unroll
    for (int j = 0; j < 4; ++j) gv[j] = *((const f32x4*)fg + lane + 64 * j);
    for (int m0 = gw; m0 < M; m0 += 2 * NGW) {
        int sl[2][2]; f32x4 v[2][4]; u32x2 o[2][2][4];
#pragma unroll
        for (int q = 0; q < 2; ++q) { const int m = m0 + q * NGW; const int4 ti = *(const int4*)(toki + (size_t)m * 4); int s1 = 0, s2 = 0;
#pragma unroll
            for (int e = 0; e < 8; ++e) { if (ti.x == e) s1 = seg[e]; if (ti.z == e) s2 = seg[e]; }
            sl[q][0] = s1 + ti.y; sl[q][1] = s2 + ti.w; }
#pragma unroll
        for (int q = 0; q < 2; ++q) { const int m = m0 + q * NGW; const u32x2* hr = (const u32x2*)(H3 + (size_t)m * D) + lane;
#pragma unroll
            for (int j = 0; j < 4; ++j) { const u32x2 hb = hr[64 * j]; v[q][j] = (f32x4){bflo(hb.x), bfhi(hb.x), bflo(hb.y), bfhi(hb.y)}; }
#pragma unroll
            for (int w2 = 0; w2 < 2; ++w2) { const int s_ = sl[q][w2];
                if (s_ < tr0) { const u32x2* o1 = (const u32x2*)(OS + (size_t)s_ * D) + lane;
#pragma unroll
                    for (int j = 0; j < 4; ++j) o[q][w2][j] = o1[64 * j]; }
                else {
#pragma unroll
                    for (int j = 0; j < 4; ++j) o[q][w2][j] = (u32x2){0u, 0u};
                    for (int ks = 0; ks < MOE_KS; ++ks) { const u32x2* o1 = (const u32x2*)(OP + ((size_t)ks * MOE_TAIL_ROWS + (s_ - tr0)) * D) + lane;
#pragma unroll
                        for (int j = 0; j < 4; ++j) { const u32x2 a = o1[64 * j]; v[q][j].x += bflo(a.x); v[q][j].y += bfhi(a.x); v[q][j].z += bflo(a.y); v[q][j].w += bfhi(a.y); } } } } }
#pragma unroll
        for (int q = 0; q < 2; ++q) { const int m = m0 + q * NGW; float s = 0.f;
#pragma unroll
            for (int j = 0; j < 4; ++j) {
#pragma unroll
                for (int w2 = 0; w2 < 2; ++w2) { const u32x2 a = o[q][w2][j]; v[q][j].x += bflo(a.x); v[q][j].y += bfhi(a.x); v[q][j].z += bflo(a.y); v[q][j].w += bfhi(a.y); }
                s += (v[q][j].x * v[q][j].x + v[q][j].y * v[q][j].y) + (v[q][j].z * v[q][j].z + v[q][j].w * v[q][j].w); }
            const float rs = rsqrtf(wave_sum(s) * (1.0f / 1024.0f) + 1e-6f); f32x4* hw = (f32x4*)(H + (size_t)m * D) + lane;
#pragma unroll
            for (int j = 0; j < 4; ++j) hw[64 * j] = v[q][j] * rs * gv[j]; } }
}
typedef __bf16 bf16x2c_t __attribute__((ext_vector_type(2)));
__device__ __forceinline__ unsigned cvt_pk_c(float lo, float hi) { f32x2 v = {lo, hi}; bf16x2c_t b = __builtin_convertvector(v, bf16x2c_t); return __builtin_bit_cast(unsigned, b); }
constexpr int RP = 72;
constexpr int RC_A = 0, RC_B = 9216, RC_K = 18432, RC_R = 27648, RC_AT = 36864, RC_BHT = 46080, RC_KHT = 55296, RC_VT = 64512;
constexpr int RC_AAB = 73728, RC_T = 90368, RC_AAK = 107008, RC_MRK = 116224, RC_ELC = 125440, RC_TMP = 125696;
constexpr int RC_LA = RC_AAB, RC_SS = RC_T, RC_MRB = RC_A, RC_X1T = RC_B, RC_TB = RC_K, RC_WT = RC_AAB, RC_U0T = RC_T, RC_GI = RC_AT, RC_QI = RC_B;
static_assert(RC_TMP + 4096 <= RING_BYTES, "rwkv pre LDS map");
__device__ __forceinline__ size_t wag_fp(int m0, int h, int o) { return ((size_t)(m0 + (o >> 8)) * 512 + h * 64) * 4 + (o & 255); }

__device__ __forceinline__ void rwkv_pre_phase(Frame& F, const Args& A) {
    F.tid = fresh_tid(); F.lane = F.tid & 63;
    const int tid = F.tid, lane = F.lane, wave = F.wave, r32 = lane & 31, hi = lane >> 5, kw = wave * 8;
    const bf16_t* P1 = (const bf16_t*)(F.ws + WS_P1); unsigned char* WAG0 = F.ws + WS_WAG; unsigned char* WAG1 = F.ws + WS_WAG + (size_t)M * 512 * 4; float* BON = (float*)(F.ws + WS_BON);
    LAS unsigned char* L = F.lds;
    LAS bf16_t* IA = (LAS bf16_t*)(L + RC_A); LAS bf16_t* IB = (LAS bf16_t*)(L + RC_B); LAS bf16_t* IK = (LAS bf16_t*)(L + RC_K); LAS bf16_t* IR = (LAS bf16_t*)(L + RC_R);
    LAS bf16_t* IAT = (LAS bf16_t*)(L + RC_AT); LAS bf16_t* IBH = (LAS bf16_t*)(L + RC_BHT); LAS bf16_t* IKH = (LAS bf16_t*)(L + RC_KHT); LAS bf16_t* IVT = (LAS bf16_t*)(L + RC_VT);
    LAS float* AAB = (LAS float*)(L + RC_AAB); LAS float* TM = (LAS float*)(L + RC_T); LAS bf16_t* IAK = (LAS bf16_t*)(L + RC_AAK); LAS bf16_t* IMK = (LAS bf16_t*)(L + RC_MRK);
    LAS float* ELC = (LAS float*)(L + RC_ELC); LAS float* TMP = (LAS float*)(L + RC_TMP); LAS float* LA = (LAS float*)(L + RC_LA); LAS float* SS = (LAS float*)(L + RC_SS);
    LAS bf16_t* IMB = (LAS bf16_t*)(L + RC_MRB); LAS bf16_t* IX1 = (LAS bf16_t*)(L + RC_X1T); LAS bf16_t* ITB = (LAS bf16_t*)(L + RC_TB); LAS bf16_t* IWT = (LAS bf16_t*)(L + RC_WT); LAS bf16_t* IU0 = (LAS bf16_t*)(L + RC_U0T);
    LAS bf16_t* IGI = (LAS bf16_t*)(L + RC_GI); LAS bf16_t* IQI = (LAS bf16_t*)(L + RC_QI);
    const int h = ((int)blockIdx.x >> 5) & 7;
    const float* mu = A.in[16]; const int hc = h * 64 + kw;
    for (int c = blockIdx.x; c < 2048; c += F.G) {
        const int bh = c >> 5, n = c & 31, b = bh >> 3, m0 = b * T + n * 64; const bool hp = (n * 64 + lane) > 0;
        f32x4 mur[2], muk[2], muv[2], kkc[2], kac[2], rkc[2];
#pragma unroll
        for (int q = 0; q < 2; ++q) { mur[q] = *(const f32x4*)(mu + R_R + hc + 4 * q); muk[q] = *(const f32x4*)(mu + R_K + hc + 4 * q); muv[q] = *(const f32x4*)(mu + R_V + hc + 4 * q);
            kkc[q] = *(const f32x4*)(A.in[22] + hc + 4 * q); kac[q] = *(const f32x4*)(A.in[23] + hc + 4 * q); rkc[q] = *(const f32x4*)(A.in[24] + hc + 4 * q); }
        const bf16_t* rowp = P1 + (size_t)(m0 + lane) * N1P;
        const u32x4 cr = *(const u32x4*)(rowp + R_R + hc), ck = *(const u32x4*)(rowp + R_K + hc), cv = *(const u32x4*)(rowp + R_V + hc);
        const u32x4 z4 = (u32x4){0u, 0u, 0u, 0u};
        const u32x4 pr = hp ? *(const u32x4*)(rowp - N1P + R_R + hc) : z4, pk = hp ? *(const u32x4*)(rowp - N1P + R_K + hc) : z4, pv = hp ? *(const u32x4*)(rowp - N1P + R_V + hc) : z4;
        const size_t wo = ((size_t)(m0 + lane) * 512 + hc) * 4;
        const f32x4 lw0 = *(const f32x4*)(WAG0 + wo), lw1 = *(const f32x4*)(WAG0 + wo + 16), as0 = *(const f32x4*)(WAG1 + wo), as1 = *(const f32x4*)(WAG1 + wo + 16);
        float r[8], k[8], v[8], lw[8], as[8];
#pragma unroll
        for (int q = 0; q < 4; ++q) { const float m_r0 = mur[q >> 1][(q & 1) * 2], m_r1 = mur[q >> 1][(q & 1) * 2 + 1], m_k0 = muk[q >> 1][(q & 1) * 2], m_k1 = muk[q >> 1][(q & 1) * 2 + 1], m_v0 = muv[q >> 1][(q & 1) * 2], m_v1 = muv[q >> 1][(q & 1) * 2 + 1];
            float c0 = bflo(cr[q]), c1 = bfhi(cr[q]); r[2 * q] = c0 + (bflo(pr[q]) - c0) * m_r0; r[2 * q + 1] = c1 + (bfhi(pr[q]) - c1) * m_r1;
            c0 = bflo(ck[q]); c1 = bfhi(ck[q]); k[2 * q] = c0 + (bflo(pk[q]) - c0) * m_k0; k[2 * q + 1] = c1 + (bfhi(pk[q]) - c1) * m_k1;
            c0 = bflo(cv[q]); c1 = bfhi(cv[q]); v[2 * q] = c0 + (bflo(pv[q]) - c0) * m_v0; v[2 * q + 1] = c1 + (bfhi(pv[q]) - c1) * m_v1; }
#pragma unroll
        for (int j = 0; j < 4; ++j) { lw[j] = lw0[j]; lw[4 + j] = lw1[j]; as[j] = as0[j]; as[4 + j] = as1[j]; }
        float kkv[8], km[8], ssp = 0.f, bp = 0.f;
#pragma unroll
        for (int j = 0; j < 8; ++j) { kkv[j] = k[j] * kkc[j >> 2][j & 3]; ssp += kkv[j] * kkv[j]; km[j] = k[j] * (1.0f + (as[j] - 1.0f) * kac[j >> 2][j & 3]); bp += r[j] * km[j] * rkc[j >> 2][j & 3]; }
        SS[wave * 64 + lane] = ssp; SS[512 + wave * 64 + lane] = bp;
        *(LAS f32x4*)(LA + lane * 64 + kw) = lw0; *(LAS f32x4*)(LA + lane * 64 + kw + 4) = lw1;
        asm volatile("s_waitcnt lgkmcnt(0)" ::: "memory");
        if (lane < 8) { float xs[64];
#pragma unroll
            for (int t = 0; t < 64; ++t) xs[t] = LA[t * 64 + kw + lane];
#pragma unroll
            for (int t = 1; t < 64; ++t) xs[t] += xs[t - 1];
#pragma unroll
            for (int t = 0; t < 64; ++t) LA[t * 64 + kw + lane] = xs[t]; }
        asm volatile("s_waitcnt lgkmcnt(0)" ::: "memory");
        float Lc[8], LC[8];
        { const f32x4 b0 = *(const LAS f32x4*)(LA + lane * 64 + kw), b1 = *(const LAS f32x4*)(LA + lane * 64 + kw + 4), e0 = *(const LAS f32x4*)(LA + 63 * 64 + kw), e1 = *(const LAS f32x4*)(LA + 63 * 64 + kw + 4);
#pragma unroll
          for (int j = 0; j < 4; ++j) { Lc[j] = b0[j]; Lc[4 + j] = b1[j]; LC[j] = e0[j]; LC[4 + j] = e1[j]; } }
        __syncthreads();
        float ss = 0.f, bon = 0.f;
#pragma unroll
        for (int w = 0; w < 8; ++w) { ss += SS[w * 64 + lane]; bon += SS[512 + w * 64 + lane]; }
        const float inv = rsqrtf(fmaxf(ss, 1e-24f));
        if (wave == 0) BON[(size_t)(m0 + lane) * 8 + h] = bon;
        { float ia[8], ib[8], ik[8], ir[8], ibh[8], ikh[8];
#pragma unroll
          for (int j = 0; j < 8; ++j) { const float kn = kkv[j] * inv, bb = kn * as[j], eL = __expf(Lc[j]), eN = __expf(-Lc[j]), eP = __expf(Lc[j] - lw[j]), eC = __expf(LC[j] - Lc[j]);
              ia[j] = -kn * eP; ib[j] = bb * eN; ik[j] = km[j] * eN; ir[j] = r[j] * eL; ibh[j] = bb * eC; ikh[j] = km[j] * eC; }
          u32x4 w4;
#define PK8(src) (w4.x = cvt_pk_bf16(src[0], src[1]), w4.y = cvt_pk_bf16(src[2], src[3]), w4.z = cvt_pk_bf16(src[4], src[5]), w4.w = cvt_pk_bf16(src[6], src[7]), w4)
          *(LAS u32x4*)(IA + lane * RP + kw) = PK8(ia); *(LAS u32x4*)(IB + lane * RP + kw) = PK8(ib); *(LAS u32x4*)(IK + lane * RP + kw) = PK8(ik); *(LAS u32x4*)(IR + lane * RP + kw) = PK8(ir);
#undef PK8
#pragma unroll
          for (int j = 0; j < 8; ++j) { IAT[(kw + j) * RP + lane] = (bf16_t)f2bf(ia[j]); IBH[(kw + j) * RP + lane] = (bf16_t)f2bf(ibh[j]); IKH[(kw + j) * RP + lane] = (bf16_t)f2bf(ikh[j]); IVT[(kw + j) * RP + lane] = (bf16_t)f2bf(v[j]); }
          if (lane < 8) { float d = LC[0];
#pragma unroll
              for (int j = 1; j < 8; ++j) d = (lane == j) ? LC[j] : d;
              ELC[kw + lane] = __expf(d); } }
        __syncthreads();
        for (int i = tid; i < 64 * 65; i += NTHR) TM[i] = 0.f;
        { const int ti = wave >> 2, which = (wave >> 1) & 1, tj = wave & 1; f32x16 acc = {};
          if (tj <= ti) acc = gla_mma64(acc, IA + 32 * ti * RP, (which ? IK : IB) + 32 * tj * RP, r32, hi);
#pragma unroll
          for (int rr = 0; rr < 16; ++rr) { const int t = 32 * ti + crow32(rr, hi), s = 32 * tj + r32; const float val = (s < t) ? acc[rr] : 0.f;
              if (which == 0) AAB[t * 65 + s] = val; else IAK[t * RP + s] = (bf16_t)f2bf(val); } }
        __syncthreads();
        { const int ti = wave >> 2, which = (wave >> 1) & 1, tj = wave & 1; f32x16 acc = {};
          if (tj <= ti) acc = gla_mma64(acc, IR + 32 * ti * RP, (which ? IK : IB) + 32 * tj * RP, r32, hi);
          LAS bf16_t* dst = which ? IMK : IMB;
#pragma unroll
          for (int rr = 0; rr < 16; ++rr) { const int t = 32 * ti + crow32(rr, hi), s = 32 * tj + r32; float mv = (s <= t) ? acc[rr] : 0.f; if ((DBG_SKIP) & 32768) mv = (s <= t) ? 0.01f : 0.f; dst[t * RP + s] = (bf16_t)f2bf(mv); } }
        __syncthreads();
        if (wave < 4) { const int tv = wave >> 1, tt = wave & 1; f32x16 acc = {}; acc = gla_mma64(acc, IVT + 32 * tv * RP, IAK + 32 * tt * RP, r32, hi);
#pragma unroll
            for (int rr = 0; rr < 16; ++rr) IX1[(32 * tv + crow32(rr, hi)) * RP + 32 * tt + r32] = (bf16_t)f2bf(acc[rr]); }
        else if (wave == 4) {
            { int cc = lane & 15; asm volatile("" : "+v"(cc)); const int bi = lane >> 4; float x[16];
#pragma unroll
              for (int t = 0; t < 16; ++t) { float s = (t == cc) ? 1.0f : 0.f;
#pragma unroll
                  for (int q = 0; q < 16; ++q) if (q < t) s += AAB[(16 * bi + t) * 65 + 16 * bi + q] * x[q];
                  x[t] = s; TM[(16 * bi + t) * 65 + 16 * bi + cc] = s; } }
            asm volatile("s_waitcnt lgkmcnt(0)" ::: "memory");
            const int l15 = lane & 15, lq = lane >> 4;
#pragma unroll
            for (int blk = 0; blk < 2; ++blk) { const int bi = 2 * blk + 1, bj = 2 * blk; f32x4 p = {0.f, 0.f, 0.f, 0.f};
#pragma unroll
                for (int kk = 0; kk < 4; ++kk) p = __builtin_amdgcn_mfma_f32_16x16x4f32(AAB[(16 * bi + l15) * 65 + 16 * bj + 4 * kk + lq], TM[(16 * bj + 4 * kk + lq) * 65 + 16 * bj + l15], p, 0, 0, 0);
#pragma unroll
                for (int j = 0; j < 4; ++j) TMP[blk * 256 + (4 * lq + j) * 16 + l15] = p[j]; }
            asm volatile("s_waitcnt lgkmcnt(0)" ::: "memory");
#pragma unroll
            for (int blk = 0; blk < 2; ++blk) { const int bi = 2 * blk + 1, bj = 2 * blk; f32x4 p = {0.f, 0.f, 0.f, 0.f};
#pragma unroll
                for (int kk = 0; kk < 4; ++kk) p = __builtin_amdgcn_mfma_f32_16x16x4f32(TM[(16 * bi + l15) * 65 + 16 * bi + 4 * kk + lq], TMP[blk * 256 + (4 * kk + lq) * 16 + l15], p, 0, 0, 0);
#pragma unroll
                for (int j = 0; j < 4; ++j) TM[(16 * bi + 4 * lq + j) * 65 + 16 * bj + l15] = p[j]; }
            asm volatile("s_waitcnt lgkmcnt(0)" ::: "memory");
            { f32x16 x = {};
#pragma unroll
              for (int kk = 0; kk < 16; ++kk) x = __builtin_amdgcn_mfma_f32_32x32x2f32(AAB[(32 + r32) * 65 + 2 * kk + hi], TM[(2 * kk + hi) * 65 + r32], x, 0, 0, 0);
#pragma unroll
              for (int rr = 0; rr < 16; ++rr) TMP[crow32(rr, hi) * 32 + r32] = x[rr]; }
            asm volatile("s_waitcnt lgkmcnt(0)" ::: "memory");
            { f32x16 x = {};
#pragma unroll
              for (int kk = 0; kk < 16; ++kk) x = __builtin_amdgcn_mfma_f32_32x32x2f32(TM[(32 + r32) * 65 + 32 + 2 * kk + hi], TMP[(2 * kk + hi) * 32 + r32], x, 0, 0, 0);
#pragma unroll
              for (int rr = 0; rr < 16; ++rr) TM[(32 + crow32(rr, hi)) * 65 + r32] = x[rr]; }
        }
        __syncthreads();
        { const int t = tid >> 3, s8 = (tid & 7) * 8; const LAS float* tp = TM + t * 65 + s8; u32x4 w4;
          w4.x = cvt_pk_bf16(tp[0], tp[1]); w4.y = cvt_pk_bf16(tp[2], tp[3]); w4.z = cvt_pk_bf16(tp[4], tp[5]); w4.w = cvt_pk_bf16(tp[6], tp[7]); *(LAS u32x4*)(ITB + t * RP + s8) = w4; }
        __syncthreads();
        { const int t0 = (wave >> 1) & 1, t1 = wave & 1; f32x16 acc = {}; acc = gla_mma64(acc, ((wave < 4) ? IAT : IX1) + 32 * t0 * RP, ITB + 32 * t1 * RP, r32, hi);
          LAS bf16_t* dst = (wave < 4) ? IWT : IU0;
#pragma unroll
          for (int rr = 0; rr < 16; ++rr) dst[(32 * t0 + crow32(rr, hi)) * RP + 32 * t1 + r32] = (bf16_t)f2bf(acc[rr]); }
        __syncthreads();
        { const int t0 = (wave >> 1) & 1, t1 = wave & 1, tile = t0 * 2 + t1;
          if (wave < 4) {
              f32x16 g = {}; g = gla_mma64(g, IBH + 32 * t0 * RP, IWT + 32 * t1 * RP, r32, hi);
#pragma unroll
              for (int rr = 0; rr < 16; ++rr) { const int kr = 32 * t0 + crow32(rr, hi), kc = 32 * t1 + r32; IGI[kr * RP + kc] = (bf16_t)f2bf(g[rr] + ((kr == kc) ? ELC[kr] : 0.f)); }
              f32x16 j = {}; j = gla_mma64(j, IBH + 32 * t0 * RP, IU0 + 32 * t1 * RP, r32, hi); j = gla_mma64(j, IKH + 32 * t0 * RP, IVT + 32 * t1 * RP, r32, hi);
              u32x4 w0, w1; w0.x = cvt_pk_c(j[0], j[1]); w0.y = cvt_pk_c(j[2], j[3]); w0.z = cvt_pk_c(j[4], j[5]); w0.w = cvt_pk_c(j[6], j[7]);
              w1.x = cvt_pk_c(j[8], j[9]); w1.y = cvt_pk_c(j[10], j[11]); w1.z = cvt_pk_c(j[12], j[13]); w1.w = cvt_pk_c(j[14], j[15]);
              const int o = tile * 2048 + lane * 16; *(u32x4*)(WAG1 + wag_fp(m0, h, o)) = w0; *(u32x4*)(WAG1 + wag_fp(m0, h, o + 1024)) = w1;
          } else {
              f32x16 q = {}; q = gla_mma64(q, IMB + 32 * t0 * RP, IWT + 32 * t1 * RP, r32, hi);
#pragma unroll
              for (int rr = 0; rr < 16; ++rr) { const int tr = 32 * t0 + crow32(rr, hi), kc = 32 * t1 + r32; IQI[tr * RP + kc] = (bf16_t)f2bf(q[rr] + bf2f(IR[tr * RP + kc])); }
              f32x16 y = {}; if (!((DBG_SKIP) & 8192)) y = gla_mma64(y, IMB + 32 * t0 * RP, IU0 + 32 * t1 * RP, r32, hi); if (!((DBG_SKIP) & 16384)) y = gla_mma64(y, IMK + 32 * t0 * RP, IVT + 32 * t1 * RP, r32, hi);
              if ((DBG_SKIP) & 65536) { for (int rr = 0; rr < 16; ++rr) y[rr] = 0.5f; }
              if ((DBG_SKIP) & 131072) { for (int rr = 0; rr < 16; ++rr) y[rr] = bf2f(IVT[(32 * t1 + r32) * RP + 32 * t0 + crow32(rr, hi)]); }
              if ((DBG_SKIP) & 262144) { for (int rr = 0; rr < 16; ++rr) y[rr] = bf2f(IMK[(32 * t0 + crow32(rr, hi)) * RP + 32 * t1 + r32]); }
              u32x4 w0, w1; w0.x = cvt_pk_c(y[0], y[1]); w0.y = cvt_pk_c(y[2], y[3]); w0.z = cvt_pk_c(y[4], y[5]); w0.w = cvt_pk_c(y[6], y[7]);
              w1.x = cvt_pk_c(y[8], y[9]); w1.y = cvt_pk_c(y[10], y[11]); w1.z = cvt_pk_c(y[12], y[13]); w1.w = cvt_pk_c(y[14], y[15]);
              const int o = 8192 + tile * 2048 + lane * 16; *(u32x4*)(WAG1 + wag_fp(m0, h, o)) = w0; *(u32x4*)(WAG1 + wag_fp(m0, h, o + 1024)) = w1;
          } }
        __syncthreads();
#pragma unroll
        for (int p = 0; p < 2; ++p) { const int o = tid + 512 * p, which = o >> 9, row = (o >> 3) & 63, c8 = (o & 7) * 8;
            const u32x4 val = *(const LAS u32x4*)((which ? IQI : IGI) + row * RP + c8);
            *(u32x4*)(WAG0 + wag_fp(m0, h, ((which * 2 + (row >> 5)) * 4 + (c8 >> 4)) * 1024 + ((row & 31) + 32 * ((c8 >> 3) & 1)) * 16)) = val; }
        __syncthreads();
    }
}

constexpr int RS_HT0 = 0, RS_HT1 = 9216;
__device__ __forceinline__ void rwkv_cscan_phase(Frame& F, const Args& A, int bh, int probe = 0) {
    F.tid = fresh_tid(); F.lane = F.tid & 63; (void)A;
    const int tid = F.tid, lane = F.lane, wave = F.wave, r32 = lane & 31, hi = lane >> 5;
    const int b = bh >> 3, h = bh & 7, t0 = (wave >> 1) & 1, t1 = wave & 1, tile = t0 * 2 + t1; const bool stw = wave < 4;
    const unsigned char* WAG0 = F.ws + WS_WAG; const unsigned char* WAG1 = F.ws + WS_WAG + (size_t)M * 512 * 4; bf16_t* YR = (bf16_t*)(F.ws + (probe ? WS_WE2T + ((size_t)32 << 20) : WS_YRAW));
    LAS bf16_t* HT[2] = {(LAS bf16_t*)(F.lds + RS_HT0), (LAS bf16_t*)(F.lds + RS_HT1)};
    LAS bf16_t* YS = (LAS bf16_t*)(F.lds + 18432 + (wave & 3) * 2560);
    for (int i = tid; i < 2 * 64 * RP / 2; i += NTHR) ((LAS unsigned*)F.lds)[i] = 0u;
    __syncthreads();
    f32x16 acc = {};
    bf16x8 afq[4][4]; u32x4 c0q[4], c1q[4];
#define CS_LOAD(q_, n_) do { const int m0_ = b * T + (n_) * 64; \
        _Pragma("unroll") for (int s_ = 0; s_ < 4; ++s_) afq[q_][s_] = *(const bf16x8*)(WAG0 + wag_fp(m0_, h, (((stw ? 0 : 2) + t0) * 4 + s_) * 1024 + lane * 16)); \
        const int o_ = (stw ? 0 : 8192) + tile * 2048 + lane * 16; c0q[q_] = *(const u32x4*)(WAG1 + wag_fp(m0_, h, o_)); c1q[q_] = *(const u32x4*)(WAG1 + wag_fp(m0_, h, o_ + 1024)); } while (0)
#pragma unroll
    for (int q = 0; q < 4; ++q) CS_LOAD(q, q);
#ifdef SCAN_PROBE
#define CS_LOAD2(q_, n_) do { if (!probe) CS_LOAD(q_, n_); } while (0)
#else
#define CS_LOAD2(q_, n_) CS_LOAD(q_, n_)
#endif
    for (int n0 = 0; n0 < 32; n0 += 4) {
#pragma unroll
      for (int j = 0; j < 4; ++j) { const int n = n0 + j;
        const LAS bf16_t* Hc = HT[n & 1]; LAS bf16_t* Hn = HT[(n + 1) & 1];
        bf16x8 a_[4]; const u32x4 d0 = c0q[j], d1 = c1q[j];
#pragma unroll
        for (int s = 0; s < 4; ++s) a_[s] = afq[j][s];
        CS_LOAD2(j, (n + 4 < 32) ? n + 4 : 31);
        f32x16 o;
        o[0] = bflo(d0.x); o[1] = bfhi(d0.x); o[2] = bflo(d0.y); o[3] = bfhi(d0.y); o[4] = bflo(d0.z); o[5] = bfhi(d0.z); o[6] = bflo(d0.w); o[7] = bfhi(d0.w);
        o[8] = bflo(d1.x); o[9] = bfhi(d1.x); o[10] = bflo(d1.y); o[11] = bfhi(d1.y); o[12] = bflo(d1.z); o[13] = bfhi(d1.z); o[14] = bflo(d1.w); o[15] = bfhi(d1.w);
#pragma unroll
        for (int s = 0; s < 4; ++s) { const bf16x8 bfr = *(const LAS bf16x8*)(Hc + (32 * t1 + r32) * RP + 16 * s + 8 * hi); o = __builtin_amdgcn_mfma_f32_32x32x16_bf16(a_[s], bfr, o, 0, 0, 0); }
        if (stw) {
            acc = o;
#pragma unroll
            for (int g = 0; g < 4; ++g) { u32x2 w; w.x = cvt_pk_c(o[4 * g], o[4 * g + 1]); w.y = cvt_pk_c(o[4 * g + 2], o[4 * g + 3]);
                *(LAS u32x2*)(Hn + (32 * t1 + r32) * RP + 32 * t0 + 8 * g + 4 * hi) = w; }
        } else {
            const int m0 = b * T + n * 64;
#pragma unroll
            for (int rr = 0; rr < 16; ++rr) YS[crow32(rr, hi) * 40 + r32] = (bf16_t)f2bf(o[rr]);
            LDS_WAIT(); asm volatile("" ::: "memory");
#pragma unroll
            for (int i = 0; i < 2; ++i) { const int sg = lane + 64 * i, tk = sg >> 2, vs = sg & 3; const u32x4 w = *(const LAS u32x4*)(YS + tk * 40 + vs * 8);
                *(u32x4*)(YR + (size_t)(m0 + 32 * t0 + tk) * 512 + h * 64 + 32 * t1 + 8 * vs) = w; }
        }
        __syncthreads();
      }
    }
    if ((DBG_SKIP) & 1024) { for (int i = tid; i < T * 64; i += NTHR) YR[(size_t)(b * T + (i >> 6)) * 512 + h * 64 + (i & 63)] = (bf16_t)0; }
    (void)acc;
#undef CS_LOAD
}

__device__ __forceinline__ void rwkv_post2_phase(Frame& F, const Args& A) {
    F.tid = fresh_tid(); F.lane = F.tid & 63;
    const int gw = F.vcu * NWAVES + F.wave, NGW = F.G * NWAVES, lane = F.lane;
    const bf16_t* P1 = (const bf16_t*)(F.ws + WS_P1); const float* WAG = (const float*)(F.ws + WS_WAG); const bf16_t* YR = (const bf16_t*)(F.ws + WS_YRAW); bf16_t* YC = (bf16_t*)(F.ws + WS_YC1); const float* BON = (const float*)(F.ws + WS_BON);
    const float* mu = A.in[16];
    const int hq = gw & 1, hd = hq * 4 + (lane >> 4), hc = hd * 64 + (lane & 15) * 4;
    const f32x4 muv = *(const f32x4*)(mu + R_V + hc), lg = *(const f32x4*)(A.in[25] + hc), lb = *(const f32x4*)(A.in[26] + hc);
#define UNP4(dst, w) do { dst[0] = bflo((w).x); dst[1] = bfhi((w).x); dst[2] = bflo((w).y); dst[3] = bfhi((w).y); } while (0)
    for (int it0 = gw; it0 < M * 2; it0 += 2 * NGW) {
        u32x2 cv[2], pv[2], yw[2]; f32x4 g4[2]; float bo[2]; int mm[2]; bool ok[2];
#pragma unroll
        for (int j = 0; j < 2; ++j) { const int it = it0 + j * NGW; ok[j] = it < M * 2; const int m = ok[j] ? (it >> 1) : 0; mm[j] = m; const bf16_t* rp = P1 + (size_t)m * N1P; const bool hp = (m % T) > 0;
            cv[j] = *(const u32x2*)(rp + R_V + hc); pv[j] = hp ? *(const u32x2*)(rp - N1P + R_V + hc) : (u32x2){0u, 0u};
            g4[j] = *(const f32x4*)(WAG + (size_t)2 * M * 512 + (size_t)m * 512 + hc); yw[j] = ((DBG_SKIP) & 256) ? (u32x2){0u, 0u} : *(const u32x2*)(YR + (size_t)m * 512 + hc); bo[j] = ((DBG_SKIP) & 128) ? 0.f : BON[(size_t)m * 8 + hd]; }
#pragma unroll
        for (int j = 0; j < 2; ++j) { f32x4 v, v0, y; UNP4(v, cv[j]); UNP4(v0, pv[j]); UNP4(y, yw[j]);
            v = v + (v0 - v) * muv;
            const float mean = dpp_sum16((y[0] + y[1]) + (y[2] + y[3])) * (1.0f / 64.0f); const f32x4 d = y - mean;
            const float var = dpp_sum16((d[0] * d[0] + d[1] * d[1]) + (d[2] * d[2] + d[3] * d[3])) * (1.0f / 64.0f); const float rstd = rsqrtf(var + 64e-5f);
            const f32x4 o = (d * rstd * lg + lb + v * bo[j]) * g4[j];
            if (ok[j]) { u32x2 w; w.x = cvt_pk_bf16(o[0], o[1]); w.y = cvt_pk_bf16(o[2], o[3]); *(u32x2*)(YC + (size_t)mm[j] * D + hc) = w; } }
    }
#undef UNP4
}
constexpr int N_PHASES = 19;
#ifndef MK_N_LAUNCHES
#define MK_N_LAUNCHES 1
#endif
__global__ void __launch_bounds__(NTHR, 2) trunk_fwd(Args args) {
    extern __shared__ __attribute__((aligned(16))) unsigned char lds_raw[];
    Frame F;
    F.lds = (LAS unsigned char*)lds_raw;
    F.tid = fresh_tid(); F.lane = F.tid & 63; F.wave = __builtin_amdgcn_readfirstlane(F.tid >> 6);
    F.G = gridDim.x; { const int bx = blockIdx.x; F.vcu = (F.G % 8 == 0) ? (bx % 8) * (F.G / 8) + bx / 8 : bx; }
    F.ws = args.ws; F.ctl = (unsigned*)(args.ws + WS_CTL);
    unsigned char* ws = args.ws; float* H = args.out;
    for (int u = F.tid; u < (LDS_BYTES - LDSCTL_OFF) / 4; u += NTHR) ((LAS unsigned*)(F.lds + LDSCTL_OFF))[u] = 0u;
    __syncthreads();
    const int lo = args.ph_lo, hi = args.ph_hi;
    XcdBarrier bar; bar.bar = (unsigned*)(F.ctl + CW_BAR); bar.x = 0; bar.st = nullptr;
    if (hi - lo > 1) bar = xcd_barrier_post((unsigned*)(F.ctl + CW_BAR), (volatile LAS unsigned*)(F.lds + MISC_OFF) + 8);
#ifndef DBG_SKIP
#define DBG_SKIP 0
#endif
#ifndef DBL_MASK
#define DBL_MASK 0
#endif
#define REP(k) for (int rep_ = 0; rep_ < (((DBL_MASK) >> (k)) & 1) + 1; ++rep_)
#ifndef PH_MASK
#define PH_MASK 0x7FFFF
#endif
#define IN(k) ((((PH_MASK) >> (k)) & 1) && lo <= (k) && (k) < hi)
#define SEAM(k) do { if (IN(k) && IN((k) + 1)) xcd_barrier(bar); } while (0)
    constexpr int CV_G1 = 0, CV_G3 = CV_G1 + 64 * 8 * 8, CV_G5 = CV_G3 + 128 * 8 * 11, CV_LORA = CV_G5 + 128 * 8 * 11, CV_SCAN = CV_LORA + 128 * 8 * 3, CV_P11 = CV_SCAN + 192 * 8 * 0;
    typedef pg8::u64 u64; const u64* ssq0 = (const u64*)(F.ctl + CW_SSQ0); u64* ssq1 = (u64*)(F.ctl + CW_SSQ1); u64* ssq2 = (u64*)(F.ctl + CW_SSQ2); u64* ssq3 = (u64*)(F.ctl + CW_SSQ3);

    if (IN(0)) REP(0) { if (rep_) xcd_barrier(bar); p0_prologue(F, args); } SEAM(0);
#ifdef XBAR_PROBE
    for (int xb_ = 0; xb_ < XBAR_PROBE; ++xb_) XBAR_FN(bar);
#endif
    if (IN(1)) REP(1) { if (rep_) xcd_barrier(bar);
        pg8::StaticOrder S; S.init(M, N0P, F.G, (int)blockIdx.x);
        pg8::EpiRowScale E{(bf16_t*)(ws + WS_P0), N0P, ssq0, -1, -1, 1.0f, nullptr, -1};
        pg8::gemm_phase<pg8::EpiRowScale, pg8::StaticOrder, false>(F.lds, (const bf16_t*)(ws + WS_XB), (const bf16_t*)(ws + WS_W0T), D, S, E);
        if (!rep_ && (int)blockIdx.x >= 192) { __syncthreads(); moe_convert(F, args, ((int)blockIdx.x - 192) * NWAVES + F.wave, 64 * NWAVES, CV_G1, CV_G3); }
    } SEAM(1);
    if (IN(2)) REP(2) { if (rep_) xcd_barrier(bar); conv_phase(F, args); gla_x_phase(F, args); } SEAM(2);
    if (IN(3)) REP(3) { if (rep_) xcd_barrier(bar); gla_carry_phase(F, args); } SEAM(3);
    if (IN(4)) REP(4) { if (rep_) xcd_barrier(bar); gla_z_phase(F, args); } SEAM(4);
    if (IN(5)) REP(5) { if (rep_) xcd_barrier(bar);
        pg8::StaticOrder S; S.init(M, D, F.G, (int)blockIdx.x);
        pg8::EpiResid<false> E{(const bf16_t*)(ws + WS_XB), (bf16_t*)(ws + WS_H1B), nullptr, ssq1, rep_ == 0};
        pg8::gemm_phase<pg8::EpiResid<false>, pg8::StaticOrder, false>(F.lds, (const bf16_t*)(ws + WS_YC0), (const bf16_t*)(ws + WS_WO0T), D, S, E);
    } SEAM(5);
    if (IN(6)) REP(6) { if (rep_) xcd_barrier(bar);
        pg8::StaticOrder S; S.init(M, 2 * FF, F.G, (int)blockIdx.x);
        pg8::EpiSwiGLU<false> E{(bf16_t*)(ws + WS_ACT), FF, ssq1, nullptr, nullptr};
        pg8::gemm_phase<pg8::EpiSwiGLU<false>, pg8::StaticOrder, false>(F.lds, (const bf16_t*)(ws + WS_H1B), (const bf16_t*)(ws + WS_W13T), D, S, E);
        if (!rep_ && (int)blockIdx.x >= 128) { __syncthreads(); moe_convert(F, args, ((int)blockIdx.x - 128) * NWAVES + F.wave, 128 * NWAVES, CV_G3, CV_G5); }
    } SEAM(6);
    if (IN(7)) REP(7) { if (rep_) xcd_barrier(bar);
        pg8::StaticOrder S; S.init(M, D, F.G, (int)blockIdx.x);
        pg8::EpiResid<false> E{(const bf16_t*)(ws + WS_H1B), (bf16_t*)(ws + WS_H2B), nullptr, ssq2, rep_ == 0};
        pg8::gemm_phase<pg8::EpiResid<false>, pg8::StaticOrder, false>(F.lds, (const bf16_t*)(ws + WS_ACT), (const bf16_t*)(ws + WS_W2T), FF, S, E);
    } SEAM(7);
    if (IN(8)) REP(8) { if (rep_) xcd_barrier(bar);
        pg8::StaticOrder S; S.init(M, N1P, F.G, (int)blockIdx.x);
        pg8::EpiRowScale E{(bf16_t*)(ws + WS_P1), N1P, ssq2, F_Q, F_K, C2LOG, (float*)(ws + WS_FL32), F_L};
        pg8::gemm_phase<pg8::EpiRowScale, pg8::StaticOrder, false>(F.lds, (const bf16_t*)(ws + WS_H2B), (const bf16_t*)(ws + WS_W1IN), D, S, E);
        if (!rep_ && (int)blockIdx.x >= 128) { __syncthreads(); moe_convert(F, args, ((int)blockIdx.x - 128) * NWAVES + F.wave, 128 * NWAVES, CV_G5, CV_P11); }
    } SEAM(8);
    if (IN(9)) REP(9) { if (rep_) xcd_barrier(bar); lora_prep_phase(F, args); } SEAM(9);
    if (IN(10)) REP(10) { if (rep_) xcd_barrier(bar);
        pg8::StaticOrder S; S.init(M, 1536, F.G, (int)blockIdx.x);
        pg8::EpiLora E{(float*)(ws + WS_WAG), args.in[18], args.in[20], M};
        int k256 = 256; asm volatile("" : "+s"(k256));
        pg8::gemm_phase<pg8::EpiLora, pg8::StaticOrder, false>(F.lds, (const bf16_t*)(ws + WS_ALORA), (const bf16_t*)(ws + WS_LORA), k256, S, E);
        if (!rep_ && (int)blockIdx.x >= 128) { __syncthreads(); moe_convert(F, args, ((int)blockIdx.x - 128) * NWAVES + F.wave, 128 * NWAVES, CV_LORA, CV_SCAN); }
    } SEAM(10);
    if (IN(11)) REP(11) { if (rep_) xcd_barrier(bar);
        const int half_ = (int)blockIdx.x & 1, cwi_ = ((int)blockIdx.x >> 1) * NWAVES + F.wave, cnw_ = (F.G / 2) * NWAVES;
        if (half_) { moe_convert(F, args, 2 * cwi_ + 1, 2 * cnw_, CV_P11); __syncthreads(); }
        rwkv_pre_phase(F, args);
        __syncthreads();
        { const attn_body::AttnTensors AT{(const attn_body::bf16*)(ws + WS_P1) + F_Q, (const attn_body::bf16*)(ws + WS_P1) + F_K, (const attn_body::bf16*)(ws + WS_P1) + F_V, (attn_body::bf16*)(ws + WS_YC1) + 512, (const unsigned long long*)(ws + WS_CAUG)};
          const attn_body::StaticOrder S(256, (int)F.vcu);
          attn_body::attn_phase<attn_body::StaticOrder, 32>((char*)lds_raw, AT, S); }
        __syncthreads();
        if (!half_) moe_convert(F, args, 2 * cwi_, 2 * cnw_, CV_P11);
    } SEAM(11);
    if (IN(12)) REP(12) { if (rep_) xcd_barrier(bar); if (blockIdx.x < 64) rwkv_cscan_phase(F, args, (int)blockIdx.x, rep_); else if (!rep_) moe_convert(F, args, ((int)blockIdx.x - 64) * NWAVES + F.wave, 192 * NWAVES, CV_SCAN, CV_P11); } SEAM(12);
    if (IN(13)) REP(13) { if (rep_) xcd_barrier(bar); rwkv_post2_phase(F, args); } SEAM(13);
    if (IN(14)) REP(14) { if (rep_) xcd_barrier(bar);
        pg8::StaticOrder S; S.init(M, D, F.G, (int)blockIdx.x);
        pg8::EpiResid<true> E{(const bf16_t*)(ws + WS_H2B), (bf16_t*)(ws + WS_H3), ws + WS_H3B, ssq3, rep_ == 0};
        pg8::gemm_phase<pg8::EpiResid<true>, pg8::StaticOrder, false>(F.lds, (const bf16_t*)(ws + WS_YC1), (const bf16_t*)(ws + WS_WO1T), D, S, E);
    } SEAM(14);
    if (IN(15)) REP(15) { if (rep_) xcd_barrier(bar); router_phase(F, args, (const bf16_t*)(ws + WS_H3)); } SEAM(15);
    if (IN(16)) REP(16) { if (rep_) xcd_barrier(bar);
        MoeOrder S; { const unsigned* cp = F.ctl + CW_CNT; for (int e = 0; e < 8; ++e) S.cn[e] = __builtin_amdgcn_readfirstlane((int)cp[e]); } S.NT = 2 * FE / 256; S.G = F.G; S.c = (int)blockIdx.x; S.down = false; S.kdiv = 2; S.lists = (const int*)(ws + WS_LIST); S.glists = (const float*)(ws + WS_GLIST);
        pg8::EpiSwiGLU<true, true> E{(bf16_t*)(ws + WS_ACTE), FE, ssq3, (const float*)(ws + WS_RLIST), (const int*)(ws + WS_LIST)};
        pg8::gemm_phase<pg8::EpiSwiGLU<true, true>, MoeOrder, true, true>(F.lds, (const bf16_t*)(ws + WS_H3B), (const bf16_t*)(ws + WS_WE13T), D / 2, S, E);
    } SEAM(16);
    if (IN(17)) REP(17) { if (rep_) xcd_barrier(bar);
        MoeOrder S; { const unsigned* cp = F.ctl + CW_CNT; for (int e = 0; e < 8; ++e) S.cn[e] = __builtin_amdgcn_readfirstlane((int)cp[e]); } S.NT = D / 256; S.G = F.G; S.c = (int)blockIdx.x; S.down = true; S.kdiv = 2; S.lists = (const int*)(ws + WS_LIST); S.glists = (const float*)(ws + WS_GLIST);
        pg8::EpiMoeDown E{(bf16_t*)(ws + WS_OUTS), (bf16_t*)(ws + WS_OUTP), S.split_tail() ? S.tail_row0() : 0, MOE_TAIL_ROWS, 1.0f / (pg8::Q8_ACT * pg8::Q8_W)};
        pg8::gemm_phase<pg8::EpiMoeDown, MoeOrder, false, true>(F.lds, (const bf16_t*)(ws + WS_ACTE), (const bf16_t*)(ws + WS_WE2T), FE / 2, S, E);
    } SEAM(17);
    if (IN(18)) REP(18) { if (rep_) xcd_barrier(bar); final_phase(F, args, (const bf16_t*)(ws + WS_H3), H); }
#undef IN
#undef SEAM
}

extern "C" void kernel_launch(void* const* d_in, const int* in_sizes, int n_in, void* d_out, int out_size, void* d_ws, size_t ws_size, hipStream_t stream) {
    static int grid = 0;
    if (grid == 0) {
        if (n_in != 34 || out_size != M * D || ws_size < WS_END) { fprintf(stderr, "kernel_launch: unexpected problem (n_in %d out %d ws %zu need %zu)\n", n_in, out_size, ws_size, (size_t)WS_END); grid = -1; return; }
        int dev = 0, cus = 0, per_cu = 0;
        if (hipGetDevice(&dev) != hipSuccess || hipDeviceGetAttribute(&cus, hipDeviceAttributeMultiprocessorCount, dev) != hipSuccess) { grid = -1; return; }
        if (hipFuncSetAttribute((const void*)trunk_fwd, hipFuncAttributeMaxDynamicSharedMemorySize, LDS_BYTES) != hipSuccess) { fprintf(stderr, "kernel_launch: hipFuncSetAttribute failed\n"); grid = -1; return; }
        if (hipOccupancyMaxActiveBlocksPerMultiprocessor(&per_cu, (const void*)trunk_fwd, NTHR, LDS_BYTES) != hipSuccess || per_cu < 1) fprintf(stderr, "kernel_launch: occupancy query reports %d\n", per_cu);
        (void)hipGetLastError();
        grid = 256;
        if (cus < 256) { fprintf(stderr, "kernel_launch: device has %d CUs, need 256\n", cus); grid = -1; return; }
    }
    if (grid < 0) return;
    (void)in_sizes;
    (void)hipMemsetAsync((char*)d_ws + WS_CTL, 0, CTL_BYTES, stream);
    Args a{};
    for (int i = 0; i < 34; ++i) a.in[i] = (const float*)d_in[i];
    a.out = (float*)d_out; a.ws = (unsigned char*)d_ws;
    for (int li = 0; li < MK_N_LAUNCHES; ++li) {
        a.ph_lo = (MK_N_LAUNCHES == 1) ? 0 : li; a.ph_hi = (MK_N_LAUNCHES == 1) ? N_PHASES : li + 1;
        hipLaunchKernelGGL(trunk_fwd, dim3(grid), dim3(NTHR), LDS_BYTES, stream, a);
    }
}
```

```cpp
#include <hip/hip_runtime.h>
#include <hip/hip_bf16.h>
#include <cstdio>
#include <cstdint>
#include <cmath>

#define LAS __attribute__((address_space(3)))
#define GAS __attribute__((address_space(1)))
typedef unsigned short bf16_t;
typedef short bf16x8 __attribute__((ext_vector_type(8)));
typedef float f32x4 __attribute__((ext_vector_type(4)));
typedef float f32x2 __attribute__((ext_vector_type(2)));
typedef unsigned u32x4 __attribute__((ext_vector_type(4)));
typedef unsigned u32x2 __attribute__((ext_vector_type(2)));
typedef float f32x16 __attribute__((ext_vector_type(16)));
typedef int v8i32 __attribute__((ext_vector_type(8)));
__device__ __forceinline__ unsigned pk_fp8x4(float a, float b, float c, float d) { a = fminf(fmaxf(a, -448.f), 448.f); b = fminf(fmaxf(b, -448.f), 448.f); c = fminf(fmaxf(c, -448.f), 448.f); d = fminf(fmaxf(d, -448.f), 448.f);
    int w = __builtin_amdgcn_cvt_pk_fp8_f32(a, b, 0, false); w = __builtin_amdgcn_cvt_pk_fp8_f32(c, d, w, true); return (unsigned)w; }

__device__ __forceinline__ unsigned cvt_pk_bf16(float lo, float hi) { unsigned r; asm volatile("v_cvt_pk_bf16_f32 %0, %1, %2" : "=v"(r) : "v"(lo), "v"(hi)); return r; }
__device__ __forceinline__ float bf2f(bf16_t b) { return __uint_as_float(((unsigned)b) << 16); }
__device__ __forceinline__ float bflo(unsigned w) { return __uint_as_float(w << 16); }
__device__ __forceinline__ float bfhi(unsigned w) { return __uint_as_float(w & 0xffff0000u); }
__device__ __forceinline__ unsigned f2bf(float f) { unsigned u = __float_as_uint(f); return (u + 0x7fffu + ((u >> 16) & 1u)) >> 16; }
__device__ __forceinline__ unsigned pk2(float lo, float hi) { return f2bf(lo) | (f2bf(hi) << 16); }
__device__ __forceinline__ float sigmoidf_(float x) { return __builtin_amdgcn_rcpf(1.0f + __expf(-x)); }
__device__ __forceinline__ float siluf_(float x) { return x * __builtin_amdgcn_rcpf(1.0f + __expf(-x)); }
__device__ __forceinline__ float logsigmoidf_(float x) { return fminf(x, 0.f) - log1pf(__expf(-fabsf(x))); }
__device__ __forceinline__ int fresh_tid() { int t = (int)threadIdx.x; asm volatile("" : "+v"(t)); return t; }
__device__ __forceinline__ float rows_sum(float v) {
    { const auto r = __builtin_amdgcn_permlane16_swap(__float_as_uint(v), __float_as_uint(v), false, false); v = __uint_as_float(r[0]) + __uint_as_float(r[1]); }
    { const auto r = __builtin_amdgcn_permlane32_swap(__float_as_uint(v), __float_as_uint(v), false, false); v = __uint_as_float(r[0]) + __uint_as_float(r[1]); }
    return v;
}
__device__ __forceinline__ float wave_sum(float v) {
    v += __int_as_float(__builtin_amdgcn_update_dpp(0, __float_as_int(v), 0xB1, 0xF, 0xF, false));
    v += __int_as_float(__builtin_amdgcn_update_dpp(0, __float_as_int(v), 0x4E, 0xF, 0xF, false));
    v += __int_as_float(__builtin_amdgcn_update_dpp(0, __float_as_int(v), 0x141, 0xF, 0xF, false));
    v += __int_as_float(__builtin_amdgcn_update_dpp(0, __float_as_int(v), 0x140, 0xF, 0xF, false));
    return rows_sum(v);
}

#define WT_RSRC(p) __builtin_amdgcn_make_buffer_rsrc((void*)(p), 0, 0x7fffffff, 0x27000)
__device__ __forceinline__ void wt_store16(__amdgpu_buffer_rsrc_t r, unsigned off, u32x4 v) { __builtin_amdgcn_raw_buffer_store_b128(v, r, (int)off, 0, 16); }
__device__ __forceinline__ void wt_store8(__amdgpu_buffer_rsrc_t r, unsigned off, u32x2 v) { __builtin_amdgcn_raw_buffer_store_b64(v, r, (int)off, 0, 16); }
namespace pg8 {
constexpr int BM = 256, BK = 64, HALF = 128, HTB = HALF * BK * 2, STAGE_BYTES = 8 * HTB, NXCD = 8, WGM = 8;
__host__ __device__ __forceinline__ int lds_byte(int r, int c) { const int st = (r >> 4) * 2 + (c >> 5), rr = r & 15, cc = c & 31, ob = rr * 64 + cc * 2; return st * 1024 + (ob ^ (((ob >> 9) & 1) << 5)); }
__host__ __device__ __forceinline__ void stage_rc(int b, int& R, int& C) { const int st = b / 1024, sb = b % 1024, swz = sb ^ (((sb >> 9) & 1) << 5); R = (st >> 1) * 16 + swz / 64; C = (st & 1) * 32 + (swz % 64) / 2; }
__host__ __device__ __forceinline__ int perm32(int rho) { const int n = rho >> 4, i = rho & 15; return 8 * (i >> 2) + 4 * n + (i & 3); }

struct Unit { int arow; int brow; int orow; int ocol; int nrows; int ex; const int* rows; int koff; int nt; };

struct StaticOrder {
    int nM, nN, nwg, G, c;
    __device__ void init(int M, int N, int G_, int c_) { nM = M / BM; nN = N / BM; nwg = nM * nN; G = G_; c = c_; }
    __device__ bool next(int i, Unit& u) const {
        const long L = (long)i * G + c; if (L >= nwg) return false;
        int wgid = (int)L; { const int q = nwg / NXCD, r = nwg % NXCD, xcd = wgid % NXCD, off = wgid / NXCD; wgid = (xcd < r ? xcd * (q + 1) : r * (q + 1) + (xcd - r) * q) + off; }
        const int nig = WGM * nN, gid = wgid / nig, fm = gid * WGM, gsz = (nM - fm) < WGM ? (nM - fm) : WGM;
        const int pm = fm + ((wgid % nig) % gsz), pn = (wgid % nig) / gsz;
        u.arow = pm * BM; u.brow = pn * BM; u.orow = pm * BM; u.ocol = pn * BM; u.nrows = BM; u.ex = 0; u.rows = nullptr; u.koff = 0; u.nt = 0; return true;
    }
};

template <class Epi, class Sched, bool GATHER, bool FP8 = false>
__device__ __forceinline__ void gemm_phase(LAS unsigned char* lds, const bf16_t* Ab, const bf16_t* Btb, const int K, const Sched& S, const Epi& E) {
    const int tid = fresh_tid(), wid = __builtin_amdgcn_readfirstlane(tid >> 6), lane = tid & 63, wr = wid >> 2, wc = wid & 3, fr = lane & 15, fq = lane >> 4;
    const int nt = K / BK;
    int Rs[2], Cs[2]; unsigned voffB[2];
#pragma unroll
    for (int i = 0; i < 2; ++i) { int R, C; stage_rc(tid * 16 + i * 8192, R, C); const int Rb = Epi::PERM ? ((R & ~31) + perm32(R & 31)) : R; Rs[i] = R; Cs[i] = C; voffB[i] = (unsigned)(Rb * K + C) * 2u; }
    const size_t kstep = (size_t)(BK * 2);
    const size_t hstep = (size_t)HALF * K * 2;
    const unsigned ldsw = (unsigned)wid * 1024u;
    const int aoff = lds_byte(wr * 64 + fr, fq * 8), boff = lds_byte(wc * 32 + fr, fq * 8);
#define PG8_SA(b, h) (((b) * 2 + (h)) * HTB)
#define PG8_SB(b, h) ((4 + (b) * 2 + (h)) * HTB)
#define PG8_STAGE(bufoff, gbase, voff) do { _Pragma("unroll") for (int _i = 0; _i < 2; ++_i) \
        __builtin_amdgcn_global_load_lds((const unsigned*)((const char*)(gbase) + (voff)[_i]), (LAS unsigned*)(lds + (bufoff) + ldsw + _i * 8192), 16, 0, 0); } while (0)
#define PG8_LD8(dst, idx, addr0, addr1) do { const u32x4 lo_ = *(const LAS u32x4*)(addr0), hi_ = *(const LAS u32x4*)(addr1); dst[idx] = (v8i32){(int)lo_[0], (int)lo_[1], (int)lo_[2], (int)lo_[3], (int)hi_[0], (int)hi_[1], (int)hi_[2], (int)hi_[3]}; } while (0)
#define PG8_LDA(dst, b, h) do { if constexpr (FP8) { _Pragma("unroll") for (int m = 0; m < 4; ++m) PG8_LD8(dst##8, m, lds + PG8_SA(b, h) + aoff + m * 2048, lds + PG8_SA(b, h) + aoff + m * 2048 + 1024); } \
        else { _Pragma("unroll") for (int m = 0; m < 4; ++m) _Pragma("unroll") for (int k = 0; k < 2; ++k) dst[m][k] = *(const LAS bf16x8*)(lds + PG8_SA(b, h) + aoff + m * 2048 + k * 1024); } } while (0)
#define PG8_LDB(dst, b, h) do { if constexpr (FP8) { _Pragma("unroll") for (int n = 0; n < 2; ++n) PG8_LD8(dst##8, n, lds + PG8_SB(b, h) + boff + n * 2048, lds + PG8_SB(b, h) + boff + n * 2048 + 1024); } \
        else { _Pragma("unroll") for (int n = 0; n < 2; ++n) _Pragma("unroll") for (int k = 0; k < 2; ++k) dst[n][k] = *(const LAS bf16x8*)(lds + PG8_SB(b, h) + boff + n * 2048 + k * 1024); } } while (0)
#define PG8_MMA(ai, bj, At, Bt) do { __builtin_amdgcn_s_setprio(1); \
        if constexpr (FP8) { _Pragma("unroll") for (int m = 0; m < 4; ++m) _Pragma("unroll") for (int n = 0; n < 2; ++n) \
            asm volatile("v_mfma_scale_f32_16x16x128_f8f6f4 %0, %1, %2, %0, %3, %3 op_sel_hi:[0,0,0]" : "+v"(acc[ai][bj][m][n]) : "v"(Bt##8[n]), "v"(At##8[m]), "v"(one8)); } \
        else { _Pragma("unroll") for (int m = 0; m < 4; ++m) _Pragma("unroll") for (int n = 0; n < 2; ++n) _Pragma("unroll") for (int k = 0; k < 2; ++k) \
            acc[ai][bj][m][n] = __builtin_amdgcn_mfma_f32_16x16x32_bf16(Bt[n][k], At[m][k], acc[ai][bj][m][n], 0, 0, 0); } \
        __builtin_amdgcn_s_setprio(0); } while (0)
#define PG8_WAIT_V(n) asm volatile("s_waitcnt vmcnt(" #n ")" ::: "memory")
#define PG8_WAIT_L(n) asm volatile("s_waitcnt lgkmcnt(" #n ")" ::: "memory")
#define PG8_BAR __builtin_amdgcn_s_barrier()
#define PG8_SCHED __builtin_amdgcn_sched_barrier(0)
#define PG8_UNIT_A(u, base, vA) do { if constexpr (GATHER) { base = (const char*)Ab + (size_t)(u).koff * 2; \
            _Pragma("unroll") for (int _h = 0; _h < 2; ++_h) _Pragma("unroll") for (int _i = 0; _i < 2; ++_i) { const int _r = _h * HALF + Rs[_i]; const int _row = (u).rows[_r < (u).nrows ? _r : (u).nrows - 1]; vA[_h][_i] = (unsigned)(_row * K + Cs[_i]) * 2u; } } \
        else { base = (const char*)Ab + ((size_t)(u).arow * K + (u).koff) * 2; \
            _Pragma("unroll") for (int _h = 0; _h < 2; ++_h) _Pragma("unroll") for (int _i = 0; _i < 2; ++_i) vA[_h][_i] = (unsigned)((_h * HALF + Rs[_i]) * K + Cs[_i]) * 2u; } } while (0)
    Unit cur, nxt; int ui = 0;
    if (!S.next(0, cur)) return;
    f32x4 acc[2][2][4][2];
#pragma unroll
    for (int a = 0; a < 2; ++a)
#pragma unroll
        for (int b = 0; b < 2; ++b)
#pragma unroll
            for (int m = 0; m < 4; ++m)
#pragma unroll
                for (int n = 0; n < 2; ++n) acc[a][b][m][n] = (f32x4){0.f, 0.f, 0.f, 0.f};
    const int one8 = 0x7F7F7F7F;
    bf16x8 At[4][2], B0[2][2], B1[2][2]; v8i32 At8[4], B08[2], B18[2];
    const char* cA; unsigned vAc[2][2], vAn[2][2];
    PG8_UNIT_A(cur, cA, vAc);
    const char* cB = (const char*)Btb + ((size_t)cur.brow * K + cur.koff) * 2;
    typename Epi::Pre pre = E.prefetch(cur, wr, fr);
    PG8_STAGE(PG8_SB(0, 0), cB, voffB); PG8_STAGE(PG8_SB(0, 1), cB + hstep, voffB); PG8_STAGE(PG8_SA(0, 0), cA, vAc[0]); PG8_STAGE(PG8_SA(0, 1), cA, vAc[1]);
    if (wr == 1) PG8_BAR;
    PG8_WAIT_V(2); PG8_BAR;
    PG8_STAGE(PG8_SB(1, 0), cB + kstep, voffB); PG8_STAGE(PG8_SA(1, 0), cA + kstep, vAc[0]); PG8_STAGE(PG8_SB(1, 1), cB + hstep + kstep, voffB);
    PG8_WAIT_V(6); PG8_BAR;
    for (;;) {
        const bool has_next = S.next(ui + 1, nxt);
        const char* nA = cA; const char* nB = cB;
#pragma unroll
        for (int h = 0; h < 2; ++h)
#pragma unroll
            for (int i = 0; i < 2; ++i) vAn[h][i] = vAc[h][i];
        if (has_next) { PG8_UNIT_A(nxt, nA, vAn); nB = (const char*)Btb + ((size_t)nxt.brow * K + nxt.koff) * 2; }
        const int ntc = cur.nt ? cur.nt : nt;
        for (int t = 0; t < ntc; t += 2) {
            const bool last = (t == ntc - 2);
            const char* a1 = cA + (size_t)(t + 1) * kstep;
            const char* a2 = last ? nA : cA + (size_t)(t + 2) * kstep; const char* b2 = last ? nB : cB + (size_t)(t + 2) * kstep;
            const char* a3 = a2 + kstep; const char* b3 = b2 + kstep;
            unsigned vs0[2], vs1[2];
#pragma unroll
            for (int i = 0; i < 2; ++i) { vs0[i] = last ? vAn[0][i] : vAc[0][i]; vs1[i] = last ? vAn[1][i] : vAc[1][i]; }
            PG8_LDB(B0, 0, 0); PG8_LDB(B1, 0, 1); PG8_SCHED; PG8_LDA(At, 0, 0); PG8_STAGE(PG8_SA(1, 1), a1, vAc[1]);
            PG8_WAIT_V(8); PG8_WAIT_L(0); PG8_BAR; PG8_MMA(0, 0, At, B0); PG8_MMA(0, 1, At, B1); PG8_BAR; PG8_SCHED;
            PG8_LDA(At, 0, 1); PG8_STAGE(PG8_SB(0, 0), b2, voffB); PG8_STAGE(PG8_SB(0, 1), b2 + hstep, voffB); PG8_STAGE(PG8_SA(0, 0), a2, vs0);
            PG8_WAIT_V(8); PG8_WAIT_L(0); PG8_BAR; PG8_MMA(1, 0, At, B0); PG8_MMA(1, 1, At, B1); PG8_BAR; PG8_SCHED;
            PG8_LDB(B0, 1, 0); PG8_LDB(B1, 1, 1); PG8_SCHED; PG8_LDA(At, 1, 0); PG8_STAGE(PG8_SA(0, 1), a2, vs1);
            PG8_WAIT_V(8); PG8_WAIT_L(0); PG8_BAR; PG8_MMA(0, 0, At, B0); PG8_MMA(0, 1, At, B1); PG8_BAR; PG8_SCHED;
            PG8_LDA(At, 1, 1); PG8_STAGE(PG8_SB(1, 0), b3, voffB); PG8_STAGE(PG8_SB(1, 1), b3 + hstep, voffB); PG8_STAGE(PG8_SA(1, 0), a3, vs0);
            PG8_WAIT_V(8); PG8_WAIT_L(0); PG8_BAR; PG8_MMA(1, 0, At, B0); PG8_MMA(1, 1, At, B1); PG8_BAR; PG8_SCHED;
        }
        if constexpr (FP8) asm volatile("s_nop 15\n\ts_nop 7" ::: "memory");
        if (wr == 0) PG8_BAR;
        E(acc, cur, wr, wc, fr, fq, pre);
        if (!has_next) break;
#pragma unroll
        for (int a = 0; a < 2; ++a)
#pragma unroll
            for (int b = 0; b < 2; ++b)
#pragma unroll
                for (int m = 0; m < 4; ++m)
#pragma unroll
                    for (int n = 0; n < 2; ++n) acc[a][b][m][n] = (f32x4){0.f, 0.f, 0.f, 0.f};
        cur = nxt; cA = nA; cB = nB; ++ui;
        pre = E.prefetch(cur, wr, fr);
#pragma unroll
        for (int h = 0; h < 2; ++h)
#pragma unroll
            for (int i = 0; i < 2; ++i) vAc[h][i] = vAn[h][i];
        if (wr == 1) PG8_BAR;
    }
    PG8_WAIT_V(0);
    PG8_BAR;
#undef PG8_SA
#undef PG8_SB
#undef PG8_STAGE
#undef PG8_LD8
#undef PG8_LDA
#undef PG8_LDB
#undef PG8_MMA
#undef PG8_WAIT_V
#undef PG8_WAIT_L
#undef PG8_BAR
#undef PG8_SCHED
#undef PG8_UNIT_A
}
}
namespace pg8 {
constexpr float NORM_EPS = 1e-6f;
typedef unsigned u64;
constexpr float SSQ_SCALE = 1024.0f;
struct PreNone {}; struct PreU64 { u64 v[2][4]; }; struct PreF32 { float v[2][4]; };
__device__ __forceinline__ float rs_from(u64 v) { return rsqrtf((float)v * (1.0f / (1024.0f * 1024.0f)) + NORM_EPS); }
struct EpiRowScale {
    static constexpr bool PERM = true;
    bf16_t* O; int ldc; const u64* ssq; int q_lo, q_hi; float qscale; float* side; int side_col;
    typedef PreU64 Pre;
    __device__ __forceinline__ Pre prefetch(const Unit& u, int wr, int fr) const { Pre p; const int row0 = u.orow + wr * 64 + fr;
#pragma unroll
        for (int ai = 0; ai < 2; ++ai)
#pragma unroll
            for (int m = 0; m < 4; ++m) p.v[ai][m] = ssq[row0 + ai * HALF + m * 16];
        return p; }
    __device__ __forceinline__ void operator()(const f32x4 (&acc)[2][2][4][2], const Unit& u, int wr, int wc, int fr, int fq, const Pre& pre) const {
        const int row0 = u.orow + wr * 64 + fr, col0 = u.ocol + wc * 32 + 8 * fq;
        const float cs = (u.ocol >= q_lo && u.ocol < q_hi) ? qscale : 1.0f;
        const bool do_side = (side != nullptr) && (u.ocol == side_col) && (wc == 0) && (fq == 0);
        const __amdgpu_buffer_rsrc_t orsrc = WT_RSRC(O);
#pragma unroll
        for (int ai = 0; ai < 2; ++ai)
#pragma unroll
            for (int m = 0; m < 4; ++m) { const int row = row0 + ai * HALF + m * 16; const float rs = rs_from(pre.v[ai][m]) * cs;
                const unsigned rowo = (unsigned)(((size_t)row * ldc + col0) * 2);
#pragma unroll
                for (int bj = 0; bj < 2; ++bj) { const f32x4 v0 = acc[ai][bj][m][0] * rs, v1 = acc[ai][bj][m][1] * rs;
                    u32x4 w; w.x = cvt_pk_bf16(v0[0], v0[1]); w.y = cvt_pk_bf16(v0[2], v0[3]); w.z = cvt_pk_bf16(v1[0], v1[1]); w.w = cvt_pk_bf16(v1[2], v1[3]);
                    wt_store16(orsrc, rowo + bj * HALF * 2, w);
                    if (bj == 0 && do_side) { *(f32x4*)(side + (size_t)row * 8) = v0; *(f32x4*)(side + (size_t)row * 8 + 4) = v1; } } }
    }
};
constexpr float Q8_H = 8.0f, Q8_W = 256.0f, Q8_ACT = 16.0f;
template <bool Q8> struct EpiResid {
    static constexpr bool PERM = false;
    const bf16_t* resid; bf16_t* Hb; unsigned char* H8; u64* ssq_out; bool do_ssq;
    typedef PreNone Pre;
    __device__ __forceinline__ Pre prefetch(const Unit&, int, int) const { return Pre{}; }
    __device__ __forceinline__ void operator()(const f32x4 (&acc)[2][2][4][2], const Unit& u, int wr, int wc, int fr, int fq, const Pre&) const {
        const int row0 = u.orow + wr * 64 + fr, col0 = u.ocol + wc * 32 + 4 * fq;
#pragma unroll
        for (int ai = 0; ai < 2; ++ai) {
            u32x2 rv[4][2][2];
#pragma unroll
            for (int m = 0; m < 4; ++m)
#pragma unroll
                for (int bj = 0; bj < 2; ++bj)
#pragma unroll
                    for (int n = 0; n < 2; ++n) rv[m][bj][n] = *(const u32x2*)(resid + (size_t)(row0 + ai * HALF + m * 16) * 1024 + col0 + bj * HALF + n * 16);
#pragma unroll
            for (int m = 0; m < 4; ++m) { const int row = row0 + ai * HALF + m * 16; const size_t off = (size_t)row * 1024 + col0; float s = 0.f;
#pragma unroll
                for (int bj = 0; bj < 2; ++bj)
#pragma unroll
                    for (int n = 0; n < 2; ++n) { const size_t o = off + bj * HALF + n * 16; const u32x2 r2 = rv[m][bj][n];
                        const f32x4 v = acc[ai][bj][m][n] + (f32x4){bflo(r2.x), bfhi(r2.x), bflo(r2.y), bfhi(r2.y)};
                        { u32x2 w; w.x = cvt_pk_bf16(v[0], v[1]); w.y = cvt_pk_bf16(v[2], v[3]); *(u32x2*)(Hb + o) = w; }
                        s += (v[0] * v[0] + v[1] * v[1]) + (v[2] * v[2] + v[3] * v[3]); }
                s = rows_sum(s);
                if (fq == 0 && do_ssq) atomicAdd(ssq_out + row, (u64)(s * SSQ_SCALE + 0.5f)); } }
    }
};
template <bool GATHER, bool Q8 = false> struct EpiSwiGLU {
    static constexpr bool PERM = true;
    bf16_t* O; int ldo; const u64* ssq; const float* rsl; const int* lists0;
    typedef PreU64 Pre;
    __device__ __forceinline__ Pre prefetch(const Unit& u, int wr, int fr) const { Pre p;
#pragma unroll
        for (int ai = 0; ai < 2; ++ai)
#pragma unroll
            for (int m = 0; m < 4; ++m) { const int r = ai * HALF + wr * 64 + m * 16 + fr;
                if constexpr (GATHER) p.v[ai][m] = (u64)__float_as_uint(rsl[(u.rows - lists0) + (r < u.nrows ? r : u.nrows - 1)]); else p.v[ai][m] = ssq[u.orow + r]; }
        return p; }
    __device__ __forceinline__ void operator()(const f32x4 (&acc)[2][2][4][2], const Unit& u, int wr, int wc, int fr, int fq, const Pre& pre) const {
        const int col0 = (u.ocol >> 1) + wc * 32 + 8 * fq;
        const __amdgpu_buffer_rsrc_t orsrc = WT_RSRC(O);
#pragma unroll
        for (int ai = 0; ai < 2; ++ai)
#pragma unroll
            for (int m = 0; m < 4; ++m) { const int r = ai * HALF + wr * 64 + m * 16 + fr;
                if (r < u.nrows) { const int orow = u.orow + r; const float rs = (GATHER ? __uint_as_float((unsigned)pre.v[ai][m]) : rs_from(pre.v[ai][m])) * (Q8 ? 1.0f / (Q8_H * Q8_W) : 1.0f);
                    const float c1 = -1.4426950408889634f * rs, ic2 = __builtin_amdgcn_rcpf(rs * rs * (Q8 ? Q8_ACT : 1.0f));
                    const f32x2 c1v = {c1, c1}, ic2v = {ic2, ic2};
                    f32x2 o[4];
#pragma unroll
                    for (int n = 0; n < 2; ++n)
#pragma unroll
                        for (int i = 0; i < 2; ++i) { const f32x4 ga = acc[ai][0][m][n], ua = acc[ai][1][m][n];
                            const f32x2 g = i ? __builtin_shufflevector(ga, ga, 2, 3) : __builtin_shufflevector(ga, ga, 0, 1), up = i ? __builtin_shufflevector(ua, ua, 2, 3) : __builtin_shufflevector(ua, ua, 0, 1);
                            const f32x2 t = g * up, x = g * c1v; f32x2 e; e.x = __builtin_amdgcn_exp2f(x.x); e.y = __builtin_amdgcn_exp2f(x.y);
                            const f32x2 d = e * ic2v + ic2v; f32x2 rr; rr.x = __builtin_amdgcn_rcpf(d.x); rr.y = __builtin_amdgcn_rcpf(d.y);
                            o[n * 2 + i] = t * rr; }
                    if constexpr (Q8) { u32x2 w; w.x = pk_fp8x4(o[0].x, o[0].y, o[1].x, o[1].y); w.y = pk_fp8x4(o[2].x, o[2].y, o[3].x, o[3].y); *(u32x2*)((unsigned char*)O + (size_t)orow * ldo + col0) = w; }
                    else { u32x4 w; w.x = cvt_pk_bf16(o[0].x, o[0].y); w.y = cvt_pk_bf16(o[1].x, o[1].y); w.z = cvt_pk_bf16(o[2].x, o[2].y); w.w = cvt_pk_bf16(o[3].x, o[3].y);
                        wt_store16(orsrc, (unsigned)(((size_t)orow * ldo + col0) * 2), w); } } }
    }
};
struct EpiMoeDown {
    static constexpr bool PERM = true;
    bf16_t* O; bf16_t* OP; int tail_row0; int tail_rows; float oscale;
    typedef PreF32 Pre;
    __device__ __forceinline__ Pre prefetch(const Unit& u, int wr, int fr) const { Pre p; const float* gl = (const float*)u.rows;
#pragma unroll
        for (int ai = 0; ai < 2; ++ai)
#pragma unroll
            for (int m = 0; m < 4; ++m) { const int r = ai * HALF + wr * 64 + m * 16 + fr; p.v[ai][m] = gl[r < u.nrows ? r : u.nrows - 1]; }
        return p; }
    __device__ __forceinline__ void operator()(const f32x4 (&acc)[2][2][4][2], const Unit& u, int wr, int wc, int fr, int fq, const Pre& pre) const {
        asm volatile("" : "+v"(fr), "+v"(fq));
        const int col0 = u.ocol + wc * 32 + 8 * fq;
        bf16_t* base = (u.ex == 0) ? O + (size_t)u.orow * 1024 : OP + ((size_t)(u.ex - 1) * tail_rows + (u.orow - tail_row0)) * 1024;
        const __amdgpu_buffer_rsrc_t orsrc = WT_RSRC(base);
#pragma unroll
        for (int ai = 0; ai < 2; ++ai)
#pragma unroll
            for (int m = 0; m < 4; ++m) { const int r = ai * HALF + wr * 64 + m * 16 + fr;
                if (r < u.nrows) { const float gs = pre.v[ai][m] * oscale; const unsigned rowo = (unsigned)(((size_t)r * 1024 + col0) * 2);
#pragma unroll
                    for (int bj = 0; bj < 2; ++bj) { const f32x4 v0 = acc[ai][bj][m][0] * gs, v1 = acc[ai][bj][m][1] * gs;
                        u32x4 w; w.x = cvt_pk_bf16(v0[0], v0[1]); w.y = cvt_pk_bf16(v0[2], v0[3]); w.z = cvt_pk_bf16(v1[0], v1[1]); w.w = cvt_pk_bf16(v1[2], v1[3]);
                        wt_store16(orsrc, rowo + bj * HALF * 2, w); } } }
    }
};
struct EpiLora {
    static constexpr bool PERM = false;
    float* WAG; const float* w0; const float* a0; int M;
    typedef PreNone Pre;
    __device__ __forceinline__ Pre prefetch(const Unit&, int, int) const { return Pre{}; }
    __device__ __forceinline__ void operator()(const f32x4 (&acc)[2][2][4][2], const Unit& u, int wr, int wc, int fr, int fq, const Pre&) const {
        const int type = u.ocol >> 9, colt = (u.ocol & 511) + wc * 32 + 4 * fq, row0 = u.orow + wr * 64 + fr;
        float* base = WAG + (size_t)type * M * 512;
        const __amdgpu_buffer_rsrc_t orsrc = WT_RSRC(base);
        f32x4 bv[2][2];
#pragma unroll
        for (int bj = 0; bj < 2; ++bj)
#pragma unroll
            for (int n = 0; n < 2; ++n) { const int c = colt + bj * HALF + n * 16; bv[bj][n] = type == 0 ? *(const f32x4*)(w0 + c) : (type == 1 ? *(const f32x4*)(a0 + c) : (f32x4){0.f, 0.f, 0.f, 0.f}); }
#pragma unroll
        for (int ai = 0; ai < 2; ++ai)
#pragma unroll
            for (int m = 0; m < 4; ++m) { const int row = row0 + ai * HALF + m * 16;
#pragma unroll
                for (int bj = 0; bj < 2; ++bj)
#pragma unroll
                    for (int n = 0; n < 2; ++n) { f32x4 v = acc[ai][bj][m][n] + bv[bj][n];
                        if (type == 0) {
#pragma unroll
                            for (int i = 0; i < 4; ++i) v[i] = -0.606531f * __builtin_amdgcn_rcpf(1.0f + __expf(-v[i])); }
                        else if (type == 1) {
#pragma unroll
                            for (int i = 0; i < 4; ++i) v[i] = __builtin_amdgcn_rcpf(1.0f + __expf(-v[i])); }
                        wt_store16(orsrc, (unsigned)(((size_t)row * 512 + colt + bj * HALF + n * 16) * 4), __builtin_bit_cast(u32x4, v)); } }
    }
};
}
#ifndef DBL_MASK
#define DBL_MASK 0
#endif
#ifndef DBG_SKIP
#define DBG_SKIP 0
#endif
constexpr int NB = 8, T = 2048, M = NB * T, D = 1024;
constexpr int N0 = 2576, N0P = 2816;
constexpr int C_VAL = 0, C_GATE = 512, C_GQ = 1024, C_GK = 1280, C_GV = 1536, C_GG = 2048, C_ALR = 2560;
constexpr int N1 = 3336, N1P = 3584;
constexpr int R_R = 0, R_K = 512, R_V = 1024, R_XW = 1536, R_XA = 1600, R_XG = 1664, F_Q = 1792, F_K = 2304, F_V = 2816, F_L = 3328;
constexpr int FF = 2816, FE = 3584, NE = 8;
constexpr float C2LOG = 0.125f * 1.4426950408889634f;
constexpr int NWAVES = 8, NTHR = 512;

constexpr size_t WS_CTL = 0, CTL_BYTES = 1u << 20;
constexpr size_t WS_WO1T = CTL_BYTES;
constexpr size_t WS_W0T = WS_WO1T + (size_t)D * D * 2;
constexpr size_t WS_WO0T = WS_W0T + (size_t)N0P * D * 2;
constexpr size_t WS_W13T = WS_WO0T + (size_t)D * D * 2;
constexpr size_t WS_W2T = WS_W13T + (size_t)2 * FF * D * 2;
constexpr size_t WS_W1IN = WS_W2T + (size_t)D * FF * 2;
constexpr size_t WS_LORA = WS_W1IN + (size_t)N1P * D * 2;
constexpr size_t WS_WE13T = WS_LORA + (size_t)1536 * 256 * 2;
constexpr size_t WS_WE2T = WS_WE13T + (size_t)NE * 2 * FE * D * 2;
constexpr size_t RB = WS_WE2T + (size_t)NE * D * FE * 2;
constexpr size_t MB335 = (size_t)M * D * 2;
constexpr size_t WS_XB = RB;
constexpr size_t WS_P0 = RB + MB335;
constexpr size_t WS_YC0 = WS_P0 + (size_t)M * N0P * 2;
constexpr size_t WS_H1B = WS_YC0 + MB335;
constexpr size_t WS_GLT = WS_H1B + MB335;
constexpr size_t WS_GST = WS_GLT + (size_t)1024 * 8192 * 4;
constexpr size_t WS_GDEC = WS_GST + (size_t)1024 * 8192 * 2;
constexpr size_t WS_ACT = RB;
constexpr size_t WS_H2B = WS_WE13T + ((size_t)60 << 20);
static_assert((size_t)NE * 2 * FE * D <= ((size_t)60 << 20) && WS_H2B + MB335 <= WS_WE2T, "h2 fits above the fp8 up-weights");
constexpr size_t WS_H3 = WS_H1B;
constexpr size_t WS_P1 = RB;
constexpr size_t WS_FL32 = RB + (size_t)120 * 1000000;
constexpr size_t WS_CFOX = RB + (size_t)121 * 1000000;
constexpr size_t WS_BON = RB + (size_t)118 * 1000000;
constexpr size_t WS_CAUG = RB + (size_t)122 * 1000000;
constexpr size_t WS_YRAW = WS_W0T;
constexpr size_t WS_ALORA = WS_H1B;
constexpr size_t WS_WAG = WS_H1B + (size_t)M * 256 * 2;
constexpr size_t WS_YC1 = WS_YC0;
constexpr size_t WS_ACTE = RB;
constexpr size_t WS_H3B = RB + (size_t)(32768 + 256) * FE * 2;
constexpr size_t WS_LIST = WS_H3B + MB335;
constexpr size_t WS_GLIST = WS_LIST + (size_t)NE * M * 4;
constexpr size_t WS_RLIST = WS_GLIST + (size_t)NE * M * 4;
constexpr size_t WS_TOKI = WS_RLIST + (size_t)NE * M * 4;
constexpr size_t WS_OUTS = WS_WE13T;
constexpr int MOE_KS = 7, MOE_TAIL_ROWS = 2304;
constexpr size_t WS_OUTP = WS_OUTS + (size_t)32768 * D * 2;
static_assert(WS_OUTP + (size_t)MOE_KS * MOE_TAIL_ROWS * D * 2 <= WS_WE2T, "tail slabs fit over the dead up-weights");
constexpr size_t WS_END = WS_TOKI + (size_t)M * 16;
static_assert(WS_P1 + (size_t)M * N1P * 2 <= WS_BON && WS_BON + (size_t)M * 8 * 4 <= WS_FL32, "bonus map");
static_assert(WS_P1 + (size_t)M * N1P * 2 <= WS_FL32 && WS_CFOX + 64 * 2048 * 4 <= WS_CAUG && WS_CAUG + 64 * 2048 * 8 <= WS_YC0, "layer-1 map");
static_assert(WS_GDEC + 1024 * 64 * 4 <= WS_END, "gla map");
static_assert(WS_YRAW + (size_t)M * 512 * 2 <= WS_W2T && WS_WAG + (size_t)3 * M * 512 * 4 <= WS_END && WS_END <= 487325728ull, "ws map");
constexpr int CW_BAR = 4096, CW_CNT = 8192, CW_SSQ1 = 16384, CW_SSQ2 = 49152, CW_SSQ3 = 81920, CW_SSQ0 = 114688;

constexpr int RING_BYTES = 131072, LDSCTL_OFF = RING_BYTES, MISC_OFF = LDSCTL_OFF + 320, LDS_BYTES = 147456;

#define RLX_AGENT __ATOMIC_RELAXED, __HIP_MEMORY_SCOPE_AGENT
#define LDS_WAIT() asm volatile("s_waitcnt lgkmcnt(0)" ::: "memory")
#define VM_WAIT() asm volatile("s_waitcnt vmcnt(0)" ::: "memory")
#define XB_TMO      128
#define XB_XCNT(j)  (256  + 64 * (j))
#define XB_XSUB(j)  (1280 + 64 * (j))
#define XB_XGEN(j)  (2304 + 64 * (j))
#define XB_TOP      3328
#define XB_TOPGEN   3392
#define XCD_BAR_WORDS 3456
#define XB_SPIN_CAP (1u << 18)

__device__ __forceinline__ unsigned xb_ld(unsigned* p)              { return __hip_atomic_load(p, __ATOMIC_RELAXED, __HIP_MEMORY_SCOPE_AGENT); }
__device__ __forceinline__ unsigned xb_add(unsigned* p, unsigned v) { return __hip_atomic_fetch_add(p, v, __ATOMIC_RELAXED, __HIP_MEMORY_SCOPE_AGENT); }
__device__ __forceinline__ unsigned xb_xcc_id() { return (unsigned)__builtin_amdgcn_s_getreg((3 << 11) | 20) & 0xFu; }
#define XB_SPIN(cond, bar) do { unsigned _sp = 0; while (cond) { __builtin_amdgcn_s_sleep(1); \
    if ((++_sp & 255u) == 0u) { if (xb_ld(&(bar)[XB_TMO])) break; if (_sp > XB_SPIN_CAP) { atomicAdd(&(bar)[XB_TMO], 1u); break; } } } } while (0)

struct XcdBarrier {
    unsigned* bar; unsigned x;
    volatile LAS unsigned* st;
};

__device__ __forceinline__ XcdBarrier xcd_barrier_post(unsigned* bar, volatile LAS unsigned* st) {
    XcdBarrier b; b.bar = bar; b.x = xb_xcc_id(); b.st = st;
    if (threadIdx.x == 0) (void)xb_add(&bar[XB_XCNT(b.x)], 1u);
    return b;
}
__device__ __forceinline__ void xcd_barrier_complete(unsigned* bar, unsigned x, unsigned& nloc, unsigned& nx) {
    const unsigned G = gridDim.x * gridDim.y * gridDim.z;
    unsigned sum, cnt, mine, sp = 0u;
    for (;;) {
        sum = 0u; cnt = 0u; mine = 0u;
#pragma unroll
        for (unsigned j = 0; j < 16; ++j) { const unsigned c = xb_ld(&bar[XB_XCNT(j)]); sum += c; cnt += (c > 0u) ? 1u : 0u; mine = (j == x) ? c : mine; }
        if (sum == G) break;
        __builtin_amdgcn_s_sleep(1);
        if ((++sp & 255u) == 0u) { if (xb_ld(&bar[XB_TMO])) break; if (sp > XB_SPIN_CAP) { atomicAdd(&bar[XB_TMO], 1u); break; } }
    }
    nloc = mine > 0u ? mine : 1u; nx = cnt > 0u ? cnt : 1u;
}

__device__ __forceinline__ void xcd_barrier(const XcdBarrier& b) {
    asm volatile("s_waitcnt vmcnt(0)" ::: "memory");
    __syncthreads();
    if (threadIdx.x == 0) {
        unsigned* bar = b.bar;
        __builtin_amdgcn_s_waitcnt(0);
        unsigned nloc = b.st[0], nx = b.st[1];
        if (nloc == 0u) { xcd_barrier_complete(bar, b.x, nloc, nx); b.st[0] = nloc; b.st[1] = nx; }
        const unsigned old = xb_add(&bar[XB_XSUB(b.x)], 1u);
        const unsigned gen = old / nloc;
        if (old + 1u == (gen + 1u) * nloc) {
            __builtin_amdgcn_fence(__ATOMIC_RELEASE, "agent");
            asm volatile("s_waitcnt vmcnt(0)" ::: "memory");
            const unsigned og = xb_add(&bar[XB_TOP], 1u);
            const unsigned tg = og / nx;
            if (og + 1u == (tg + 1u) * nx) xb_add(&bar[XB_TOPGEN], 1u);
            else XB_SPIN(xb_ld(&bar[XB_TOPGEN]) == tg, bar);
            __builtin_amdgcn_fence(__ATOMIC_ACQUIRE, "agent");
            xb_add(&bar[XB_XGEN(b.x)], 1u);
            asm volatile("s_waitcnt vmcnt(0)" ::: "memory");
        } else {
            XB_SPIN(xb_ld(&bar[XB_XGEN(b.x)]) == gen, bar);
            __builtin_amdgcn_fence(__ATOMIC_ACQUIRE, "agent");
            asm volatile("s_waitcnt vmcnt(0)" ::: "memory");
        }
    }
    __syncthreads();
}
namespace attn_body {
using bf16=__hip_bfloat16;
using bf16x8=__attribute__((ext_vector_type(8)))short;
using s16x4=__attribute__((ext_vector_type(4)))short;
using f32x16=__attribute__((ext_vector_type(16)))float;
using u32x4=__attribute__((ext_vector_type(4)))unsigned;
constexpr int BATCH=8,NHEAD=8,SEQ=2048,D=64,DM=3584,DMO=1024;
constexpr int NW=8,QBLK=32,QB=QBLK*NW,KVBLK=64,NQB=SEQ/QB;
constexpr int ATTN_PITCH=DM, ATTN_UNIT_ROWS=QB;
__device__ __forceinline__ int crow(int r,int hi){return (r&3)+8*(r>>2)+4*hi;}
#define SBAR() __builtin_amdgcn_sched_barrier(0)
__device__ __forceinline__ void cmask(f32x16&p0,f32x16&p1,int jb,int qrel,int hi){
  const float NEG=-INFINITY; int kb=64*jb+4*hi;
  #pragma unroll
  for(int r=0;r<16;++r){int kv=kb+(r&3)+8*(r>>2); if(kv>qrel)p0[r]=NEG; if(kv+32>qrel)p1[r]=NEG;}
}

constexpr int NSLOT=3, SLOTB=8192;
constexpr int LDS_K=0, LDS_V=NSLOT*SLOTB, LDS_WS=2*NSLOT*SLOTB, LDS_OST=LDS_WS+NW*64*4, LDS_AUG=LDS_OST+NW*4096, LDS_BYTES=LDS_AUG+SEQ*8+64;
constexpr float C2=0.125f*1.4426950408889634f;
__device__ __forceinline__ void glds16(const void*gsrc,unsigned lds_dst){unsigned keep;
  asm volatile("s_mov_b32 %0, m0\n\ts_mov_b32 m0, %2\n\ts_nop 0\n\tglobal_load_lds_dwordx4 %1, off\n\ts_mov_b32 m0, %0":"=&s"(keep):"v"(gsrc),"s"(lds_dst):"memory");}
__device__ __forceinline__ float max3f(float a,float b,float c){float r;asm("v_max3_f32 %0, %1, %2, %3":"=v"(r):"v"(a),"v"(b),"v"(c));return r;}
__device__ __forceinline__ float max2f(float a,float b){float r;asm("v_max_f32_e32 %0, %1, %2":"=v"(r):"v"(a),"v"(b));return r;}
__device__ __forceinline__ float fadd_s(float a,float b){float r;asm("v_add_f32_e32 %0, %1, %2":"=v"(r):"v"(a),"v"(b));return r;}
__device__ __forceinline__ float fsub_s(float a,float b){float r;asm("v_sub_f32_e32 %0, %1, %2":"=v"(r):"v"(a),"v"(b));return r;}
typedef float f32x2_t __attribute__((ext_vector_type(2))); typedef __bf16 bf16x2_t __attribute__((ext_vector_type(2)));
__device__ __forceinline__ unsigned cvtpk_s(float lo,float hi){f32x2_t v={lo,hi};bf16x2_t b=__builtin_convertvector(v,bf16x2_t);return __builtin_bit_cast(unsigned,b);}
#define WAIT_BAR(N) asm volatile("s_waitcnt vmcnt(" #N ") lgkmcnt(0)\n\ts_barrier":::"memory")

__device__ __forceinline__ void qkt(f32x16&p0,f32x16&p1,const char*Kslot,const bf16x8*qr,int r32,int hi,bf16x8 ka0,bf16x8 ka1,bf16x8 qa){ const f32x16 negm=f32x16{};
  const char*kb=Kslot+hi*1024+r32*16;
  p0=__builtin_amdgcn_mfma_f32_32x32x16_bf16(ka0,qa,negm,0,0,0);p1=__builtin_amdgcn_mfma_f32_32x32x16_bf16(ka1,qa,negm,0,0,0);
  #pragma unroll
  for(int d0=0;d0<4;++d0){
    const bf16x8 b0=*reinterpret_cast<const bf16x8*>(kb+d0*2048);
    const bf16x8 b1=*reinterpret_cast<const bf16x8*>(kb+d0*2048+512);
    p0=__builtin_amdgcn_mfma_f32_32x32x16_bf16(b0,qr[d0],p0,0,0,0);p1=__builtin_amdgcn_mfma_f32_32x32x16_bf16(b1,qr[d0],p1,0,0,0);}
}
typedef __attribute__((address_space(3))) const char* lds_cptr;
typedef short v4i16_t __attribute__((ext_vector_type(4)));
__device__ __forceinline__ void kload8(bf16x8*kf,lds_cptr kp){
  kf[0]=*(const __attribute__((address_space(3))) bf16x8*)(kp);      kf[1]=*(const __attribute__((address_space(3))) bf16x8*)(kp+512);
  kf[2]=*(const __attribute__((address_space(3))) bf16x8*)(kp+2048); kf[3]=*(const __attribute__((address_space(3))) bf16x8*)(kp+2560);
  kf[4]=*(const __attribute__((address_space(3))) bf16x8*)(kp+4096); kf[5]=*(const __attribute__((address_space(3))) bf16x8*)(kp+4608);
  kf[6]=*(const __attribute__((address_space(3))) bf16x8*)(kp+6144); kf[7]=*(const __attribute__((address_space(3))) bf16x8*)(kp+6656);
}
__device__ __forceinline__ void kload2(bf16x8*kf,lds_cptr kp,int j){ kf[2*j]=*(const __attribute__((address_space(3))) bf16x8*)(kp+j*2048); kf[2*j+1]=*(const __attribute__((address_space(3))) bf16x8*)(kp+j*2048+512); }
__device__ __forceinline__ s16x4 vtr(lds_cptr p){ return __builtin_bit_cast(s16x4,__builtin_amdgcn_ds_read_tr16_b64_v4i16((__attribute__((address_space(3))) v4i16_t*)p)); }
__device__ __forceinline__ float rowmax(const f32x16&p0,const f32x16&p1){
  float a=max3f(p0[0],p0[1],p1[0]),b=max3f(p0[2],p0[3],p1[1]);a=max3f(a,p1[2],p1[3]);
  #pragma unroll
  for(int r=4;r<16;r+=4){a=max3f(a,p0[r],p0[r+1]);b=max3f(b,p0[r+2],p0[r+3]);a=max3f(a,p1[r],p1[r+1]);b=max3f(b,p1[r+2],p1[r+3]);}
  const float m=max2f(a,b);
  auto rr=__builtin_amdgcn_permlane32_swap(__float_as_uint(m),__float_as_uint(m),false,false);
  return max2f(__uint_as_float(rr[0]),__uint_as_float(rr[1]));
}
__device__ __forceinline__ void pv(f32x16*o,int vb,bf16x8 pa0,bf16x8 pa1,bf16x8 pa2,bf16x8 pa3){
  #pragma unroll
  for(int d0=0;d0<2;++d0){s16x4 lo[4],hi[4];
    #pragma unroll
    for(int ks=0;ks<4;++ks){
      asm volatile("ds_read_b64_tr_b16 %0,%1 offset:%c2":"=&v"(lo[ks]):"v"(vb),"i"(d0*4096+ks*1024):"memory");
      asm volatile("ds_read_b64_tr_b16 %0,%1 offset:%c2":"=&v"(hi[ks]):"v"(vb),"i"(d0*4096+ks*1024+512):"memory");}
    asm volatile("s_waitcnt lgkmcnt(0)":::"memory");SBAR();
    #define PK(k) (bf16x8){lo[k][0],lo[k][1],lo[k][2],lo[k][3],hi[k][0],hi[k][1],hi[k][2],hi[k][3]}
    o[d0]=__builtin_amdgcn_mfma_f32_32x32x16_bf16(pa0,PK(0),o[d0],0,0,0);
    o[d0]=__builtin_amdgcn_mfma_f32_32x32x16_bf16(pa1,PK(1),o[d0],0,0,0);
    o[d0]=__builtin_amdgcn_mfma_f32_32x32x16_bf16(pa2,PK(2),o[d0],0,0,0);
    o[d0]=__builtin_amdgcn_mfma_f32_32x32x16_bf16(pa3,PK(3),o[d0],0,0,0);
    #undef PK
  }
}

#ifndef ATTN_STORE16
#define ATTN_STORE16(p,v) (*(u32x4*)(p)=(v))
#endif
template<int THRL> __device__ __forceinline__ void attn_unit(int b,int h,int qb,const bf16*Q,const bf16*__restrict__ K,const bf16*__restrict__ V,bf16*O,const unsigned long long*__restrict__ AUG,char*shm){
  const int tid=fresh_tid(),lane=tid&63,r32=lane&31,hi=lane>>5; const int wid=__builtin_amdgcn_readfirstlane(tid>>6);
  const long rowbase=(long)b*SEQ; const int q0=qb*QB; unsigned long long augq_;
  const bf16*Qw=Q+(rowbase+q0+wid*QBLK)*DM+h*D;
  const bf16*Kh=K+rowbase*DM+h*D,*Vh=V+rowbase*DM+h*D;
  const unsigned lds0=(unsigned)(uintptr_t)shm;
  float*wsf=(float*)(shm+LDS_WS)+wid*64;
  const bf16*ksrc=Kh+(long)lane*DM+wid*8;
  const bf16*vsrc=Vh+(long)(16*(wid&3)+(lane>>2))*DM+(wid>>2)*32+(lane&3)*8;
  const unsigned kdst=lds0+LDS_K+wid*1024, vdst=lds0+LDS_V+wid*1024;
  #define DMA_K(t,slot) glds16(ksrc+(long)(t)*KVBLK*DM,(unsigned)__builtin_amdgcn_readfirstlane(kdst+(slot)))
  #define DMA_V(t,slot) glds16(vsrc+(long)(t)*KVBLK*DM,(unsigned)__builtin_amdgcn_readfirstlane(vdst+(slot)))
  const int vb0=(int)(lds0+LDS_V)+((lane>>4)&1)*32+(lane&3)*8+(4*hi+((lane&15)>>2))*64;
  const char*Kbase=shm+LDS_K; bf16x8 kf[8];
  const lds_cptr shm3=(lds_cptr)shm; const lds_cptr kp0=shm3+LDS_K+hi*1024+r32*16; const lds_cptr vp0=shm3+LDS_V+((lane>>4)&1)*32+(lane&3)*8+(4*hi+((lane&15)>>2))*64;
  const int NT=(q0+QB)/KVBLK;
  const unsigned long long*augb=AUG+(long)(b*NHEAD+h)*SEQ;
  { const int nk=q0+QB; unsigned long long t_[4];
    _Pragma("unroll") for(int i=0;i<4;++i){const int k_=tid+512*i; t_[i]=(k_<nk)?augb[k_]:0ull;}
    const unsigned long long qw_=augb[q0+wid*QBLK+r32];
    asm volatile("s_waitcnt vmcnt(0)":::"memory");
    _Pragma("unroll") for(int i=0;i<4;++i){const int k_=tid+512*i; if(k_<nk)*(unsigned long long*)(shm+LDS_AUG+k_*8)=t_[i];}
    augq_=qw_; }
  bf16x8 qa=__builtin_bit_cast(bf16x8,(u32x4){hi?0u:0x3F803F80u,hi?0u:(0x3F80u|((unsigned)augq_<<16)),hi?0u:(((unsigned)augq_>>16)|((unsigned)(augq_>>32)<<16)),0u});
  #define SETQA() do{ const float nm_=-mhat; const unsigned a1_=cvtpk_s(nm_,0.f)&0xffffu; const float r1_=nm_-__uint_as_float(a1_<<16); const unsigned a2_=cvtpk_s(r1_,0.f)&0xffffu; const float r2_=r1_-__uint_as_float(a2_<<16); const unsigned a3_=cvtpk_s(r2_,0.f)&0xffffu; \
      u32x4 q4_=__builtin_bit_cast(u32x4,qa); q4_[0]=hi?(a1_|(a2_<<16)):q4_[0]; q4_[1]=hi?a3_:q4_[1]; qa=__builtin_bit_cast(bf16x8,q4_); }while(0)
  const lds_cptr augp=(lds_cptr)shm+LDS_AUG+r32*8;
  #define KAUG(t,half) ({ const unsigned long long w_=*(const __attribute__((address_space(3))) unsigned long long*)(augp+((t)*64+(half)*32)*8); \
      __builtin_bit_cast(bf16x8,(u32x4){hi?0x3F803F80u:(((unsigned)w_)^0x80008000u),hi?0x3F80u:(((((unsigned)(w_>>32))&0xffffu)^0x8000u)|0x3F800000u),hi?0u:0x3F803F80u,0u}); })
  DMA_K(0,0);DMA_V(0,0);DMA_K(1,SLOTB);
  bf16x8 qr[4];
  #pragma unroll
  for(int d0=0;d0<4;++d0)qr[d0]=*reinterpret_cast<const bf16x8*>(&Qw[(long)r32*DM+d0*16+hi*8]);
  float mhat=0.f,l_reg=0.f;f32x16 o[2];o[0]=f32x16{};o[1]=f32x16{};const f32x16 zero16=f32x16{};
  const int qrel=wid*QBLK+r32;
  #define CMASK(P0,P1,t) do{int jb_=(t)-(NT-4); if(jb_>=0)cmask(P0,P1,jb_,qrel,hi);}while(0)
  bool resc=false;
  #define START(P0,P1) do{ const float rm=rowmax(P0,P1); resc=false; \
    { const float dl=rm; mhat=fadd_s(mhat,dl); \
      _Pragma("unroll") for(int r=0;r<16;++r){P0[r]=fsub_s(P0[r],dl);P1[r]=fsub_s(P1[r],dl);} \
      SETQA(); } \
    _Pragma("unroll") for(int r=0;r<16;++r)P0[r]=__builtin_amdgcn_exp2f(P0[r]); }while(0)
  #define RESC() do{ if(resc){ asm volatile("s_waitcnt lgkmcnt(0)":::"memory"); \
      _Pragma("unroll") for(int d_=0;d_<2;++d_) _Pragma("unroll") for(int r=0;r<16;++r)o[d_][r]*=wsf[crow(r,hi)]; } }while(0)
  f32x16 pA0,pA1,pB0,pB1;
  int sl_prev=0,sl_cur=0,sl_next=SLOTB;
  #define ROT() do{sl_prev=sl_cur;sl_cur=sl_next;sl_next=(sl_next==(NSLOT-1)*SLOTB)?0:sl_next+SLOTB;}while(0)
  DMA_K(2,2*SLOTB);
  WAIT_BAR(3);
  qkt(pA0,pA1,Kbase,qr,r32,hi,KAUG(0,0),KAUG(0,1),qa);asm volatile("s_nop 15\n\ts_nop 7":"+v"(pA0),"+v"(pA1));CMASK(pA0,pA1,0);
  START(pA0,pA1);
  _Pragma("unroll") for(int r=0;r<16;++r)pA1[r]=__builtin_amdgcn_exp2f(pA1[r]);
  WAIT_BAR(0);
  DMA_K(3,0);DMA_V(1,SLOTB);
  ROT();
  kload8(kf,kp0+sl_cur);
  WAIT_BAR(2);
  s16x4 vlo[8],vhi[8]; u32x4 pw0,pw1,pw2,pw3;
  #define PKW(P,B) cvtpk_s(P[B],P[B+1])
  #define PAF(k) __builtin_bit_cast(bf16x8,pw##k)
  #define VFR(i) (bf16x8){vlo[i][0],vlo[i][1],vlo[i][2],vlo[i][3],vhi[i][0],vhi[i][1],vhi[i][2],vhi[i][3]}
  #define PIN(x) asm volatile("":"+v"(x))
  #define MX3(a,b,c) __builtin_fmaxf(__builtin_fmaxf((a),(b)),(c))
  #define GAPA(MF,A0,A1,A2,A3,W0,W1,PW) do{ MF; sacc+=A0; sacc+=A1; sacc+=A2; sacc+=A3; PIN(sacc); W0; W1; PIN(PW); SBAR(); }while(0)
  #define EX(v) __builtin_amdgcn_exp2f(v)
  #define GAPB(MF,X,B) do{ MF; X[B]=EX(X[B]); X[B+1]=EX(X[B+1]); X[B+2]=EX(X[B+2]); X[B+3]=EX(X[B+3]); PIN(X); SBAR(); }while(0)
  #define VRD(i) do{ vlo[i]=vtr(vp_+(((i)>>2)*4096+((i)&3)*1024)); vhi[i]=vtr(vp_+(((i)>>2)*4096+((i)&3)*1024+512)); }while(0)
  #define KRD(G,j) do{ if(G){ kload2(kf,kp0+sl_next,j); SBAR(); } }while(0)
  #define STEP(C0,C1,P0,P1,t,GK,GV,GL) do{ SBAR(); \
    const lds_cptr vp_=vp0+sl_prev; \
    { const bf16x8 ka0_=KAUG(t,0), ka1_=KAUG(t,1); C0=__builtin_amdgcn_mfma_f32_32x32x16_bf16(ka0_,qa,zero16,0,0,0); C1=__builtin_amdgcn_mfma_f32_32x32x16_bf16(ka1_,qa,zero16,0,0,0); } SBAR(); \
    VRD(0); SBAR(); float sacc=(P0[0]+P0[1]); \
    GAPA(C0=__builtin_amdgcn_mfma_f32_32x32x16_bf16(kf[0],qr[0],C0,0,0,0), P0[2],P0[3],P0[4],P0[5],     pw0[0]=PKW(P0,0), pw0[1]=PKW(P0,2), pw0); \
    VRD(4); SBAR(); GAPA(C1=__builtin_amdgcn_mfma_f32_32x32x16_bf16(kf[1],qr[0],C1,0,0,0), P0[6],P0[7],P0[8],P0[9],     pw0[2]=PKW(P0,4), pw0[3]=PKW(P0,6), pw0); \
    VRD(1); SBAR(); GAPA(C0=__builtin_amdgcn_mfma_f32_32x32x16_bf16(kf[2],qr[1],C0,0,0,0),   P0[10],P0[11],P0[12],P0[13], pw1[0]=PKW(P0,8), pw1[1]=PKW(P0,10), pw1); \
    VRD(5); SBAR(); GAPA(C1=__builtin_amdgcn_mfma_f32_32x32x16_bf16(kf[3],qr[1],C1,0,0,0),   P0[14],P0[15],P1[0],P1[1],   pw1[2]=PKW(P0,12),pw1[3]=PKW(P0,14), pw1); \
    VRD(2); SBAR(); GAPA(C0=__builtin_amdgcn_mfma_f32_32x32x16_bf16(kf[4],qr[2],C0,0,0,0),   P1[2],P1[3],P1[4],P1[5],     pw2[0]=PKW(P1,0), pw2[1]=PKW(P1,2), pw2); \
    VRD(6); SBAR(); GAPA(C1=__builtin_amdgcn_mfma_f32_32x32x16_bf16(kf[5],qr[2],C1,0,0,0),   P1[6],P1[7],P1[8],P1[9],     pw2[2]=PKW(P1,4), pw2[3]=PKW(P1,6), pw2); \
    VRD(3); SBAR(); GAPA(C0=__builtin_amdgcn_mfma_f32_32x32x16_bf16(kf[6],qr[3],C0,0,0,0),   P1[10],P1[11],P1[12],P1[13], pw3[0]=PKW(P1,8), pw3[1]=PKW(P1,10), pw3); \
    VRD(7); SBAR(); GAPA(C1=__builtin_amdgcn_mfma_f32_32x32x16_bf16(kf[7],qr[3],C1,0,0,0),   P1[14],P1[15],0.f,0.f,       pw3[2]=PKW(P1,12),pw3[3]=PKW(P1,14), pw3); \
    l_reg+=sacc; \
    if(GK){DMA_K((t)+3,sl_cur);} if(GV){DMA_V((t)+1,sl_next);} \
    CMASK(C0,C1,t); \
    { float a=MX3(C0[0],C0[1],C1[0]),b=MX3(C0[2],C0[3],C1[1]); a=MX3(a,C1[2],C1[3]); \
      _Pragma("unroll") for(int r=4;r<16;r+=4){a=MX3(a,C0[r],C0[r+1]);b=MX3(b,C0[r+2],C0[r+3]);a=MX3(a,C1[r],C1[r+1]);b=MX3(b,C1[r+2],C1[r+3]);} \
      float rm=__builtin_fmaxf(a,b); { auto rr=__builtin_amdgcn_permlane32_swap(__float_as_uint(rm),__float_as_uint(rm),false,false); rm=__builtin_fmaxf(__uint_as_float(rr[0]),__uint_as_float(rr[1])); } \
      resc=false; \
      if(__builtin_expect(__any(rm>(float)THRL),0)){ const float dl=__builtin_fmaxf(rm,0.f); mhat+=dl; \
        _Pragma("unroll") for(int r=0;r<16;++r){C0[r]-=dl;C1[r]-=dl;} \
        SETQA(); \
        const float f=__builtin_amdgcn_exp2f(-dl); l_reg*=f; if(hi==0)wsf[r32]=f; resc=true; } } \
    SBAR(); \
    GAPB(o[0]=__builtin_amdgcn_mfma_f32_32x32x16_bf16(PAF(0),VFR(0),o[0],0,0,0), C0,0); \
    GAPB(o[1]=__builtin_amdgcn_mfma_f32_32x32x16_bf16(PAF(0),VFR(4),o[1],0,0,0), C0,4); \
    KRD(GL,0); GAPB(o[0]=__builtin_amdgcn_mfma_f32_32x32x16_bf16(PAF(1),VFR(1),o[0],0,0,0), C0,8); \
    KRD(GL,1); GAPB(o[1]=__builtin_amdgcn_mfma_f32_32x32x16_bf16(PAF(1),VFR(5),o[1],0,0,0), C0,12); \
    KRD(GL,2); GAPB(o[0]=__builtin_amdgcn_mfma_f32_32x32x16_bf16(PAF(2),VFR(2),o[0],0,0,0), C1,0); \
    KRD(GL,3); GAPB(o[1]=__builtin_amdgcn_mfma_f32_32x32x16_bf16(PAF(2),VFR(6),o[1],0,0,0), C1,4); \
    GAPB(o[0]=__builtin_amdgcn_mfma_f32_32x32x16_bf16(PAF(3),VFR(3),o[0],0,0,0), C1,8); \
    GAPB(o[1]=__builtin_amdgcn_mfma_f32_32x32x16_bf16(PAF(3),VFR(7),o[1],0,0,0), C1,12); \
    }while(0)
  int t=1;
  #undef CMASK
  #define CMASK(P0,P1,t) do{}while(0)
  for(;t+5<NT;t+=2){
    STEP(pB0,pB1,pA0,pA1,t,true,true,true);     WAIT_BAR(2); RESC(); ROT();
    STEP(pA0,pA1,pB0,pB1,t+1,true,true,true);   WAIT_BAR(2); RESC(); ROT();
  }
  #undef CMASK
  #define CMASK(P0,P1,t) do{int jb_=(t)-(NT-4); if(jb_>=0)cmask(P0,P1,jb_,qrel,hi);}while(0)
  #define ENDW(tt) do{ if((tt)+3<NT){WAIT_BAR(2);} else if((tt)+2<NT){WAIT_BAR(1);} else {WAIT_BAR(0);} }while(0)
  for(;t+1<NT;t+=2){
    STEP(pB0,pB1,pA0,pA1,t,(t+3<NT),(t+1<NT),(t+1<NT));       ENDW(t);   RESC(); ROT();
    STEP(pA0,pA1,pB0,pB1,t+1,(t+4<NT),(t+2<NT),(t+2<NT));     ENDW(t+1); RESC(); ROT();
  }
  STEP(pB0,pB1,pA0,pA1,NT-1,false,false,false); RESC();
  { float sacc=pB0[0]+pB0[1]; _Pragma("unroll") for(int r=2;r<16;++r)sacc+=pB0[r]; _Pragma("unroll") for(int r=0;r<16;++r)sacc+=pB1[r]; l_reg+=sacc;
    pw0=(u32x4){PKW(pB0,0),PKW(pB0,2),PKW(pB0,4),PKW(pB0,6)};pw1=(u32x4){PKW(pB0,8),PKW(pB0,10),PKW(pB0,12),PKW(pB0,14)};pw2=(u32x4){PKW(pB1,0),PKW(pB1,2),PKW(pB1,4),PKW(pB1,6)};pw3=(u32x4){PKW(pB1,8),PKW(pB1,10),PKW(pB1,12),PKW(pB1,14)};
    SBAR(); pv(o,vb0+sl_cur,PAF(0),PAF(1),PAF(2),PAF(3)); }
  #undef PKW
  #undef PAF
  #undef VFR
  #undef PIN
  #undef MX3
  #undef GAPA
  #undef GAPB
  #undef EX
  #undef VRD
  #undef KRD
  #undef STEP
  #undef ENDW
  {auto rr=__builtin_amdgcn_permlane32_swap(__float_as_uint(l_reg),__float_as_uint(l_reg),false,false);l_reg=__uint_as_float(rr[0])+__uint_as_float(rr[1]);}
  if(hi==0)wsf[32+r32]=l_reg;asm volatile("s_waitcnt lgkmcnt(0)":::"memory");
  float rli[16];
  #pragma unroll
  for(int r=0;r<16;++r)rli[r]=__builtin_amdgcn_rcpf(wsf[32+crow(r,hi)]);
  bf16*Ow=O+(rowbase+q0+wid*QBLK)*DMO+h*D;
  { bf16*stg=(bf16*)(shm+LDS_OST)+wid*2048;
    #pragma unroll
    for(int r=0;r<16;++r){const int orow=crow(r,hi);
      #pragma unroll
      for(int d0=0;d0<2;++d0)stg[orow*64+d0*32+r32]=__float2bfloat16(o[d0][r]*rli[r]);}
    asm volatile("s_waitcnt lgkmcnt(0)":::"memory");
    #pragma unroll
    for(int i=0;i<4;++i){const int row=i*8+(lane>>3),ch=lane&7; const u32x4 v=*(const u32x4*)(stg+row*64+ch*8); ATTN_STORE16(Ow+(long)row*DMO+ch*8,v);} }
  asm volatile("s_waitcnt lgkmcnt(0)\n\ts_barrier":::"memory");
  #undef KAUG
  #undef SETQA
  #undef DMA_K
  #undef DMA_V
  #undef CMASK
  #undef START
  #undef RESC
  #undef ROT
}
constexpr int ATTN_LDS_BYTES=LDS_BYTES;
struct AttnTensors { const bf16* Q; const bf16* K; const bf16* V; bf16* O; const unsigned long long* AUG; };
struct AttnUnit { int bh; int qb; };
struct StaticOrder {
  int fb, nb;
  __device__ __forceinline__ explicit StaticOrder(int nblk,int idx):fb(idx),nb(nblk){}
  __device__ __forceinline__ bool next(int i,AttnUnit&u)const{
    if(nb==256){ if(i>=2)return false; const int s=fb&3; u.bh=fb>>2; u.qb=(i==0)?7-s:s; return true; }
    if(i>=4)return false; const int s=(fb&1)*2+(i>>1); u.bh=fb>>1; u.qb=(i&1)?s:7-s; return true; }
  __device__ __forceinline__ void a_ready(const AttnUnit&)const{}
  __device__ __forceinline__ void done(const AttnUnit&)const{}
};
template<class Sched,int THRL=8> __device__ __forceinline__ void attn_phase(char*lds,const AttnTensors&T,const Sched&S){
  AttnUnit u;
  for(int i=0;S.next(i,u);++i){ S.a_ready(u); attn_unit<THRL>(u.bh/NHEAD,u.bh%NHEAD,u.qb,T.Q,T.K,T.V,T.O,T.AUG,lds); S.done(u); }
}
#undef SBAR
#undef WAIT_BAR
}
struct Frame {
    LAS unsigned char* lds;
    unsigned* ctl;
    unsigned char* ws;
    int tid, lane, wave, vcu, G;
};
struct Args { const float* in[34]; float* out; unsigned char* ws; int ph_lo, ph_hi; };

__device__ __forceinline__ void tr_item(const float* W, int K, int N, int NP, bf16_t* WT, int ldk, int kcol_off, int mode, int row_off, const float* gk, LAS float* scr, int item, int lane) {
    const int nblk = NP / 32, kb = item / nblk, nb = item % nblk, k0 = 64 * kb, n0 = 32 * nb;
    (void)K;
    { const int n4 = (lane & 7) * 4, kr = lane >> 3; f32x4 v[8];
#pragma unroll
      for (int i = 0; i < 8; ++i) { const int kk = 8 * i + kr; v[i] = (n0 + n4 < N) ? *(const f32x4*)(W + (size_t)(k0 + kk) * N + n0 + n4) : (f32x4){0.f, 0.f, 0.f, 0.f}; }
#pragma unroll
      for (int i = 0; i < 8; ++i) { const int kk = 8 * i + kr; const float g = gk ? gk[k0 + kk] : 1.0f; LAS float* d = scr + kk * 33 + n4; d[0] = v[i].x * g; d[1] = v[i].y * g; d[2] = v[i].z * g; d[3] = v[i].w * g; } }
    LDS_WAIT(); asm volatile("" ::: "memory");
    const int c = lane & 7;
#pragma unroll
    for (int j = 0; j < 4; ++j) { const int n = (lane >> 3) + 8 * j; const LAS float* s = scr + (8 * c) * 33 + n; const int ng = n0 + n;
        const int drow = row_off + (mode ? ((ng >> 7) * 256 + (ng & 127)) : ng);
        u32x4 o; o.x = pk2(s[0 * 33], s[1 * 33]); o.y = pk2(s[2 * 33], s[3 * 33]); o.z = pk2(s[4 * 33], s[5 * 33]); o.w = pk2(s[6 * 33], s[7 * 33]);
        *(u32x4*)(WT + (size_t)drow * ldk + kcol_off + k0 + 8 * c) = o; }
    LDS_WAIT(); asm volatile("" ::: "memory");
}
__device__ __forceinline__ void tr_item8(const float* W, int N, unsigned char* WT, int ldk, int mode, int row_off, const float* gk, float scale, LAS float* scr, int item, int lane) {
    const int nblk = N / 32, kb = item / nblk, nb = item % nblk, k0 = 64 * kb, n0 = 32 * nb;
    { const int n4 = (lane & 7) * 4, kr = lane >> 3; f32x4 v[8];
#pragma unroll
      for (int i = 0; i < 8; ++i) { const int kk = 8 * i + kr; v[i] = *(const f32x4*)(W + (size_t)(k0 + kk) * N + n0 + n4); }
#pragma unroll
      for (int i = 0; i < 8; ++i) { const int kk = 8 * i + kr; const float g = (gk ? gk[k0 + kk] : 1.0f) * scale; LAS float* d = scr + kk * 33 + n4; d[0] = v[i].x * g; d[1] = v[i].y * g; d[2] = v[i].z * g; d[3] = v[i].w * g; } }
    LDS_WAIT(); asm volatile("" ::: "memory");
    const int c = lane & 3;
#pragma unroll
    for (int j = 0; j < 2; ++j) { const int n = (lane >> 2) + 16 * j; const LAS float* s = scr + (16 * c) * 33 + n; const int ng = n0 + n;
        const int drow = row_off + (mode ? ((ng >> 7) * 256 + (ng & 127)) : ng);
        u32x4 o; o.x = pk_fp8x4(s[0 * 33], s[1 * 33], s[2 * 33], s[3 * 33]); o.y = pk_fp8x4(s[4 * 33], s[5 * 33], s[6 * 33], s[7 * 33]);
        o.z = pk_fp8x4(s[8 * 33], s[9 * 33], s[10 * 33], s[11 * 33]); o.w = pk_fp8x4(s[12 * 33], s[13 * 33], s[14 * 33], s[15 * 33]);
        *(u32x4*)(WT + (size_t)drow * ldk + k0 + 16 * c) = o; }
    LDS_WAIT(); asm volatile("" ::: "memory");
}
__device__ __forceinline__ void p0_prologue(Frame& F, const Args& A) {
    F.tid = fresh_tid(); F.lane = F.tid & 63;
    LAS float* scr = (LAS float*)(F.lds + F.wave * 16384);
    const int gw = F.vcu * NWAVES + F.wave, NGW = F.G * NWAVES, lane = F.lane;
    unsigned char* ws = F.ws;
    const float* g_mix = A.in[1]; const float* g_ffn = A.in[2];
    constexpr int I_IN0 = 16 * (N0P / 32), I_SQ = 16 * 32, I_F13 = 16 * (FF / 32), I_F2 = (FF / 64) * 32, I_IN1 = 16 * (N1P / 32);
    constexpr int I_L1 = 1 * 16, I_L2 = 1 * 16, I_L3 = 2 * 16;
    constexpr int NITEMS = I_IN0 + I_SQ + 2 * I_F13 + I_F2 + I_IN1 + I_SQ + I_L1 + I_L2 + I_L3;
    for (int it = gw; it < NITEMS; it += NGW) {
        int r = it;
        if (r < I_IN0) { tr_item(A.in[3], D, N0, N0P, (bf16_t*)(ws + WS_W0T), D, 0, 0, 0, g_mix, scr, r, lane); continue; } r -= I_IN0;
        if (r < I_SQ) { tr_item(A.in[11], D, D, D, (bf16_t*)(ws + WS_WO0T), D, 0, 0, 0, nullptr, scr, r, lane); continue; } r -= I_SQ;
        if (r < I_F13) { tr_item(A.in[12], D, FF, FF, (bf16_t*)(ws + WS_W13T), D, 0, 1, 0, g_ffn, scr, r, lane); continue; } r -= I_F13;
        if (r < I_F13) { tr_item(A.in[13], D, FF, FF, (bf16_t*)(ws + WS_W13T), D, 0, 1, 128, g_ffn, scr, r, lane); continue; } r -= I_F13;
        if (r < I_F2) { tr_item(A.in[14], FF, D, D, (bf16_t*)(ws + WS_W2T), FF, 0, 0, 0, nullptr, scr, r, lane); continue; } r -= I_F2;
        if (r < I_IN1) { tr_item(A.in[15], D, N1, N1P, (bf16_t*)(ws + WS_W1IN), D, 0, 0, 0, g_mix + D, scr, r, lane); continue; } r -= I_IN1;
        if (r < I_SQ) { tr_item(A.in[28], D, D, D, (bf16_t*)(ws + WS_WO1T), D, 0, 0, 0, nullptr, scr, r, lane); continue; } r -= I_SQ;
        if (r < I_L1) { tr_item(A.in[17], 64, 512, 512, (bf16_t*)(ws + WS_LORA), 256, 0, 0, 0, nullptr, scr, r, lane); continue; } r -= I_L1;
        if (r < I_L2) { tr_item(A.in[19], 64, 512, 512, (bf16_t*)(ws + WS_LORA), 256, 64, 0, 512, nullptr, scr, r, lane); continue; } r -= I_L2;
        tr_item(A.in[21], 128, 512, 512, (bf16_t*)(ws + WS_LORA), 256, 128, 0, 1024, nullptr, scr, r, lane);
    }
    { bf16_t* L = (bf16_t*)(ws + WS_LORA);
      for (int i = (F.vcu * NTHR + F.tid); i < 1536 * 256 / 8; i += F.G * NTHR) { const int row = i >> 5, c8 = (i & 31) * 8; const int type = row >> 9;
          const bool diag = (type == 0) ? (c8 < 64) : (type == 1) ? (c8 >= 64 && c8 < 128) : (c8 >= 128);
          if (!diag) *(u32x4*)(L + (size_t)row * 256 + c8) = (u32x4){0u, 0u, 0u, 0u}; } }
    { const float* x = A.in[0]; bf16_t* xb = (bf16_t*)(ws + WS_XB); pg8::u64* ssq0 = (pg8::u64*)(F.ctl + CW_SSQ0);
      for (int m = gw; m < M; m += NGW) { const f32x4* xr = (const f32x4*)(x + (size_t)m * D) + lane; f32x4 v[4]; float s = 0.f;
#pragma unroll
          for (int j = 0; j < 4; ++j) { v[j] = xr[64 * j]; s += (v[j].x * v[j].x + v[j].y * v[j].y) + (v[j].z * v[j].z + v[j].w * v[j].w); }
          s = wave_sum(s); if (lane == 0) ssq0[m] = (pg8::u64)(s * pg8::SSQ_SCALE + 0.5f);
          u32x2* o8 = (u32x2*)(xb + (size_t)m * D) + lane;
#pragma unroll
          for (int j = 0; j < 4; ++j) { u32x2 w; w.x = cvt_pk_bf16(v[j].x, v[j].y); w.y = cvt_pk_bf16(v[j].z, v[j].w); o8[64 * j] = w; } } }
}
__device__ __forceinline__ void moe_convert(Frame& F, const Args& A, int wi, int nw, int lo = 0, int hi = 0x7fffffff) {
    F.tid = fresh_tid(); F.lane = F.tid & 63;
    LAS float* scr = (LAS float*)(F.lds + F.wave * 16384); unsigned char* ws = F.ws; const float* g_ffn = A.in[2]; const int lane = F.lane;
    constexpr int I_E13 = 16 * (FE / 32), I_E2 = (FE / 64) * 32, NITEMS = NE * (2 * I_E13 + I_E2);
    for (int it = lo + wi; it < (hi < NITEMS ? hi : NITEMS); it += nw) {
        int r = it;
        if (r < NE * I_E13) { const int e = r / I_E13; tr_item8(A.in[30] + (size_t)e * D * FE, FE, ws + WS_WE13T + (size_t)e * 2 * FE * D, D, 1, 0, g_ffn + D, pg8::Q8_W, scr, r % I_E13, lane); continue; } r -= NE * I_E13;
        if (r < NE * I_E13) { const int e = r / I_E13; tr_item8(A.in[31] + (size_t)e * D * FE, FE, ws + WS_WE13T + (size_t)e * 2 * FE * D, D, 1, 128, g_ffn + D, pg8::Q8_W, scr, r % I_E13, lane); continue; } r -= NE * I_E13;
        const int e = r / I_E2; tr_item8(A.in[32] + (size_t)e * FE * D, D, ws + WS_WE2T + (size_t)e * D * FE, FE, 0, 0, nullptr, pg8::Q8_W, scr, r % I_E2, lane);
    }
}

__device__ __forceinline__ void conv_phase(Frame& F, const Args& A) {
    F.tid = fresh_tid(); F.lane = F.tid & 63;
    const bf16_t* P0 = (const bf16_t*)(F.ws + WS_P0); bf16_t* YC = (bf16_t*)(F.ws + WS_YC0);
    const float* cw = A.in[4]; const float* cb = A.in[5]; const float* lg = A.in[6]; const float* lb = A.in[7];
    LAS bf16_t* U = (LAS bf16_t*)F.lds; LAS float* Y = (LAS float*)(F.lds + 65536);
    const int c = F.tid;
    float w[31];
#pragma unroll
    for (int j = 0; j < 31; ++j) w[j] = cw[j * 512 + c];
    const float bias = cb[c];
    for (int unit = blockIdx.x; unit < M / 32; unit += F.G) {
        const int m0 = unit * 32, t0 = m0 % T;
        { u32x4 va[8], ga[8];
#pragma unroll
          for (int j = 0; j < 8; ++j) { const int it = F.tid + NTHR * j, i = it >> 6, c8 = (it & 63) * 8; const bool ok = (it < 62 * 64) && (t0 - 30 + i >= 0);
              const bf16_t* rp = P0 + (size_t)(ok ? (m0 - 30 + i) : m0) * N0P; va[j] = *(const u32x4*)(rp + C_VAL + c8); ga[j] = *(const u32x4*)(rp + C_GATE + c8); }
#pragma unroll
          for (int j = 0; j < 8; ++j) { const int it = F.tid + NTHR * j, i = it >> 6, c8 = (it & 63) * 8; const bool ok = (t0 - 30 + i >= 0);
              if (it < 62 * 64) { u32x4 o = (u32x4){0u, 0u, 0u, 0u};
                  if (ok) { float r[8];
#pragma unroll
                      for (int q = 0; q < 4; ++q) { r[2 * q] = bflo(va[j][q]) * sigmoidf_(bflo(ga[j][q])); r[2 * q + 1] = bfhi(va[j][q]) * sigmoidf_(bfhi(ga[j][q])); }
                      o.x = cvt_pk_bf16(r[0], r[1]); o.y = cvt_pk_bf16(r[2], r[3]); o.z = cvt_pk_bf16(r[4], r[5]); o.w = cvt_pk_bf16(r[6], r[7]); }
                  *(LAS u32x4*)(U + i * 512 + c8) = o; } } }
        __syncthreads();
        { float y[32];
#pragma unroll
          for (int t = 0; t < 32; ++t) y[t] = bias;
#pragma unroll
          for (int i = 0; i < 62; ++i) { const float uv = bf2f(U[i * 512 + c]);
#pragma unroll
              for (int t = 0; t < 32; ++t) { if (i - t >= 0 && i - t <= 30) y[t] += uv * w[i - t]; } }
#pragma unroll
          for (int t = 0; t < 32; ++t) Y[t * 512 + c] = y[t]; }
        __syncthreads();
        for (int t = F.wave; t < 32; t += NWAVES) { const LAS f32x4* yr = (const LAS f32x4*)(Y + t * 512 + F.lane * 8); const f32x4 a = yr[0], b = yr[1];
            float s = (a.x + a.y) + (a.z + a.w) + (b.x + b.y) + (b.z + b.w); const float mean = wave_sum(s) * (1.0f / 512.0f);
            const f32x4 da = a - mean, db = b - mean; float q = (da.x * da.x + da.y * da.y) + (da.z * da.z + da.w * da.w) + (db.x * db.x + db.y * db.y) + (db.z * db.z + db.w * db.w);
            const float rstd = rsqrtf(wave_sum(q) * (1.0f / 512.0f) + 1e-5f);
            const f32x4 g0 = *(const f32x4*)(lg + F.lane * 8), g1 = *(const f32x4*)(lg + F.lane * 8 + 4), b0 = *(const f32x4*)(lb + F.lane * 8), b1 = *(const f32x4*)(lb + F.lane * 8 + 4);
            float o[8];
#pragma unroll
            for (int i = 0; i < 4; ++i) { o[i] = siluf_(da[i] * rstd * g0[i] + b0[i]); o[4 + i] = siluf_(db[i] * rstd * g1[i] + b1[i]); }
            u32x4 wv; wv.x = cvt_pk_bf16(o[0], o[1]); wv.y = cvt_pk_bf16(o[2], o[3]); wv.z = cvt_pk_bf16(o[4], o[5]); wv.w = cvt_pk_bf16(o[6], o[7]);
            *(u32x4*)(YC + (size_t)(m0 + t) * D + F.lane * 8) = wv; }
        __syncthreads();
    }
}

__device__ __forceinline__ float rdl(float x, int l) { return __int_as_float(__builtin_amdgcn_readlane(__float_as_int(x), l)); }

constexpr int GL_LD = 72;
constexpr int GL_QD = 0, GL_KD = 9216, GL_VT = 18432, GL_ST = 36864, GL_AT = 55296, GL_O = 64512, GL_OLD = 132;
__device__ __forceinline__ int crow32(int r, int hi) { return (r & 3) + 8 * (r >> 2) + 4 * hi; }
constexpr int GL_LA = 98304;
constexpr int GL_WA = GL_LA + 16384, GL_BA = GL_WA + 4096;
__device__ __forceinline__ void gla_bcum(const u32x4 a0, const u32x4 a1, const LAS float* WAl, const LAS float* BAl, int lane, LAS float* LA, int kw, float (&bc)[8], float (&bl)[8]) {
    float al[16];
#pragma unroll
    for (int q = 0; q < 4; ++q) { al[2 * q] = bflo(a0[q]); al[2 * q + 1] = bfhi(a0[q]); al[8 + 2 * q] = bflo(a1[q]); al[8 + 2 * q + 1] = bfhi(a1[q]); }
    float la[8];
    { const f32x4 b0 = *(const LAS f32x4*)(BAl + kw), b1 = *(const LAS f32x4*)(BAl + kw + 4);
#pragma unroll
      for (int j = 0; j < 4; ++j) { la[j] = b0[j]; la[4 + j] = b1[j]; }
#pragma unroll
      for (int r = 0; r < 16; ++r) { const f32x4 w0 = *(const LAS f32x4*)(WAl + r * 64 + kw), w1 = *(const LAS f32x4*)(WAl + r * 64 + kw + 4);
#pragma unroll
          for (int j = 0; j < 4; ++j) { la[j] += al[r] * w0[j]; la[4 + j] += al[r] * w1[j]; } }
#pragma unroll
      for (int j = 0; j < 8; ++j) { const float lg = la[j]; la[j] = (fminf(lg, 0.f) - __logf(1.0f + __expf(-fabsf(lg)))) * (1.0f / 16.0f); } }
    *(LAS f32x4*)(LA + lane * 64 + kw) = (f32x4){la[0], la[1], la[2], la[3]}; *(LAS f32x4*)(LA + lane * 64 + kw + 4) = (f32x4){la[4], la[5], la[6], la[7]};
    asm volatile("s_waitcnt lgkmcnt(0)" ::: "memory");
    if (lane < 8) { float xs[64];
#pragma unroll
        for (int t = 0; t < 64; ++t) xs[t] = LA[t * 64 + kw + lane];
#pragma unroll
        for (int t = 1; t < 64; ++t) xs[t] += xs[t - 1];
#pragma unroll
        for (int t = 0; t < 64; ++t) LA[t * 64 + kw + lane] = xs[t]; }
    asm volatile("s_waitcnt lgkmcnt(0)" ::: "memory");
    const f32x4 b0 = *(const LAS f32x4*)(LA + lane * 64 + kw), b1 = *(const LAS f32x4*)(LA + lane * 64 + kw + 4), e0 = *(const LAS f32x4*)(LA + 63 * 64 + kw), e1 = *(const LAS f32x4*)(LA + 63 * 64 + kw + 4);
#pragma unroll
    for (int j = 0; j < 4; ++j) { bc[j] = b0[j]; bc[4 + j] = b1[j]; bl[j] = e0[j]; bl[4 + j] = e1[j]; }
}
__device__ __forceinline__ void gla_load_v(u32x4 (&vr)[2], const bf16_t* P0, size_t m0, int h, int tid) {
#pragma unroll
    for (int i = 0; i < 2; ++i) { const int it = tid + 512 * i, t = it & 63, d8 = (it >> 6) * 8; vr[i] = *(const u32x4*)(P0 + (m0 + t) * N0P + C_GV + h * 128 + d8); }
}
__device__ __forceinline__ void gla_stage_vt(LAS bf16_t* VT, const u32x4 (&vr)[2], int tid) {
#pragma unroll
    for (int i = 0; i < 2; ++i) { const int it = tid + 512 * i, t = it & 63, d8 = (it >> 6) * 8; const u32x4 v = vr[i];
#pragma unroll
        for (int q = 0; q < 4; ++q) { VT[(d8 + 2 * q) * GL_LD + t] = (bf16_t)(v[q] & 0xffffu); VT[(d8 + 2 * q + 1) * GL_LD + t] = (bf16_t)(v[q] >> 16); } }
}
__device__ __forceinline__ f32x16 gla_mma64(f32x16 acc, const LAS bf16_t* A, const LAS bf16_t* Bt, int r32, int hi) {
#pragma unroll
    for (int s = 0; s < 4; ++s) { const bf16x8 a = *(const LAS bf16x8*)(A + r32 * GL_LD + 16 * s + 8 * hi), b = *(const LAS bf16x8*)(Bt + r32 * GL_LD + 16 * s + 8 * hi);
        acc = __builtin_amdgcn_mfma_f32_32x32x16_bf16(a, b, acc, 0, 0, 0); }
    return acc;
}
__device__ __forceinline__ void gla_x_phase(Frame& F, const Args& A) {
    F.tid = fresh_tid(); F.lane = F.tid & 63;
    const int tid = F.tid, lane = F.lane, wave = F.wave, r32 = lane & 31, hi = lane >> 5;
    const bf16_t* P0 = (const bf16_t*)(F.ws + WS_P0); float* LT = (float*)(F.ws + WS_GLT); float* DEC = (float*)(F.ws + WS_GDEC);
    LAS bf16_t* KET = (LAS bf16_t*)(F.lds + GL_QD); LAS bf16_t* VT = (LAS bf16_t*)(F.lds + GL_VT);
    { const int hh = ((int)blockIdx.x >> 5) & 3; LAS float* WAl = (LAS float*)(F.lds + GL_WA); LAS float* BAl = (LAS float*)(F.lds + GL_BA);
      for (int i = tid; i < 1024; i += NTHR) WAl[i] = A.in[8][(i >> 6) * 256 + hh * 64 + (i & 63)];
      if (tid < 64) BAl[tid] = A.in[9][hh * 64 + tid];
      __syncthreads(); }
    u32x4 n_a0, n_a1, n_kv, n_vr[2];
#define GX_LOAD(c_) do { const int bh_ = (c_) >> 5, n_ = (c_) & 31, b_ = bh_ >> 2, h_ = bh_ & 3; const size_t m0_ = (size_t)b_ * T + n_ * 64; const bf16_t* rp_ = P0 + (m0_ + lane) * N0P; \
        n_a0 = *(const u32x4*)(rp_ + C_ALR); n_a1 = *(const u32x4*)(rp_ + C_ALR + 8); n_kv = *(const u32x4*)(rp_ + C_GK + h_ * 64 + wave * 8); gla_load_v(n_vr, P0, m0_, h_, tid); } while (0)
    GX_LOAD((int)blockIdx.x);
    for (int c = blockIdx.x; c < 1024; c += F.G) { const int bh = c >> 5, n = c & 31, b = bh >> 2, h = bh & 3; const size_t m0 = (size_t)b * T + n * 64;
        float bc[8], bl[8];
        const u32x4 a0 = n_a0, a1 = n_a1, kv = n_kv; u32x4 vr[2] = {n_vr[0], n_vr[1]};
        if (c + F.G < 1024) GX_LOAD(c + F.G);
        gla_bcum(a0, a1, (const LAS float*)(F.lds + GL_WA), (const LAS float*)(F.lds + GL_BA), lane, (LAS float*)(F.lds + GL_LA), wave * 8, bc, bl);
        {
#pragma unroll
          for (int q = 0; q < 4; ++q) { KET[(wave * 8 + 2 * q) * GL_LD + lane] = (bf16_t)f2bf(bflo(kv[q]) * __expf(bl[2 * q] - bc[2 * q])); KET[(wave * 8 + 2 * q + 1) * GL_LD + lane] = (bf16_t)f2bf(bfhi(kv[q]) * __expf(bl[2 * q + 1] - bc[2 * q + 1])); }
          if (lane < 8) { float d = bl[0];
#pragma unroll
              for (int j = 1; j < 8; ++j) d = (lane == j) ? bl[j] : d;
              DEC[(size_t)c * 64 + wave * 8 + lane] = __expf(d); } }
        gla_stage_vt(VT, vr, tid);
        __syncthreads();
        { const int tv = wave >> 1, tk = wave & 1; f32x16 acc = {}; acc = gla_mma64(acc, VT + 32 * tv * GL_LD, KET + 32 * tk * GL_LD, r32, hi);
          float* lp = LT + (size_t)c * 8192 + 32 * tk + r32;
#pragma unroll
          for (int r = 0; r < 16; ++r) lp[(32 * tv + crow32(r, hi)) * 64] = acc[r]; }
        __syncthreads();
    }
#undef GX_LOAD
}
__device__ __forceinline__ void gla_carry_phase(Frame& F, const Args& A) {
    F.tid = fresh_tid(); (void)A;
    const float* LT = (const float*)(F.ws + WS_GLT); const float* DEC = (const float*)(F.ws + WS_GDEC); bf16_t* ST = (bf16_t*)(F.ws + WS_GST);
    const int gid = F.vcu * NTHR + F.tid; if (gid >= 32 * 8192 / 2) return;
    const int e = gid * 2, bh = e >> 13, rem = e & 8191, dk = rem & 63; float S0 = 0.f, S1 = 0.f;
#pragma unroll 8
    for (int n = 0; n < 32; ++n) { const size_t c = (size_t)bh * 32 + n; *(unsigned*)(ST + c * 8192 + rem) = cvt_pk_bf16(S0, S1);
        const f32x2 l = *(const f32x2*)(LT + c * 8192 + rem), d = *(const f32x2*)(DEC + c * 64 + dk); S0 = S0 * d.x + l.x; S1 = S1 * d.y + l.y; }
}
__device__ __forceinline__ void gla_z_phase(Frame& F, const Args& A) {
    F.tid = fresh_tid(); F.lane = F.tid & 63;
    const int tid = F.tid, lane = F.lane, wave = F.wave, r32 = lane & 31, hi = lane >> 5;
    const bf16_t* P0 = (const bf16_t*)(F.ws + WS_P0); const bf16_t* STg = (const bf16_t*)(F.ws + WS_GST); bf16_t* YC = (bf16_t*)(F.ws + WS_YC0); const float* ng = A.in[10];
    LAS bf16_t* QD = (LAS bf16_t*)(F.lds + GL_QD); LAS bf16_t* KD = (LAS bf16_t*)(F.lds + GL_KD); LAS bf16_t* VT = (LAS bf16_t*)(F.lds + GL_VT); LAS bf16_t* STl = (LAS bf16_t*)(F.lds + GL_ST);
    LAS bf16_t* AT = (LAS bf16_t*)(F.lds + GL_AT); LAS float* OL = (LAS float*)(F.lds + GL_O);
    { const int hh = ((int)blockIdx.x >> 5) & 3; LAS float* WAl = (LAS float*)(F.lds + GL_WA); LAS float* BAl = (LAS float*)(F.lds + GL_BA);
      for (int i = tid; i < 1024; i += NTHR) WAl[i] = A.in[8][(i >> 6) * 256 + hh * 64 + (i & 63)];
      if (tid < 64) BAl[tid] = A.in[9][hh * 64 + tid];
      __syncthreads(); }
    u32x4 n_a0, n_a1, n_qv, n_kv, n_vr[2], n_sr[2], n_g0, n_g1;
#define GZ_LOAD(c_) do { const int bh_ = (c_) >> 5, n_ = (c_) & 31, b_ = bh_ >> 2, h_ = bh_ & 3; const size_t m0_ = (size_t)b_ * T + n_ * 64; const bf16_t* rp_ = P0 + (m0_ + lane) * N0P; \
        n_a0 = *(const u32x4*)(rp_ + C_ALR); n_a1 = *(const u32x4*)(rp_ + C_ALR + 8); n_qv = *(const u32x4*)(rp_ + C_GQ + h_ * 64 + wave * 8); n_kv = *(const u32x4*)(rp_ + C_GK + h_ * 64 + wave * 8); \
        gla_load_v(n_vr, P0, m0_, h_, tid); \
        _Pragma("unroll") for (int i_ = 0; i_ < 2; ++i_) { const int it_ = tid + 512 * i_, dv_ = it_ >> 3, c8_ = (it_ & 7) * 8; n_sr[i_] = *(const u32x4*)(STg + (size_t)(c_) * 8192 + dv_ * 64 + c8_); } \
        const bf16_t* gp_ = P0 + (m0_ + (tid >> 3)) * N0P + C_GG + h_ * 128 + (tid & 7) * 16; n_g0 = *(const u32x4*)gp_; n_g1 = *(const u32x4*)(gp_ + 8); } while (0)
    GZ_LOAD((int)blockIdx.x);
    for (int c = blockIdx.x; c < 1024; c += F.G) { const int bh = c >> 5, n = c & 31, b = bh >> 2, h = bh & 3; const size_t m0 = (size_t)b * T + n * 64;
        float bc[8], bl[8];
        const u32x4 a0 = n_a0, a1 = n_a1, qv = n_qv, kv = n_kv, g0 = n_g0, g1 = n_g1; u32x4 vr[2] = {n_vr[0], n_vr[1]}, sr[2] = {n_sr[0], n_sr[1]};
        if (c + F.G < 1024) GZ_LOAD(c + F.G);
        gla_bcum(a0, a1, (const LAS float*)(F.lds + GL_WA), (const LAS float*)(F.lds + GL_BA), lane, (LAS float*)(F.lds + GL_LA), wave * 8, bc, bl);
        { u32x4 qo, ko;
#pragma unroll
          for (int q = 0; q < 4; ++q) { const float e0 = __expf(bc[2 * q]), e1 = __expf(bc[2 * q + 1]);
              qo[q] = cvt_pk_bf16(bflo(qv[q]) * 0.125f * e0, bfhi(qv[q]) * 0.125f * e1); ko[q] = cvt_pk_bf16(bflo(kv[q]) * __builtin_amdgcn_rcpf(e0), bfhi(kv[q]) * __builtin_amdgcn_rcpf(e1)); }
          *(LAS u32x4*)(QD + lane * GL_LD + wave * 8) = qo; *(LAS u32x4*)(KD + lane * GL_LD + wave * 8) = ko; }
        gla_stage_vt(VT, vr, tid);
#pragma unroll
        for (int i = 0; i < 2; ++i) { const int it = tid + 512 * i, dv = it >> 3, c8 = (it & 7) * 8; *(LAS u32x4*)(STl + dv * GL_LD + c8) = sr[i]; }
        __syncthreads();
        if (wave < 4) { const int ti = wave >> 1, tj = wave & 1; f32x16 acc = {};
            if (tj <= ti) acc = gla_mma64(acc, QD + 32 * ti * GL_LD, KD + 32 * tj * GL_LD, r32, hi);
#pragma unroll
            for (int r = 0; r < 16; ++r) { const int il = crow32(r, hi); float v = acc[r]; if (ti == tj && r32 > il) v = 0.f; AT[(32 * ti + il) * GL_LD + 32 * tj + r32] = (bf16_t)f2bf(v); } }
        __syncthreads();
        { const int ti = wave >> 2, tn = wave & 3; f32x16 acc = {};
          acc = gla_mma64(acc, AT + 32 * ti * GL_LD, VT + 32 * tn * GL_LD, r32, hi);
          acc = gla_mma64(acc, QD + 32 * ti * GL_LD, STl + 32 * tn * GL_LD, r32, hi);
#pragma unroll
          for (int r = 0; r < 16; ++r) OL[(32 * ti + crow32(r, hi)) * GL_OLD + 32 * tn + r32] = acc[r]; }
        __syncthreads();
        { const int i = tid >> 3, seg = (tid & 7) * 16; const LAS f32x4* op = (const LAS f32x4*)(OL + i * GL_OLD + seg); f32x4 o[4]; float ss = 0.f;
#pragma unroll
          for (int q = 0; q < 4; ++q) { o[q] = op[q]; ss += (o[q].x * o[q].x + o[q].y * o[q].y) + (o[q].z * o[q].z + o[q].w * o[q].w); }
          ss += __int_as_float(__builtin_amdgcn_update_dpp(0, __float_as_int(ss), 0xB1, 0xF, 0xF, false));
          ss += __int_as_float(__builtin_amdgcn_update_dpp(0, __float_as_int(ss), 0x4E, 0xF, 0xF, false));
          ss += __int_as_float(__builtin_amdgcn_update_dpp(0, __float_as_int(ss), 0x141, 0xF, 0xF, false));
          const float rs = rsqrtf(ss * (1.0f / 128.0f) + 1e-6f);
          float res[16];
#pragma unroll
          for (int q = 0; q < 4; ++q) { const f32x4 nv = *(const f32x4*)(ng + h * 128 + seg + 4 * q); const unsigned gw0 = (q < 2) ? g0[2 * q] : g1[2 * q - 4], gw1 = (q < 2) ? g0[2 * q + 1] : g1[2 * q - 3];
              res[4 * q] = o[q].x * rs * nv.x * siluf_(bflo(gw0)); res[4 * q + 1] = o[q].y * rs * nv.y * siluf_(bfhi(gw0)); res[4 * q + 2] = o[q].z * rs * nv.z * siluf_(bflo(gw1)); res[4 * q + 3] = o[q].w * rs * nv.w * siluf_(bfhi(gw1)); }
          u32x4 w0, w1; w0.x = cvt_pk_bf16(res[0], res[1]); w0.y = cvt_pk_bf16(res[2], res[3]); w0.z = cvt_pk_bf16(res[4], res[5]); w0.w = cvt_pk_bf16(res[6], res[7]);
          w1.x = cvt_pk_bf16(res[8], res[9]); w1.y = cvt_pk_bf16(res[10], res[11]); w1.z = cvt_pk_bf16(res[12], res[13]); w1.w = cvt_pk_bf16(res[14], res[15]);
          bf16_t* yp = YC + (m0 + i) * D + 512 + h * 128 + seg; *(u32x4*)yp = w0; *(u32x4*)(yp + 8) = w1; }
        __syncthreads();
    }
#undef GZ_LOAD
}

__device__ __forceinline__ void lora_prep_phase(Frame& F, const Args& A) {
    F.tid = fresh_tid(); F.lane = F.tid & 63;
    const bf16_t* P1 = (const bf16_t*)(F.ws + WS_P1); bf16_t* AL = (bf16_t*)(F.ws + WS_ALORA); const float* mu = A.in[16];
    {
      const int gt = F.vcu * NTHR + F.tid, c8 = (gt & 31) * 8; const f32x4 mu0 = *(const f32x4*)(mu + R_XW + c8), mu1 = *(const f32x4*)(mu + R_XW + c8 + 4);
      u32x4 cur[4], prv[4];
#pragma unroll
      for (int j = 0; j < 4; ++j) { const int m = (gt >> 5) + j * (F.G * NTHR / 32); cur[j] = *(const u32x4*)(P1 + (size_t)m * N1P + R_XW + c8);
          prv[j] = ((m % T) > 0) ? *(const u32x4*)(P1 + (size_t)(m - 1) * N1P + R_XW + c8) : (u32x4){0u, 0u, 0u, 0u}; }
#pragma unroll
      for (int j = 0; j < 4; ++j) { const int m = (gt >> 5) + j * (F.G * NTHR / 32); float r[8];
#pragma unroll
          for (int q = 0; q < 4; ++q) { const float c0 = bflo(cur[j][q]), c1 = bfhi(cur[j][q]), p0 = bflo(prv[j][q]), p1 = bfhi(prv[j][q]); const float m0_ = (q < 2) ? mu0[2 * q] : mu1[2 * q - 4], m1_ = (q < 2) ? mu0[2 * q + 1] : mu1[2 * q - 3];
              r[2 * q] = c0 + (p0 - c0) * m0_; r[2 * q + 1] = c1 + (p1 - c1) * m1_; }
          if (c8 < 64) {
#pragma unroll
              for (int q = 0; q < 8; ++q) r[q] = 1.0f - 2.0f * __builtin_amdgcn_rcpf(1.0f + __expf(2.0f * r[q])); }
          else if (c8 >= 128) {
#pragma unroll
              for (int q = 0; q < 8; ++q) r[q] = sigmoidf_(r[q]); }
          u32x4 o; o.x = cvt_pk_bf16(r[0], r[1]); o.y = cvt_pk_bf16(r[2], r[3]); o.z = cvt_pk_bf16(r[4], r[5]); o.w = cvt_pk_bf16(r[6], r[7]);
          *(u32x4*)(AL + (size_t)m * 256 + c8) = o; } }
    const int gw = F.vcu * NWAVES + F.wave;
    if (gw < 64) { const int b = gw >> 3, h = gw & 7; const float* fl = (const float*)(F.ws + WS_FL32); unsigned long long* ca = (unsigned long long*)(F.ws + WS_CAUG) + (size_t)gw * T; const float bf = A.in[27][h];
        float ls[32];
#pragma unroll
        for (int i = 0; i < 32; ++i) ls[i] = fl[((size_t)b * T + F.lane * 32 + i) * 8 + h];
        float s = 0.f;
#pragma unroll
        for (int i = 0; i < 32; ++i) { const float xg = ls[i] + bf; ls[i] = fminf(xg, 0.f) - __logf(1.0f + __expf(-fabsf(xg))); s += ls[i]; }
        float inc = s;
#pragma unroll
        for (int o = 1; o < 64; o <<= 1) { const float n = __shfl_up(inc, o); if (F.lane >= o) inc += n; }
        float run = inc - s;
#pragma unroll
        for (int i = 0; i < 32; ++i) { run += ls[i];
            const float c2 = run * 1.4426950408889634f; const unsigned p1 = f2bf(c2); const float r1 = c2 - __uint_as_float(p1 << 16); const unsigned p2 = f2bf(r1); const float r2 = r1 - __uint_as_float(p2 << 16); const unsigned p3 = f2bf(r2);
            ca[F.lane * 32 + i] = (unsigned long long)(p1 | (p2 << 16)) | ((unsigned long long)p3 << 32); } }
}


__device__ __forceinline__ float dpp_sum16(float x) {
    x += __int_as_float(__builtin_amdgcn_update_dpp(0, __float_as_int(x), 0xB1, 0xF, 0xF, false));
    x += __int_as_float(__builtin_amdgcn_update_dpp(0, __float_as_int(x), 0x4E, 0xF, 0xF, false));
    x += __int_as_float(__builtin_amdgcn_update_dpp(0, __float_as_int(x), 0x141, 0xF, 0xF, false));
    x += __int_as_float(__builtin_amdgcn_update_dpp(0, __float_as_int(x), 0x140, 0xF, 0xF, false));
    return x;
}
constexpr int RW_TS = 32;
__device__ __forceinline__ void rwkv_scan_phase(Frame& F, const Args& A, int rb) {
    F.tid = fresh_tid(); F.lane = F.tid & 63;
    const int tid = F.tid, lane = F.lane, wave = F.wave;
    const int bh = rb >> 1, half = rb & 1, b = bh >> 3, h = bh & 7;
    const bf16_t* P1 = (const bf16_t*)(F.ws + WS_P1); const float* WAG = (const float*)(F.ws + WS_WAG); bf16_t* YR = (bf16_t*)(F.ws + WS_YRAW);
    const float* mu = A.in[16];
    LAS float* LW = (LAS float*)F.lds; LAS float* LKK = LW + 2048; LAS float* LBB = LKK + 2048; LAS float* LKM = LBB + 2048; LAS float* LRR = LKM + 2048; LAS float* LV = LRR + 2048; LAS float* LY = LV + 1024;
    const int ps = tid >> 4, pq = tid & 15, kc = h * 64 + pq * 4, vc = h * 64 + half * 32 + pq * 2;
    f32x4 mur, muk, kkc, kac; float muv[2];
#pragma unroll
    for (int i = 0; i < 4; ++i) { mur[i] = mu[R_R + kc + i]; muk[i] = mu[R_K + kc + i]; kkc[i] = A.in[22][kc + i]; kac[i] = A.in[23][kc + i]; }
    muv[0] = mu[R_V + vc]; muv[1] = mu[R_V + vc + 1];
    const int sq = lane & 15, vl = wave * 4 + (lane >> 4);
    f32x2 S01 = {0.f, 0.f}, S23 = {0.f, 0.f}; const bool b3 = (sq & 8) != 0, b2 = (sq & 4) != 0, b1 = (sq & 2) != 0, b0 = (sq & 1) != 0;
    u32x2 g_r, g_k, g_pr, g_pk; unsigned g_v, g_pv; f32x4 g_w, g_a;
#define RW_LOAD(t0) do { const size_t m_ = (size_t)b * T + (t0) + ps; const bf16_t* rp_ = P1 + m_ * N1P; const bool hp_ = ((t0) + ps) > 0; \
        g_r = *(const u32x2*)(rp_ + R_R + kc); g_k = *(const u32x2*)(rp_ + R_K + kc); g_v = *(const unsigned*)(rp_ + R_V + vc); \
        g_pr = hp_ ? *(const u32x2*)(rp_ - N1P + R_R + kc) : (u32x2){0u, 0u}; g_pk = hp_ ? *(const u32x2*)(rp_ - N1P + R_K + kc) : (u32x2){0u, 0u}; g_pv = hp_ ? *(const unsigned*)(rp_ - N1P + R_V + vc) : 0u; \
        g_w = *(const f32x4*)(WAG + m_ * 512 + kc); g_a = *(const f32x4*)(WAG + (size_t)M * 512 + m_ * 512 + kc); } while (0)
#define RW_PREP() do { f32x4 r_, k_, pr_, pk_; \
        r_[0] = bflo(g_r.x); r_[1] = bfhi(g_r.x); r_[2] = bflo(g_r.y); r_[3] = bfhi(g_r.y); k_[0] = bflo(g_k.x); k_[1] = bfhi(g_k.x); k_[2] = bflo(g_k.y); k_[3] = bfhi(g_k.y); \
        pr_[0] = bflo(g_pr.x); pr_[1] = bfhi(g_pr.x); pr_[2] = bflo(g_pr.y); pr_[3] = bfhi(g_pr.y); pk_[0] = bflo(g_pk.x); pk_[1] = bfhi(g_pk.x); pk_[2] = bflo(g_pk.y); pk_[3] = bfhi(g_pk.y); \
        r_ = r_ + (pr_ - r_) * mur; k_ = k_ + (pk_ - k_) * muk; \
        f32x4 kk_ = k_ * kkc; const float ss_ = dpp_sum16((kk_[0] * kk_[0] + kk_[1] * kk_[1]) + (kk_[2] * kk_[2] + kk_[3] * kk_[3])); \
        kk_ = kk_ * (1.0f / fmaxf(sqrtf(ss_), 1e-12f)); const f32x4 km_ = k_ * (1.0f + (g_a - 1.0f) * kac), bb_ = kk_ * g_a; \
        *(LAS f32x4*)(LW + ps * 64 + pq * 4) = g_w; *(LAS f32x4*)(LKK + ps * 64 + pq * 4) = kk_; *(LAS f32x4*)(LBB + ps * 64 + pq * 4) = bb_; \
        *(LAS f32x4*)(LKM + ps * 64 + pq * 4) = km_; *(LAS f32x4*)(LRR + ps * 64 + pq * 4) = r_; \
        const float v0_ = bflo(g_v), v1_ = bfhi(g_v), pv0_ = bflo(g_pv), pv1_ = bfhi(g_pv); \
        LV[ps * 32 + pq * 2] = v0_ + (pv0_ - v0_) * muv[0]; LV[ps * 32 + pq * 2 + 1] = v1_ + (pv1_ - v1_) * muv[1]; } while (0)
    RW_LOAD(0); RW_PREP();
    for (int t0 = 0; t0 < T; t0 += RW_TS) {
        __syncthreads();
        if (t0 + RW_TS < T) RW_LOAD(t0 + RW_TS);
        f32x4 wv = *(const LAS f32x4*)(LW + sq * 4), kkv = *(const LAS f32x4*)(LKK + sq * 4), bbv = *(const LAS f32x4*)(LBB + sq * 4), kmv = *(const LAS f32x4*)(LKM + sq * 4), rrv = *(const LAS f32x4*)(LRR + sq * 4); float vv = LV[vl];
        float yp[16];
#pragma unroll
        for (int s = 0; s < RW_TS; ++s) {
            f32x4 wn = wv, kkn = kkv, bbn = bbv, kmn = kmv, rrn = rrv; float vn = vv;
            if (s + 1 < RW_TS) { wn = *(const LAS f32x4*)(LW + (s + 1) * 64 + sq * 4); kkn = *(const LAS f32x4*)(LKK + (s + 1) * 64 + sq * 4); bbn = *(const LAS f32x4*)(LBB + (s + 1) * 64 + sq * 4);
                kmn = *(const LAS f32x4*)(LKM + (s + 1) * 64 + sq * 4); rrn = *(const LAS f32x4*)(LRR + (s + 1) * 64 + sq * 4); vn = LV[(s + 1) * 32 + vl]; }
            const f32x2 d2 = S01 * (f32x2){kkv[0], kkv[1]} + S23 * (f32x2){kkv[2], kkv[3]};
            const float sa = dpp_sum16(d2.x + d2.y);
            const f32x2 sa2 = {sa, sa}, v2 = {vv, vv};
            const f32x2 t01 = v2 * (f32x2){kmv[0], kmv[1]} - sa2 * (f32x2){bbv[0], bbv[1]}, t23 = v2 * (f32x2){kmv[2], kmv[3]} - sa2 * (f32x2){bbv[2], bbv[3]};
            S01 = S01 * (f32x2){wv[0], wv[1]} + t01; S23 = S23 * (f32x2){wv[2], wv[3]} + t23;
            const f32x2 e2 = S01 * (f32x2){rrv[0], rrv[1]} + S23 * (f32x2){rrv[2], rrv[3]};
            yp[s & 15] = e2.x + e2.y;
            if ((s & 15) == 15) {
                float t8[8], u4[4], w2[2];
#pragma unroll
                for (int i = 0; i < 8; ++i) { const float keep = b3 ? yp[i + 8] : yp[i], give = b3 ? yp[i] : yp[i + 8]; t8[i] = keep + __int_as_float(__builtin_amdgcn_update_dpp(0, __float_as_int(give), 0x140, 0xF, 0xF, false)); }
#pragma unroll
                for (int i = 0; i < 4; ++i) { const float keep = b2 ? t8[i + 4] : t8[i], give = b2 ? t8[i] : t8[i + 4]; u4[i] = keep + __int_as_float(__builtin_amdgcn_update_dpp(0, __float_as_int(give), 0x141, 0xF, 0xF, false)); }
#pragma unroll
                for (int i = 0; i < 2; ++i) { const float keep = b1 ? u4[i + 2] : u4[i], give = b1 ? u4[i] : u4[i + 2]; w2[i] = keep + __int_as_float(__builtin_amdgcn_update_dpp(0, __float_as_int(give), 0x1B, 0xF, 0xF, false)); }
                const float keep = b0 ? w2[1] : w2[0], give = b0 ? w2[0] : w2[1];
                LY[((s & ~15) + sq) * 32 + vl] = keep + __int_as_float(__builtin_amdgcn_update_dpp(0, __float_as_int(give), 0xB1, 0xF, 0xF, false));
            }
            wv = wn; kkv = kkn; bbv = bbn; kmv = kmn; rrv = rrn; vv = vn;
        }
        __syncthreads();
        { const float y0 = LY[ps * 32 + pq * 2], y1 = LY[ps * 32 + pq * 2 + 1];
          *(unsigned*)(YR + ((size_t)b * T + t0 + ps) * 512 + vc) = cvt_pk_bf16(y0, y1); }
        if (t0 + RW_TS < T) RW_PREP();
    }
#undef RW_LOAD
#undef RW_PREP
}
__device__ __forceinline__ void rwkv_post_phase(Frame& F, const Args& A) {
    F.tid = fresh_tid(); F.lane = F.tid & 63;
    const int gw = F.vcu * NWAVES + F.wave, NGW = F.G * NWAVES, lane = F.lane;
    const bf16_t* P1 = (const bf16_t*)(F.ws + WS_P1); const float* WAG = (const float*)(F.ws + WS_WAG); const bf16_t* YR = (const bf16_t*)(F.ws + WS_YRAW); bf16_t* YC = (bf16_t*)(F.ws + WS_YC1);
    const float* mu = A.in[16];
    const int hq = gw & 1, hc = (hq * 4 + (lane >> 4)) * 64 + (lane & 15) * 4;
    const f32x4 mur = *(const f32x4*)(mu + R_R + hc), muk = *(const f32x4*)(mu + R_K + hc), muv = *(const f32x4*)(mu + R_V + hc);
    const f32x4 ka = *(const f32x4*)(A.in[23] + hc), rk = *(const f32x4*)(A.in[24] + hc), lg = *(const f32x4*)(A.in[25] + hc), lb = *(const f32x4*)(A.in[26] + hc);
#define UNP4(dst, w) do { dst[0] = bflo((w).x); dst[1] = bfhi((w).x); dst[2] = bflo((w).y); dst[3] = bfhi((w).y); } while (0)
    for (int it0 = gw; it0 < M * 2; it0 += 2 * NGW) {
        u32x2 cr[2], ck[2], cv[2], pr[2], pk[2], pv[2], yw[2]; f32x4 a4[2], g4[2]; int mm[2]; bool ok[2];
#pragma unroll
        for (int j = 0; j < 2; ++j) { const int it = it0 + j * NGW; ok[j] = it < M * 2; const int m = ok[j] ? (it >> 1) : 0; mm[j] = m; const bf16_t* rp = P1 + (size_t)m * N1P; const bool hp = (m % T) > 0;
            cr[j] = *(const u32x2*)(rp + R_R + hc); ck[j] = *(const u32x2*)(rp + R_K + hc); cv[j] = *(const u32x2*)(rp + R_V + hc);
            pr[j] = hp ? *(const u32x2*)(rp - N1P + R_R + hc) : (u32x2){0u, 0u}; pk[j] = hp ? *(const u32x2*)(rp - N1P + R_K + hc) : (u32x2){0u, 0u}; pv[j] = hp ? *(const u32x2*)(rp - N1P + R_V + hc) : (u32x2){0u, 0u};
            a4[j] = *(const f32x4*)(WAG + (size_t)M * 512 + (size_t)m * 512 + hc); g4[j] = *(const f32x4*)(WAG + (size_t)2 * M * 512 + (size_t)m * 512 + hc); yw[j] = *(const u32x2*)(YR + (size_t)m * 512 + hc); }
#pragma unroll
        for (int j = 0; j < 2; ++j) { f32x4 r, k, v, r0, k0, v0, y;
            UNP4(r, cr[j]); UNP4(k, ck[j]); UNP4(v, cv[j]); UNP4(r0, pr[j]); UNP4(k0, pk[j]); UNP4(v0, pv[j]); UNP4(y, yw[j]);
            r = r + (r0 - r) * mur; k = k + (k0 - k) * muk; v = v + (v0 - v) * muv;
            const f32x4 km = k * (1.0f + (a4[j] - 1.0f) * ka);
            const float mean = dpp_sum16((y[0] + y[1]) + (y[2] + y[3])) * (1.0f / 64.0f); const f32x4 d = y - mean;
            const float var = dpp_sum16((d[0] * d[0] + d[1] * d[1]) + (d[2] * d[2] + d[3] * d[3])) * (1.0f / 64.0f); const float rstd = rsqrtf(var + 64e-5f);
            const f32x4 t = r * km * rk; const float bsum = dpp_sum16((t[0] + t[1]) + (t[2] + t[3]));
            const f32x4 o = (d * rstd * lg + lb + v * bsum) * g4[j];
            if (ok[j]) { u32x2 w; w.x = cvt_pk_bf16(o[0], o[1]); w.y = cvt_pk_bf16(o[2], o[3]); *(u32x2*)(YC + (size_t)mm[j] * D + hc) = w; } }
    }
#undef UNP4
}

__device__ __forceinline__ void router_phase(Frame& F, const Args& A, const bf16_t* H) {
    F.tid = fresh_tid(); F.lane = F.tid & 63;
    LAS float* RW = (LAS float*)F.lds;
    LAS int* LC = (LAS int*)(F.lds + 32768);
    LAS float* LG = (LAS float*)(F.lds + 36864);
    const float* rt = A.in[29]; const float* gf = A.in[2] + D; const pg8::u64* ssq = (const pg8::u64*)(F.ctl + CW_SSQ3);
    unsigned* cnt = F.ctl + CW_CNT; int* lists = (int*)(F.ws + WS_LIST); float* glists = (float*)(F.ws + WS_GLIST); float* rlists = (float*)(F.ws + WS_RLIST); int* toki = (int*)(F.ws + WS_TOKI);
    for (int i = F.tid; i < 8192; i += NTHR) { const int k = i >> 3, e = i & 7; RW[((e * 4 + ((k >> 2) & 3)) * 64 + (k >> 4)) * 4 + (k & 3)] = rt[i] * gf[k]; }
    __syncthreads();
    unsigned char* h8 = F.ws + WS_H3B;
    for (int blk = blockIdx.x; blk < M / 64; blk += F.G) {
        if (F.tid < 8) LC[F.tid] = 0;
        __syncthreads();
        for (int j = 0; j < 8; ++j) { const int tl = F.wave * 8 + j, m = blk * 64 + tl; const u32x4* hr = (const u32x4*)(H + (size_t)m * D) + 2 * F.lane;
            float acc[8];
#pragma unroll
            for (int e = 0; e < 8; ++e) acc[e] = 0.f;
            const u32x4 xb0 = hr[0], xb1 = hr[1]; f32x4 x[4];
            x[0] = (f32x4){bflo(xb0.x), bfhi(xb0.x), bflo(xb0.y), bfhi(xb0.y)}; x[1] = (f32x4){bflo(xb0.z), bfhi(xb0.z), bflo(xb0.w), bfhi(xb0.w)};
            x[2] = (f32x4){bflo(xb1.x), bfhi(xb1.x), bflo(xb1.y), bfhi(xb1.y)}; x[3] = (f32x4){bflo(xb1.z), bfhi(xb1.z), bflo(xb1.w), bfhi(xb1.w)};
            { u32x4 w;
              w.x = pk_fp8x4(x[0].x * pg8::Q8_H, x[0].y * pg8::Q8_H, x[0].z * pg8::Q8_H, x[0].w * pg8::Q8_H); w.y = pk_fp8x4(x[1].x * pg8::Q8_H, x[1].y * pg8::Q8_H, x[1].z * pg8::Q8_H, x[1].w * pg8::Q8_H);
              w.z = pk_fp8x4(x[2].x * pg8::Q8_H, x[2].y * pg8::Q8_H, x[2].z * pg8::Q8_H, x[2].w * pg8::Q8_H); w.w = pk_fp8x4(x[3].x * pg8::Q8_H, x[3].y * pg8::Q8_H, x[3].z * pg8::Q8_H, x[3].w * pg8::Q8_H);
              *(u32x4*)(h8 + (size_t)m * D + F.lane * 16) = w; }
#pragma unroll
            for (int q = 0; q < 4; ++q) {
#pragma unroll
                for (int e = 0; e < 8; ++e) { const f32x4 wv = *(const LAS f32x4*)(RW + ((e * 4 + q) * 64 + F.lane) * 4); acc[e] += (x[q].x * wv.x + x[q].y * wv.y) + (x[q].z * wv.z + x[q].w * wv.w); } }
            const float rs = pg8::rs_from(ssq[m]);
#pragma unroll
            for (int e = 0; e < 8; ++e) acc[e] = wave_sum(acc[e]) * rs;
            int e1 = 0; float v1 = acc[0];
#pragma unroll
            for (int e = 1; e < 8; ++e) if (acc[e] > v1) { v1 = acc[e]; e1 = e; }
            int e2 = (e1 == 0) ? 1 : 0; float v2 = -INFINITY;
#pragma unroll
            for (int e = 0; e < 8; ++e) if (e != e1 && acc[e] > v2) { v2 = acc[e]; e2 = e; }
            const float g2 = 1.0f / (1.0f + __expf(v1 - v2)), g1 = 1.0f - g2;
            if (F.lane == 0) { const int lp1 = atomicAdd((int*)&LC[e1], 1), lp2 = atomicAdd((int*)&LC[e2], 1);
                LC[16 + tl * 4 + 0] = e1; LC[16 + tl * 4 + 1] = e2; LC[16 + tl * 4 + 2] = lp1; LC[16 + tl * 4 + 3] = lp2; LG[16 + tl * 2] = g1; LG[16 + tl * 2 + 1] = g2; } }
        __syncthreads();
        if (F.tid < 8) LC[8 + F.tid] = (int)atomicAdd(cnt + F.tid, (unsigned)LC[F.tid]);
        __syncthreads();
        if (F.tid < 64) { const int tl = F.tid, m = blk * 64 + tl; const int e1 = LC[16 + tl * 4], e2 = LC[16 + tl * 4 + 1]; const int p1 = LC[8 + e1] + LC[16 + tl * 4 + 2], p2 = LC[8 + e2] + LC[16 + tl * 4 + 3];
            lists[e1 * M + p1] = m; lists[e2 * M + p2] = m; glists[e1 * M + p1] = LG[16 + tl * 2]; glists[e2 * M + p2] = LG[16 + tl * 2 + 1];
            { const float rsm = pg8::rs_from(ssq[m]); rlists[e1 * M + p1] = rsm; rlists[e2 * M + p2] = rsm; }
            *(int4*)(toki + (size_t)m * 4) = make_int4(e1, p1, e2, p2); }
        __syncthreads();
    }
}

struct MoeOrder {
    int cn[8]; int NT, G, c; bool down; const int* lists; const float* glists; int kdiv;
    __device__ __forceinline__ int total_units() const { int P = 0;
#pragma unroll
        for (int q = 0; q < 8; ++q) P += (cn[q] + 255) >> 8;
        return P * NT; }
    __device__ __forceinline__ bool split_tail() const { const int U = total_units(); return down && U > 512 && U <= 548; }
    __device__ __forceinline__ int tail_row0() const { int gp = 0, seg = 0, r0 = 0; bool f = false;
#pragma unroll
        for (int q = 0; q < 8; ++q) { const int nq = (cn[q] + 255) >> 8; if (!f && gp + nq > 128) { r0 = seg + (128 - gp) * 256; f = true; } gp += nq; seg += cn[q]; }
        return r0; }
    __device__ bool next(int i, pg8::Unit& u) const {
        const int cp = (c % 8) * (G / 8) + c / 8; int L = i * G + cp, ks = -1;
        if (split_tail() && i >= 2) { const int sub = (i - 2) * G + cp; if (sub >= MOE_KS * (total_units() - 512)) return false; L = 512 + sub / MOE_KS; ks = sub % MOE_KS; }
        int seg = 0, e = 8, np = 0, ce = 0; bool found = false;
#pragma unroll
        for (int q = 0; q < 8; ++q) { if (!found) { const int cq = cn[q], nq = (cq + 255) >> 8, ne = nq * NT; if (L < ne) { found = true; e = q; ce = cq; np = nq; } else { L -= ne; seg += cq; } } }
        if (!found) return false;
        const int full = NT >> 3, remt = NT & 7; int p, tile;
        if (L < full * np * 8) { const int tg = L / (np * 8), rem = L % (np * 8); p = rem >> 3; tile = tg * 8 + (rem & 7); }
        else { const int l2 = L - full * np * 8; p = l2 / remt; tile = full * 8 + l2 % remt; }
        u.nrows = min(256, ce - p * 256); u.orow = seg + p * 256; u.ocol = tile * 256; u.ex = 0; u.arow = seg + p * 256; u.koff = 0; u.nt = 0;
        if (ks >= 0) { u.ex = 1 + ks; u.koff = ks * (FE / MOE_KS) / kdiv; u.nt = FE / MOE_KS / 64 / kdiv; }
        if (!down) { u.brow = e * 2 * FE + tile * 256; u.rows = lists + e * M + p * 256; }
        else { u.brow = e * D + tile * 256; u.rows = (const int*)(glists + e * M + p * 256); }
        return true;
    }
};

__device__ __forceinline__ void final_phase(Frame& F, const Args& A, const bf16_t* H3, float* H) {
    F.tid = fresh_tid(); F.lane = F.tid & 63;
    const int gw = F.vcu * NWAVES + F.wave, NGW = F.G * NWAVES, lane = F.lane; const unsigned* cnt = F.ctl + CW_CNT; const int* toki = (const int*)(F.ws + WS_TOKI);
    const bf16_t* OS = (const bf16_t*)(F.ws + WS_OUTS); const bf16_t* OP = (const bf16_t*)(F.ws + WS_OUTP); const float* fg = A.in[33];
    int seg[8]; MoeOrder MO; { int s = 0;
#pragma unroll
        for (int e = 0; e < 8; ++e) { seg[e] = s; MO.cn[e] = (int)cnt[e]; s += (int)cnt[e]; } }
    MO.NT = D / 256; MO.down = true; MO.kdiv = 2; const bool split = MO.split_tail(); const int tr0 = split ? MO.tail_row0() : 0x7fffffff;
    f32x4 gv[4];
#pragma unroll
    for (int j = 0; j < 4; ++j) gv[j] = *((const f32x4*)fg + lane + 64 * j);
    for (int m0 = gw; m0 < M; m0 += 2 * NGW) {
        int sl[2][2]; f32x4 v[2][4]; u32x2 o[2][2][4];
#pragma unroll
        for (int q = 0; q < 2; ++q) { const int m = m0 + q * NGW; const int4 ti = *(const int4*)(toki + (size_t)m * 4); int s1 = 0, s2 = 0;
#pragma unroll
            for (int e = 0; e < 8; ++e) { if (ti.x == e) s1 = seg[e]; if (ti.z == e) s2 = seg[e]; }
            sl[q][0] = s1 + ti.y; sl[q][1] = s2 + ti.w; }
#pragma unroll
        for (int q = 0; q < 2; ++q) { const int m = m0 + q * NGW; const u32x2* hr = (const u32x2*)(H3 + (size_t)m * D) + lane;
#pragma unroll
            for (int j = 0; j < 4; ++j) { const u32x2 hb = hr[64 * j]; v[q][j] = (f32x4){bflo(hb.x), bfhi(hb.x), bflo(hb.y), bfhi(hb.y)}; }
#pragma unroll
            for (int w2 = 0; w2 < 2; ++w2) { const int s_ = sl[q][w2];
                if (s_ < tr0) { const u32x2* o1 = (const u32x2*)(OS + (size_t)s_ * D) + lane;
#pragma unroll
                    for (int j = 0; j < 4; ++j) o[q][w2][j] = o1[64 * j]; }
                else {
#pragma unroll
                    for (int j = 0; j < 4; ++j) o[q][w2][j] = (u32x2){0u, 0u};
                    for (int ks = 0; ks < MOE_KS; ++ks) { const u32x2* o1 = (const u32x2*)(OP + ((size_t)ks * MOE_TAIL_ROWS + (s_ - tr0)) * D) + lane;
#pragma unroll
                        for (int j = 0; j < 4; ++j) { const u32x2 a = o1[64 * j]; v[q][j].x += bflo(a.x); v[q][j].y += bfhi(a.x); v[q][j].z += bflo(a.y); v[q][j].w += bfhi(a.y); } } } } }
#pragma unroll
        for (int q = 0; q < 2; ++q) { const int m = m0 + q * NGW; float s = 0.f;
#pragma unroll
            for (int j = 0; j < 4; ++j) {
#pragma unroll
                for (int w2 = 0; w2 < 2; ++w2) { const u32x2 a = o[q][w2][j]; v[q][j].x += bflo(a.x); v[q][j].y += bfhi(a.x); v[q][j].z += bflo(a.y); v[q][j].w += bfhi(a.y); }
                s += (v[q][j].x * v[q][j].x + v[q][j].y * v[q][j].y) + (v[q][j].z * v[q][j].z + v[q][j].w * v[q][j].w); }
            const float rs = rsqrtf(wave_sum(s) * (1.0f / 1024.0f) + 1e-6f); f32x4* hw = (f32x4*)(H + (size_t)m * D) + lane;
#pragma unroll
            for (int j = 0; j < 4; ++j) hw[64 * j] = v[q][j] * rs * gv[j]; } }
}
typedef __bf16 bf16x2c_t __attribute__((ext_vector_type(2)));
__device__ __forceinline__ unsigned cvt_pk_c(float lo, float hi) { f32x2 v = {lo, hi}; bf16x2c_t b = __builtin_convertvector(v, bf16x2c_t); return __builtin_bit_cast(unsigned, b); }
constexpr int RP = 72;
constexpr int RC_A = 0, RC_B = 9216, RC_K = 18432, RC_R = 27648, RC_AT = 36864, RC_BHT = 46080, RC_KHT = 55296, RC_VT = 64512;
constexpr int RC_AAB = 73728, RC_T = 90368, RC_AAK = 107008, RC_MRK = 116224, RC_ELC = 125440, RC_TMP = 125696;
constexpr int RC_LA = RC_AAB, RC_SS = RC_T, RC_MRB = RC_A, RC_X1T = RC_B, RC_TB = RC_K, RC_WT = RC_AAB, RC_U0T = RC_T, RC_GI = RC_AT, RC_QI = RC_B;
constexpr int RC_STG = RC_T + 4096;
static_assert(RC_TMP + 4096 <= RING_BYTES && RC_STG + 3 * 65 * RP * 2 <= RC_ELC, "rwkv pre LDS map");
__device__ __forceinline__ size_t wag_fp(int m0, int h, int o) { return ((size_t)(m0 + (o >> 8)) * 512 + h * 64) * 4 + (o & 255); }

__device__ __forceinline__ void rwkv_pre_phase(Frame& F, const Args& A) {
    F.tid = fresh_tid(); F.lane = F.tid & 63;
    const int tid = F.tid, lane = F.lane, wave = F.wave, r32 = lane & 31, hi = lane >> 5, kw = wave * 8;
    const bf16_t* P1 = (const bf16_t*)(F.ws + WS_P1); unsigned char* WAG0 = F.ws + WS_WAG; unsigned char* WAG1 = F.ws + WS_WAG + (size_t)M * 512 * 4; float* BON = (float*)(F.ws + WS_BON);
    LAS unsigned char* L = F.lds;
    LAS bf16_t* IA = (LAS bf16_t*)(L + RC_A); LAS bf16_t* IB = (LAS bf16_t*)(L + RC_B); LAS bf16_t* IK = (LAS bf16_t*)(L + RC_K); LAS bf16_t* IR = (LAS bf16_t*)(L + RC_R);
    LAS bf16_t* IAT = (LAS bf16_t*)(L + RC_AT); LAS bf16_t* IBH = (LAS bf16_t*)(L + RC_BHT); LAS bf16_t* IKH = (LAS bf16_t*)(L + RC_KHT); LAS bf16_t* IVT = (LAS bf16_t*)(L + RC_VT);
    LAS float* AAB = (LAS float*)(L + RC_AAB); LAS float* TM = (LAS float*)(L + RC_T); LAS bf16_t* IAK = (LAS bf16_t*)(L + RC_AAK); LAS bf16_t* IMK = (LAS bf16_t*)(L + RC_MRK);
    LAS float* ELC = (LAS float*)(L + RC_ELC); LAS float* TMP = (LAS float*)(L + RC_TMP); LAS float* LA = (LAS float*)(L + RC_LA); LAS float* SS = (LAS float*)(L + RC_SS);
    LAS bf16_t* IMB = (LAS bf16_t*)(L + RC_MRB); LAS bf16_t* IX1 = (LAS bf16_t*)(L + RC_X1T); LAS bf16_t* ITB = (LAS bf16_t*)(L + RC_TB); LAS bf16_t* IWT = (LAS bf16_t*)(L + RC_WT); LAS bf16_t* IU0 = (LAS bf16_t*)(L + RC_U0T);
    LAS bf16_t* IGI = (LAS bf16_t*)(L + RC_GI); LAS bf16_t* IQI = (LAS bf16_t*)(L + RC_QI);
    LAS bf16_t* SR = (LAS bf16_t*)(L + RC_STG); LAS bf16_t* SK = (LAS bf16_t*)(L + RC_STG + 65 * RP * 2); LAS bf16_t* SV = (LAS bf16_t*)(L + RC_STG + 2 * 65 * RP * 2);
    const int h = ((int)blockIdx.x >> 5) & 7;
    const float* mu = A.in[16]; const int hc = h * 64 + kw;
    for (int c = blockIdx.x; c < 2048; c += F.G) {
        const int bh = c >> 5, n = c & 31, b = bh >> 3, m0 = b * T + n * 64; const bool hp = (n * 64 + lane) > 0;
        f32x4 mur[2], muk[2], muv[2], kkc[2], kac[2], rkc[2];
#pragma unroll
        for (int q = 0; q < 2; ++q) { mur[q] = *(const f32x4*)(mu + R_R + hc + 4 * q); muk[q] = *(const f32x4*)(mu + R_K + hc + 4 * q); muv[q] = *(const f32x4*)(mu + R_V + hc + 4 * q);
            kkc[q] = *(const f32x4*)(A.in[22] + hc + 4 * q); kac[q] = *(const f32x4*)(A.in[23] + hc + 4 * q); rkc[q] = *(const f32x4*)(A.in[24] + hc + 4 * q); }
        const u32x4 z4 = (u32x4){0u, 0u, 0u, 0u};
        { const int srow = 8 * wave + (lane >> 3), sch = (lane & 7) * 8; const bf16_t* gp = P1 + (size_t)(m0 + srow) * N1P + h * 64 + sch;
          const u32x4 tr = *(const u32x4*)(gp + R_R), tk = *(const u32x4*)(gp + R_K), tv = *(const u32x4*)(gp + R_V);
          u32x4 qr = z4, qk = z4, qv = z4; const bool edge = (wave == 0) && (lane < 8);
          if (edge && n > 0) { const bf16_t* g0 = P1 + (size_t)(m0 - 1) * N1P + h * 64 + sch; qr = *(const u32x4*)(g0 + R_R); qk = *(const u32x4*)(g0 + R_K); qv = *(const u32x4*)(g0 + R_V); }
          f32x4 tw[2];
#pragma unroll
          for (int i = 0; i < 2; ++i) { const int wrow = 8 * wave + 4 * i + (lane >> 4); tw[i] = *(const f32x4*)(WAG0 + ((size_t)(m0 + wrow) * 512 + h * 64 + (lane & 15) * 4) * 4); }
          *(LAS u32x4*)(SR + (srow + 1) * RP + sch) = tr; *(LAS u32x4*)(SK + (srow + 1) * RP + sch) = tk; *(LAS u32x4*)(SV + (srow + 1) * RP + sch) = tv;
          if (edge) { *(LAS u32x4*)(SR + sch) = qr; *(LAS u32x4*)(SK + sch) = qk; *(LAS u32x4*)(SV + sch) = qv; }
#pragma unroll
          for (int i = 0; i < 2; ++i) { const int wrow = 8 * wave + 4 * i + (lane >> 4); *(LAS f32x4*)(LA + wrow * 64 + (lane & 15) * 4) = tw[i]; } }
        __syncthreads();
        const u32x4 cr = *(const LAS u32x4*)(SR + (lane + 1) * RP + kw), ck = *(const LAS u32x4*)(SK + (lane + 1) * RP + kw), cv = *(const LAS u32x4*)(SV + (lane + 1) * RP + kw);
        const u32x4 pr = *(const LAS u32x4*)(SR + lane * RP + kw), pk = *(const LAS u32x4*)(SK + lane * RP + kw), pv = *(const LAS u32x4*)(SV + lane * RP + kw);
        const size_t wo = ((size_t)(m0 + lane) * 512 + hc) * 4;
        const f32x4 lw0 = *(const LAS f32x4*)(LA + lane * 64 + kw), lw1 = *(const LAS f32x4*)(LA + lane * 64 + kw + 4), as0 = *(const f32x4*)(WAG1 + wo), as1 = *(const f32x4*)(WAG1 + wo + 16);
        float r[8], k[8], v[8], lw[8], as[8];
#pragma unroll
        for (int q = 0; q < 4; ++q) { const float m_r0 = mur[q >> 1][(q & 1) * 2], m_r1 = mur[q >> 1][(q & 1) * 2 + 1], m_k0 = muk[q >> 1][(q & 1) * 2], m_k1 = muk[q >> 1][(q & 1) * 2 + 1], m_v0 = muv[q >> 1][(q & 1) * 2], m_v1 = muv[q >> 1][(q & 1) * 2 + 1];
            float c0 = bflo(cr[q]), c1 = bfhi(cr[q]); r[2 * q] = c0 + (bflo(pr[q]) - c0) * m_r0; r[2 * q + 1] = c1 + (bfhi(pr[q]) - c1) * m_r1;
            c0 = bflo(ck[q]); c1 = bfhi(ck[q]); k[2 * q] = c0 + (bflo(pk[q]) - c0) * m_k0; k[2 * q + 1] = c1 + (bfhi(pk[q]) - c1) * m_k1;
            c0 = bflo(cv[q]); c1 = bfhi(cv[q]); v[2 * q] = c0 + (bflo(pv[q]) - c0) * m_v0; v[2 * q + 1] = c1 + (bfhi(pv[q]) - c1) * m_v1; }
#pragma unroll
        for (int j = 0; j < 4; ++j) { lw[j] = lw0[j]; lw[4 + j] = lw1[j]; as[j] = as0[j]; as[4 + j] = as1[j]; }
        float kkv[8], km[8], ssp = 0.f, bp = 0.f;
#pragma unroll
        for (int j = 0; j < 8; ++j) { kkv[j] = k[j] * kkc[j >> 2][j & 3]; ssp += kkv[j] * kkv[j]; km[j] = k[j] * (1.0f + (as[j] - 1.0f) * kac[j >> 2][j & 3]); bp += r[j] * km[j] * rkc[j >> 2][j & 3]; }
        SS[wave * 64 + lane] = ssp; SS[512 + wave * 64 + lane] = bp;
        asm volatile("s_waitcnt lgkmcnt(0)" ::: "memory");
        if (lane < 8) { float xs[64];
#pragma unroll
            for (int t = 0; t < 64; ++t) xs[t] = LA[t * 64 + kw + lane];
#pragma unroll
            for (int t = 1; t < 64; ++t) xs[t] += xs[t - 1];
#pragma unroll
            for (int t = 0; t < 64; ++t) LA[t * 64 + kw + lane] = xs[t]; }
        asm volatile("s_waitcnt lgkmcnt(0)" ::: "memory");
        float Lc[8], LC[8];
        { const f32x4 b0 = *(const LAS f32x4*)(LA + lane * 64 + kw), b1 = *(const LAS f32x4*)(LA + lane * 64 + kw + 4), e0 = *(const LAS f32x4*)(LA + 63 * 64 + kw), e1 = *(const LAS f32x4*)(LA + 63 * 64 + kw + 4);
#pragma unroll
          for (int j = 0; j < 4; ++j) { Lc[j] = b0[j]; Lc[4 + j] = b1[j]; LC[j] = e0[j]; LC[4 + j] = e1[j]; } }
        __syncthreads();
        float ss = 0.f, bon = 0.f;
#pragma unroll
        for (int w = 0; w < 8; ++w) { ss += SS[w * 64 + lane]; bon += SS[512 + w * 64 + lane]; }
        const float inv = rsqrtf(fmaxf(ss, 1e-24f));
        if (wave == 0) BON[(size_t)(m0 + lane) * 8 + h] = bon;
        { float ia[8], ib[8], ik[8], ir[8], ibh[8], ikh[8];
#pragma unroll
          for (int j = 0; j < 8; ++j) { const float kn = kkv[j] * inv, bb = kn * as[j], eL = __expf(Lc[j]), eN = __expf(-Lc[j]), eP = __expf(Lc[j] - lw[j]), eC = __expf(LC[j] - Lc[j]);
              ia[j] = -kn * eP; ib[j] = bb * eN; ik[j] = km[j] * eN; ir[j] = r[j] * eL; ibh[j] = bb * eC; ikh[j] = km[j] * eC; }
          u32x4 w4;
#define PK8(src) (w4.x = cvt_pk_bf16(src[0], src[1]), w4.y = cvt_pk_bf16(src[2], src[3]), w4.z = cvt_pk_bf16(src[4], src[5]), w4.w = cvt_pk_bf16(src[6], src[7]), w4)
          *(LAS u32x4*)(IA + lane * RP + kw) = PK8(ia); *(LAS u32x4*)(IB + lane * RP + kw) = PK8(ib); *(LAS u32x4*)(IK + lane * RP + kw) = PK8(ik); *(LAS u32x4*)(IR + lane * RP + kw) = PK8(ir);
#undef PK8
#pragma unroll
          for (int j = 0; j < 8; ++j) { IAT[(kw + j) * RP + lane] = (bf16_t)f2bf(ia[j]); IBH[(kw + j) * RP + lane] = (bf16_t)f2bf(ibh[j]); IKH[(kw + j) * RP + lane] = (bf16_t)f2bf(ikh[j]); IVT[(kw + j) * RP + lane] = (bf16_t)f2bf(v[j]); }
          if (lane < 8) { float d = LC[0];
#pragma unroll
              for (int j = 1; j < 8; ++j) d = (lane == j) ? LC[j] : d;
              ELC[kw + lane] = __expf(d); } }
        __syncthreads();
        for (int i = tid; i < 64 * 65; i += NTHR) TM[i] = 0.f;
        { const int ti = wave >> 2, which = (wave >> 1) & 1, tj = wave & 1; f32x16 acc = {};
          if (tj <= ti) acc = gla_mma64(acc, IA + 32 * ti * RP, (which ? IK : IB) + 32 * tj * RP, r32, hi);
#pragma unroll
          for (int rr = 0; rr < 16; ++rr) { const int t = 32 * ti + crow32(rr, hi), s = 32 * tj + r32; const float val = (s < t) ? acc[rr] : 0.f;
              if (which == 0) AAB[t * 65 + s] = val; else IAK[t * RP + s] = (bf16_t)f2bf(val); } }
        __syncthreads();
        { const int ti = wave >> 2, which = (wave >> 1) & 1, tj = wave & 1; f32x16 acc = {};
          if (tj <= ti) acc = gla_mma64(acc, IR + 32 * ti * RP, (which ? IK : IB) + 32 * tj * RP, r32, hi);
          LAS bf16_t* dst = which ? IMK : IMB;
#pragma unroll
          for (int rr = 0; rr < 16; ++rr) { const int t = 32 * ti + crow32(rr, hi), s = 32 * tj + r32; float mv = (s <= t) ? acc[rr] : 0.f; if ((DBG_SKIP) & 32768) mv = (s <= t) ? 0.01f : 0.f; dst[t * RP + s] = (bf16_t)f2bf(mv); } }
        __syncthreads();
        if (wave < 4) { const int tv = wave >> 1, tt = wave & 1; f32x16 acc = {}; acc = gla_mma64(acc, IVT + 32 * tv * RP, IAK + 32 * tt * RP, r32, hi);
#pragma unroll
            for (int rr = 0; rr < 16; ++rr) IX1[(32 * tv + crow32(rr, hi)) * RP + 32 * tt + r32] = (bf16_t)f2bf(acc[rr]); }
        else if (wave == 4) {
            { int cc = lane & 15; asm volatile("" : "+v"(cc)); const int bi = lane >> 4; float x[16];
#pragma unroll
              for (int t = 0; t < 16; ++t) { float s = (t == cc) ? 1.0f : 0.f;
#pragma unroll
                  for (int q = 0; q < 16; ++q) if (q < t) s += AAB[(16 * bi + t) * 65 + 16 * bi + q] * x[q];
                  x[t] = s; TM[(16 * bi + t) * 65 + 16 * bi + cc] = s; } }
            asm volatile("s_waitcnt lgkmcnt(0)" ::: "memory");
            const int l15 = lane & 15, lq = lane >> 4;
#pragma unroll
            for (int blk = 0; blk < 2; ++blk) { const int bi = 2 * blk + 1, bj = 2 * blk; f32x4 p = {0.f, 0.f, 0.f, 0.f};
#pragma unroll
                for (int kk = 0; kk < 4; ++kk) p = __builtin_amdgcn_mfma_f32_16x16x4f32(AAB[(16 * bi + l15) * 65 + 16 * bj + 4 * kk + lq], TM[(16 * bj + 4 * kk + lq) * 65 + 16 * bj + l15], p, 0, 0, 0);
#pragma unroll
                for (int j = 0; j < 4; ++j) TMP[blk * 256 + (4 * lq + j) * 16 + l15] = p[j]; }
            asm volatile("s_waitcnt lgkmcnt(0)" ::: "memory");
#pragma unroll
            for (int blk = 0; blk < 2; ++blk) { const int bi = 2 * blk + 1, bj = 2 * blk; f32x4 p = {0.f, 0.f, 0.f, 0.f};
#pragma unroll
                for (int kk = 0; kk < 4; ++kk) p = __builtin_amdgcn_mfma_f32_16x16x4f32(TM[(16 * bi + l15) * 65 + 16 * bi + 4 * kk + lq], TMP[blk * 256 + (4 * kk + lq) * 16 + l15], p, 0, 0, 0);
#pragma unroll
                for (int j = 0; j < 4; ++j) TM[(16 * bi + 4 * lq + j) * 65 + 16 * bj + l15] = p[j]; }
            asm volatile("s_waitcnt lgkmcnt(0)" ::: "memory");
            { f32x16 x = {};
#pragma unroll
              for (int kk = 0; kk < 16; ++kk) x = __builtin_amdgcn_mfma_f32_32x32x2f32(AAB[(32 + r32) * 65 + 2 * kk + hi], TM[(2 * kk + hi) * 65 + r32], x, 0, 0, 0);
#pragma unroll
              for (int rr = 0; rr < 16; ++rr) TMP[crow32(rr, hi) * 32 + r32] = x[rr]; }
            asm volatile("s_waitcnt lgkmcnt(0)" ::: "memory");
            { f32x16 x = {};
#pragma unroll
              for (int kk = 0; kk < 16; ++kk) x = __builtin_amdgcn_mfma_f32_32x32x2f32(TM[(32 + r32) * 65 + 32 + 2 * kk + hi], TMP[(2 * kk + hi) * 32 + r32], x, 0, 0, 0);
#pragma unroll
              for (int rr = 0; rr < 16; ++rr) TM[(32 + crow32(rr, hi)) * 65 + r32] = x[rr]; }
        }
        __syncthreads();
        { const int t = tid >> 3, s8 = (tid & 7) * 8; const LAS float* tp = TM + t * 65 + s8; u32x4 w4;
          w4.x = cvt_pk_bf16(tp[0], tp[1]); w4.y = cvt_pk_bf16(tp[2], tp[3]); w4.z = cvt_pk_bf16(tp[4], tp[5]); w4.w = cvt_pk_bf16(tp[6], tp[7]); *(LAS u32x4*)(ITB + t * RP + s8) = w4; }
        __syncthreads();
        { const int t0 = (wave >> 1) & 1, t1 = wave & 1; f32x16 acc = {}; acc = gla_mma64(acc, ((wave < 4) ? IAT : IX1) + 32 * t0 * RP, ITB + 32 * t1 * RP, r32, hi);
          LAS bf16_t* dst = (wave < 4) ? IWT : IU0;
#pragma unroll
          for (int rr = 0; rr < 16; ++rr) dst[(32 * t0 + crow32(rr, hi)) * RP + 32 * t1 + r32] = (bf16_t)f2bf(acc[rr]); }
        __syncthreads();
        { const int t0 = (wave >> 1) & 1, t1 = wave & 1, tile = t0 * 2 + t1;
          if (wave < 4) {
              f32x16 g = {}; g = gla_mma64(g, IBH + 32 * t0 * RP, IWT + 32 * t1 * RP, r32, hi);
#pragma unroll
              for (int rr = 0; rr < 16; ++rr) { const int kr = 32 * t0 + crow32(rr, hi), kc = 32 * t1 + r32; IGI[kr * RP + kc] = (bf16_t)f2bf(g[rr] + ((kr == kc) ? ELC[kr] : 0.f)); }
              f32x16 j = {}; j = gla_mma64(j, IBH + 32 * t0 * RP, IU0 + 32 * t1 * RP, r32, hi); j = gla_mma64(j, IKH + 32 * t0 * RP, IVT + 32 * t1 * RP, r32, hi);
              u32x4 w0, w1; w0.x = cvt_pk_c(j[0], j[1]); w0.y = cvt_pk_c(j[2], j[3]); w0.z = cvt_pk_c(j[4], j[5]); w0.w = cvt_pk_c(j[6], j[7]);
              w1.x = cvt_pk_c(j[8], j[9]); w1.y = cvt_pk_c(j[10], j[11]); w1.z = cvt_pk_c(j[12], j[13]); w1.w = cvt_pk_c(j[14], j[15]);
              const int o = tile * 2048 + lane * 16; *(u32x4*)(WAG1 + wag_fp(m0, h, o)) = w0; *(u32x4*)(WAG1 + wag_fp(m0, h, o + 1024)) = w1;
          } else {
              f32x16 q = {}; q = gla_mma64(q, IMB + 32 * t0 * RP, IWT + 32 * t1 * RP, r32, hi);
#pragma unroll
              for (int rr = 0; rr < 16; ++rr) { const int tr = 32 * t0 + crow32(rr, hi), kc = 32 * t1 + r32; IQI[tr * RP + kc] = (bf16_t)f2bf(q[rr] + bf2f(IR[tr * RP + kc])); }
              f32x16 y = {}; if (!((DBG_SKIP) & 8192)) y = gla_mma64(y, IMB + 32 * t0 * RP, IU0 + 32 * t1 * RP, r32, hi); if (!((DBG_SKIP) & 16384)) y = gla_mma64(y, IMK + 32 * t0 * RP, IVT + 32 * t1 * RP, r32, hi);
              if ((DBG_SKIP) & 65536) { for (int rr = 0; rr < 16; ++rr) y[rr] = 0.5f; }
              if ((DBG_SKIP) & 131072) { for (int rr = 0; rr < 16; ++rr) y[rr] = bf2f(IVT[(32 * t1 + r32) * RP + 32 * t0 + crow32(rr, hi)]); }
              if ((DBG_SKIP) & 262144) { for (int rr = 0; rr < 16; ++rr) y[rr] = bf2f(IMK[(32 * t0 + crow32(rr, hi)) * RP + 32 * t1 + r32]); }
              u32x4 w0, w1; w0.x = cvt_pk_c(y[0], y[1]); w0.y = cvt_pk_c(y[2], y[3]); w0.z = cvt_pk_c(y[4], y[5]); w0.w = cvt_pk_c(y[6], y[7]);
              w1.x = cvt_pk_c(y[8], y[9]); w1.y = cvt_pk_c(y[10], y[11]); w1.z = cvt_pk_c(y[12], y[13]); w1.w = cvt_pk_c(y[14], y[15]);
              const int o = 8192 + tile * 2048 + lane * 16; *(u32x4*)(WAG1 + wag_fp(m0, h, o)) = w0; *(u32x4*)(WAG1 + wag_fp(m0, h, o + 1024)) = w1;
          } }
        __syncthreads();
#pragma unroll
        for (int p = 0; p < 2; ++p) { const int o = tid + 512 * p, which = o >> 9, row = (o >> 3) & 63, c8 = (o & 7) * 8;
            const u32x4 val = *(const LAS u32x4*)((which ? IQI : IGI) + row * RP + c8);
            *(u32x4*)(WAG0 + wag_fp(m0, h, ((which * 2 + (row >> 5)) * 4 + (c8 >> 4)) * 1024 + ((row & 31) + 32 * ((c8 >> 3) & 1)) * 16)) = val; }
        __syncthreads();
    }
}

constexpr int RS_HT0 = 0, RS_HT1 = 9216;
__device__ __forceinline__ void rwkv_cscan_phase(Frame& F, const Args& A, int bh, int probe = 0) {
    F.tid = fresh_tid(); F.lane = F.tid & 63; (void)A;
    const int tid = F.tid, lane = F.lane, wave = F.wave, r32 = lane & 31, hi = lane >> 5;
    const int b = bh >> 3, h = bh & 7, t0 = (wave >> 1) & 1, t1 = wave & 1, tile = t0 * 2 + t1; const bool stw = wave < 4;
    const unsigned char* WAG0 = F.ws + WS_WAG; const unsigned char* WAG1 = F.ws + WS_WAG + (size_t)M * 512 * 4; bf16_t* YR = (bf16_t*)(F.ws + (probe ? WS_WE2T + ((size_t)32 << 20) : WS_YRAW));
    LAS bf16_t* HT[2] = {(LAS bf16_t*)(F.lds + RS_HT0), (LAS bf16_t*)(F.lds + RS_HT1)};
    LAS bf16_t* YS = (LAS bf16_t*)(F.lds + 18432 + (wave & 3) * 2560);
    for (int i = tid; i < 2 * 64 * RP / 2; i += NTHR) ((LAS unsigned*)F.lds)[i] = 0u;
    __syncthreads();
    f32x16 acc = {};
    bf16x8 afq[4][4]; u32x4 c0q[4], c1q[4];
#define CS_LOAD(q_, n_) do { const int m0_ = b * T + (n_) * 64; \
        _Pragma("unroll") for (int s_ = 0; s_ < 4; ++s_) afq[q_][s_] = *(const bf16x8*)(WAG0 + wag_fp(m0_, h, (((stw ? 0 : 2) + t0) * 4 + s_) * 1024 + lane * 16)); \
        const int o_ = (stw ? 0 : 8192) + tile * 2048 + lane * 16; c0q[q_] = *(const u32x4*)(WAG1 + wag_fp(m0_, h, o_)); c1q[q_] = *(const u32x4*)(WAG1 + wag_fp(m0_, h, o_ + 1024)); } while (0)
#pragma unroll
    for (int q = 0; q < 4; ++q) CS_LOAD(q, q);
#ifdef SCAN_PROBE
#define CS_LOAD2(q_, n_) do { if (!probe) CS_LOAD(q_, n_); } while (0)
#else
#define CS_LOAD2(q_, n_) CS_LOAD(q_, n_)
#endif
    for (int n0 = 0; n0 < 32; n0 += 4) {
#pragma unroll
      for (int j = 0; j < 4; ++j) { const int n = n0 + j;
        const LAS bf16_t* Hc = HT[n & 1]; LAS bf16_t* Hn = HT[(n + 1) & 1];
        bf16x8 a_[4]; const u32x4 d0 = c0q[j], d1 = c1q[j];
#pragma unroll
        for (int s = 0; s < 4; ++s) a_[s] = afq[j][s];
        CS_LOAD2(j, (n + 4 < 32) ? n + 4 : 31);
        f32x16 o;
        o[0] = bflo(d0.x); o[1] = bfhi(d0.x); o[2] = bflo(d0.y); o[3] = bfhi(d0.y); o[4] = bflo(d0.z); o[5] = bfhi(d0.z); o[6] = bflo(d0.w); o[7] = bfhi(d0.w);
        o[8] = bflo(d1.x); o[9] = bfhi(d1.x); o[10] = bflo(d1.y); o[11] = bfhi(d1.y); o[12] = bflo(d1.z); o[13] = bfhi(d1.z); o[14] = bflo(d1.w); o[15] = bfhi(d1.w);
#pragma unroll
        for (int s = 0; s < 4; ++s) { const bf16x8 bfr = *(const LAS bf16x8*)(Hc + (32 * t1 + r32) * RP + 16 * s + 8 * hi); o = __builtin_amdgcn_mfma_f32_32x32x16_bf16(a_[s], bfr, o, 0, 0, 0); }
        if (stw) {
            acc = o;
#pragma unroll
            for (int g = 0; g < 4; ++g) { u32x2 w; w.x = cvt_pk_c(o[4 * g], o[4 * g + 1]); w.y = cvt_pk_c(o[4 * g + 2], o[4 * g + 3]);
                *(LAS u32x2*)(Hn + (32 * t1 + r32) * RP + 32 * t0 + 8 * g + 4 * hi) = w; }
        } else {
            const int m0 = b * T + n * 64;
#pragma unroll
            for (int rr = 0; rr < 16; ++rr) YS[crow32(rr, hi) * 40 + r32] = (bf16_t)f2bf(o[rr]);
            LDS_WAIT(); asm volatile("" ::: "memory");
#pragma unroll
            for (int i = 0; i < 2; ++i) { const int sg = lane + 64 * i, tk = sg >> 2, vs = sg & 3; const u32x4 w = *(const LAS u32x4*)(YS + tk * 40 + vs * 8);
                *(u32x4*)(YR + (size_t)(m0 + 32 * t0 + tk) * 512 + h * 64 + 32 * t1 + 8 * vs) = w; }
        }
        __syncthreads();
      }
    }
    if ((DBG_SKIP) & 1024) { for (int i = tid; i < T * 64; i += NTHR) YR[(size_t)(b * T + (i >> 6)) * 512 + h * 64 + (i & 63)] = (bf16_t)0; }
    (void)acc;
#undef CS_LOAD
}

__device__ __forceinline__ void rwkv_post2_phase(Frame& F, const Args& A) {
    F.tid = fresh_tid(); F.lane = F.tid & 63;
    const int gw = F.vcu * NWAVES + F.wave, NGW = F.G * NWAVES, lane = F.lane;
    const bf16_t* P1 = (const bf16_t*)(F.ws + WS_P1); const float* WAG = (const float*)(F.ws + WS_WAG); const bf16_t* YR = (const bf16_t*)(F.ws + WS_YRAW); bf16_t* YC = (bf16_t*)(F.ws + WS_YC1); const float* BON = (const float*)(F.ws + WS_BON);
    const float* mu = A.in[16];
    const int hq = gw & 1, hd = hq * 4 + (lane >> 4), hc = hd * 64 + (lane & 15) * 4;
    const f32x4 muv = *(const f32x4*)(mu + R_V + hc), lg = *(const f32x4*)(A.in[25] + hc), lb = *(const f32x4*)(A.in[26] + hc);
#define UNP4(dst, w) do { dst[0] = bflo((w).x); dst[1] = bfhi((w).x); dst[2] = bflo((w).y); dst[3] = bfhi((w).y); } while (0)
    for (int it0 = gw; it0 < M * 2; it0 += 2 * NGW) {
        u32x2 cv[2], pv[2], yw[2]; f32x4 g4[2]; float bo[2]; int mm[2]; bool ok[2];
#pragma unroll
        for (int j = 0; j < 2; ++j) { const int it = it0 + j * NGW; ok[j] = it < M * 2; const int m = ok[j] ? (it >> 1) : 0; mm[j] = m; const bf16_t* rp = P1 + (size_t)m * N1P; const bool hp = (m % T) > 0;
            cv[j] = *(const u32x2*)(rp + R_V + hc); pv[j] = hp ? *(const u32x2*)(rp - N1P + R_V + hc) : (u32x2){0u, 0u};
            g4[j] = *(const f32x4*)(WAG + (size_t)2 * M * 512 + (size_t)m * 512 + hc); yw[j] = ((DBG_SKIP) & 256) ? (u32x2){0u, 0u} : *(const u32x2*)(YR + (size_t)m * 512 + hc); bo[j] = ((DBG_SKIP) & 128) ? 0.f : BON[(size_t)m * 8 + hd]; }
#pragma unroll
        for (int j = 0; j < 2; ++j) { f32x4 v, v0, y; UNP4(v, cv[j]); UNP4(v0, pv[j]); UNP4(y, yw[j]);
            v = v + (v0 - v) * muv;
            const float mean = dpp_sum16((y[0] + y[1]) + (y[2] + y[3])) * (1.0f / 64.0f); const f32x4 d = y - mean;
            const float var = dpp_sum16((d[0] * d[0] + d[1] * d[1]) + (d[2] * d[2] + d[3] * d[3])) * (1.0f / 64.0f); const float rstd = rsqrtf(var + 64e-5f);
            const f32x4 o = (d * rstd * lg + lb + v * bo[j]) * g4[j];
            if (ok[j]) { u32x2 w; w.x = cvt_pk_bf16(o[0], o[1]); w.y = cvt_pk_bf16(o[2], o[3]); *(u32x2*)(YC + (size_t)mm[j] * D + hc) = w; } }
    }
#undef UNP4
}
constexpr int N_PHASES = 19;
#ifndef MK_N_LAUNCHES
#define MK_N_LAUNCHES 1
#endif
__global__ void __launch_bounds__(NTHR, 2) trunk_fwd(Args args) {
    extern __shared__ __attribute__((aligned(16))) unsigned char lds_raw[];
    Frame F;
    F.lds = (LAS unsigned char*)lds_raw;
    F.tid = fresh_tid(); F.lane = F.tid & 63; F.wave = __builtin_amdgcn_readfirstlane(F.tid >> 6);
    F.G = gridDim.x; { const int bx = blockIdx.x; F.vcu = (F.G % 8 == 0) ? (bx % 8) * (F.G / 8) + bx / 8 : bx; }
    F.ws = args.ws; F.ctl = (unsigned*)(args.ws + WS_CTL);
    unsigned char* ws = args.ws; float* H = args.out;
    for (int u = F.tid; u < (LDS_BYTES - LDSCTL_OFF) / 4; u += NTHR) ((LAS unsigned*)(F.lds + LDSCTL_OFF))[u] = 0u;
    __syncthreads();
    const int lo = args.ph_lo, hi = args.ph_hi;
    XcdBarrier bar; bar.bar = (unsigned*)(F.ctl + CW_BAR); bar.x = 0; bar.st = nullptr;
    if (hi - lo > 1) bar = xcd_barrier_post((unsigned*)(F.ctl + CW_BAR), (volatile LAS unsigned*)(F.lds + MISC_OFF) + 8);
#ifndef DBG_SKIP
#define DBG_SKIP 0
#endif
#ifndef DBL_MASK
#define DBL_MASK 0
#endif
#define REP(k) for (int rep_ = 0; rep_ < (((DBL_MASK) >> (k)) & 1) + 1; ++rep_)
#ifndef PH_MASK
#define PH_MASK 0x7FFFF
#endif
#define IN(k) ((((PH_MASK) >> (k)) & 1) && lo <= (k) && (k) < hi)
#define SEAM(k) do { if (IN(k) && IN((k) + 1)) xcd_barrier(bar); } while (0)
    constexpr int CV_G1 = 0, CV_G3 = CV_G1 + 64 * 8 * 8, CV_G5 = CV_G3 + 128 * 8 * 11, CV_LORA = CV_G5 + 128 * 8 * 11, CV_SCAN = CV_LORA + 128 * 8 * 3, CV_P11 = CV_SCAN + 192 * 8 * 0;
    typedef pg8::u64 u64; const u64* ssq0 = (const u64*)(F.ctl + CW_SSQ0); u64* ssq1 = (u64*)(F.ctl + CW_SSQ1); u64* ssq2 = (u64*)(F.ctl + CW_SSQ2); u64* ssq3 = (u64*)(F.ctl + CW_SSQ3);

    if (IN(0)) REP(0) { if (rep_) xcd_barrier(bar); p0_prologue(F, args); } SEAM(0);
#ifdef XBAR_PROBE
    for (int xb_ = 0; xb_ < XBAR_PROBE; ++xb_) XBAR_FN(bar);
#endif
    if (IN(1)) REP(1) { if (rep_) xcd_barrier(bar);
        pg8::StaticOrder S; S.init(M, N0P, F.G, (int)blockIdx.x);
        pg8::EpiRowScale E{(bf16_t*)(ws + WS_P0), N0P, ssq0, -1, -1, 1.0f, nullptr, -1};
        pg8::gemm_phase<pg8::EpiRowScale, pg8::StaticOrder, false>(F.lds, (const bf16_t*)(ws + WS_XB), (const bf16_t*)(ws + WS_W0T), D, S, E);
        if (!rep_ && (int)blockIdx.x >= 192) { __syncthreads(); moe_convert(F, args, ((int)blockIdx.x - 192) * NWAVES + F.wave, 64 * NWAVES, CV_G1, CV_G3); }
    } SEAM(1);
    if (IN(2)) REP(2) { if (rep_) xcd_barrier(bar); conv_phase(F, args); gla_x_phase(F, args); } SEAM(2);
    if (IN(3)) REP(3) { if (rep_) xcd_barrier(bar); gla_carry_phase(F, args); } SEAM(3);
    if (IN(4)) REP(4) { if (rep_) xcd_barrier(bar); gla_z_phase(F, args); } SEAM(4);
    if (IN(5)) REP(5) { if (rep_) xcd_barrier(bar);
        pg8::StaticOrder S; S.init(M, D, F.G, (int)blockIdx.x);
        pg8::EpiResid<false> E{(const bf16_t*)(ws + WS_XB), (bf16_t*)(ws + WS_H1B), nullptr, ssq1, rep_ == 0};
        pg8::gemm_phase<pg8::EpiResid<false>, pg8::StaticOrder, false>(F.lds, (const bf16_t*)(ws + WS_YC0), (const bf16_t*)(ws + WS_WO0T), D, S, E);
    } SEAM(5);
    if (IN(6)) REP(6) { if (rep_) xcd_barrier(bar);
        pg8::StaticOrder S; S.init(M, 2 * FF, F.G, (int)blockIdx.x);
        pg8::EpiSwiGLU<false> E{(bf16_t*)(ws + WS_ACT), FF, ssq1, nullptr, nullptr};
        pg8::gemm_phase<pg8::EpiSwiGLU<false>, pg8::StaticOrder, false>(F.lds, (const bf16_t*)(ws + WS_H1B), (const bf16_t*)(ws + WS_W13T), D, S, E);
        if (!rep_ && (int)blockIdx.x >= 128) { __syncthreads(); moe_convert(F, args, ((int)blockIdx.x - 128) * NWAVES + F.wave, 128 * NWAVES, CV_G3, CV_G5); }
    } SEAM(6);
    if (IN(7)) REP(7) { if (rep_) xcd_barrier(bar);
        pg8::StaticOrder S; S.init(M, D, F.G, (int)blockIdx.x);
        pg8::EpiResid<false> E{(const bf16_t*)(ws + WS_H1B), (bf16_t*)(ws + WS_H2B), nullptr, ssq2, rep_ == 0};
        pg8::gemm_phase<pg8::EpiResid<false>, pg8::StaticOrder, false>(F.lds, (const bf16_t*)(ws + WS_ACT), (const bf16_t*)(ws + WS_W2T), FF, S, E);
    } SEAM(7);
    if (IN(8)) REP(8) { if (rep_) xcd_barrier(bar);
        pg8::StaticOrder S; S.init(M, N1P, F.G, (int)blockIdx.x);
        pg8::EpiRowScale E{(bf16_t*)(ws + WS_P1), N1P, ssq2, F_Q, F_K, C2LOG, (float*)(ws + WS_FL32), F_L};
        pg8::gemm_phase<pg8::EpiRowScale, pg8::StaticOrder, false>(F.lds, (const bf16_t*)(ws + WS_H2B), (const bf16_t*)(ws + WS_W1IN), D, S, E);
        if (!rep_ && (int)blockIdx.x >= 128) { __syncthreads(); moe_convert(F, args, ((int)blockIdx.x - 128) * NWAVES + F.wave, 128 * NWAVES, CV_G5, CV_P11); }
    } SEAM(8);
    if (IN(9)) REP(9) { if (rep_) xcd_barrier(bar); lora_prep_phase(F, args); } SEAM(9);
    if (IN(10)) REP(10) { if (rep_) xcd_barrier(bar);
        pg8::StaticOrder S; S.init(M, 1536, F.G, (int)blockIdx.x);
        pg8::EpiLora E{(float*)(ws + WS_WAG), args.in[18], args.in[20], M};
        int k256 = 256; asm volatile("" : "+s"(k256));
        pg8::gemm_phase<pg8::EpiLora, pg8::StaticOrder, false>(F.lds, (const bf16_t*)(ws + WS_ALORA), (const bf16_t*)(ws + WS_LORA), k256, S, E);
        if (!rep_ && (int)blockIdx.x >= 128) { __syncthreads(); moe_convert(F, args, ((int)blockIdx.x - 128) * NWAVES + F.wave, 128 * NWAVES, CV_LORA, CV_SCAN); }
    } SEAM(10);
    if (IN(11)) REP(11) { if (rep_) xcd_barrier(bar);
        const int half_ = (int)blockIdx.x & 1, cwi_ = ((int)blockIdx.x >> 1) * NWAVES + F.wave, cnw_ = (F.G / 2) * NWAVES;
        if (half_) { moe_convert(F, args, 2 * cwi_ + 1, 2 * cnw_, CV_P11); __syncthreads(); }
        rwkv_pre_phase(F, args);
        __syncthreads();
        { const attn_body::AttnTensors AT{(const attn_body::bf16*)(ws + WS_P1) + F_Q, (const attn_body::bf16*)(ws + WS_P1) + F_K, (const attn_body::bf16*)(ws + WS_P1) + F_V, (attn_body::bf16*)(ws + WS_YC1) + 512, (const unsigned long long*)(ws + WS_CAUG)};
          const attn_body::StaticOrder S(256, (int)F.vcu);
          attn_body::attn_phase<attn_body::StaticOrder, 32>((char*)lds_raw, AT, S); }
        __syncthreads();
        if (!half_) moe_convert(F, args, 2 * cwi_, 2 * cnw_, CV_P11);
    } SEAM(11);
    if (IN(12)) REP(12) { if (rep_) xcd_barrier(bar); if (blockIdx.x < 64) rwkv_cscan_phase(F, args, (int)blockIdx.x, rep_); else if (!rep_) moe_convert(F, args, ((int)blockIdx.x - 64) * NWAVES + F.wave, 192 * NWAVES, CV_SCAN, CV_P11); } SEAM(12);
    if (IN(13)) REP(13) { if (rep_) xcd_barrier(bar); rwkv_post2_phase(F, args); } SEAM(13);
    if (IN(14)) REP(14) { if (rep_) xcd_barrier(bar);
        pg8::StaticOrder S; S.init(M, D, F.G, (int)blockIdx.x);
        pg8::EpiResid<true> E{(const bf16_t*)(ws + WS_H2B), (bf16_t*)(ws + WS_H3), ws + WS_H3B, ssq3, rep_ == 0};
        pg8::gemm_phase<pg8::EpiResid<true>, pg8::StaticOrder, false>(F.lds, (const bf16_t*)(ws + WS_YC1), (const bf16_t*)(ws + WS_WO1T), D, S, E);
    } SEAM(14);
    if (IN(15)) REP(15) { if (rep_) xcd_barrier(bar); router_phase(F, args, (const bf16_t*)(ws + WS_H3)); } SEAM(15);
    if (IN(16)) REP(16) { if (rep_) xcd_barrier(bar);
        MoeOrder S; { const unsigned* cp = F.ctl + CW_CNT; for (int e = 0; e < 8; ++e) S.cn[e] = __builtin_amdgcn_readfirstlane((int)cp[e]); } S.NT = 2 * FE / 256; S.G = F.G; S.c = (int)blockIdx.x; S.down = false; S.kdiv = 2; S.lists = (const int*)(ws + WS_LIST); S.glists = (const float*)(ws + WS_GLIST);
        pg8::EpiSwiGLU<true, true> E{(bf16_t*)(ws + WS_ACTE), FE, ssq3, (const float*)(ws + WS_RLIST), (const int*)(ws + WS_LIST)};
        pg8::gemm_phase<pg8::EpiSwiGLU<true, true>, MoeOrder, true, true>(F.lds, (const bf16_t*)(ws + WS_H3B), (const bf16_t*)(ws + WS_WE13T), D / 2, S, E);
    } SEAM(16);
    if (IN(17)) REP(17) { if (rep_) xcd_barrier(bar);
        MoeOrder S; { const unsigned* cp = F.ctl + CW_CNT; for (int e = 0; e < 8; ++e) S.cn[e] = __builtin_amdgcn_readfirstlane((int)cp[e]); } S.NT = D / 256; S.G = F.G; S.c = (int)blockIdx.x; S.down = true; S.kdiv = 2; S.lists = (const int*)(ws + WS_LIST); S.glists = (const float*)(ws + WS_GLIST);
        pg8::EpiMoeDown E{(bf16_t*)(ws + WS_OUTS), (bf16_t*)(ws + WS_OUTP), S.split_tail() ? S.tail_row0() : 0, MOE_TAIL_ROWS, 1.0f / (pg8::Q8_ACT * pg8::Q8_W)};
        pg8::gemm_phase<pg8::EpiMoeDown, MoeOrder, false, true>(F.lds, (const bf16_t*)(ws + WS_ACTE), (const bf16_t*)(ws + WS_WE2T), FE / 2, S, E);
    } SEAM(17);
    if (IN(18)) REP(18) { if (rep_) xcd_barrier(bar); final_phase(F, args, (const bf16_t*)(ws + WS_H3), H); }
#undef IN
#undef SEAM
}

extern "C" void kernel_launch(void* const* d_in, const int* in_sizes, int n_in, void* d_out, int out_size, void* d_ws, size_t ws_size, hipStream_t stream) {
    static int grid = 0;
    if (grid == 0) {
        if (n_in != 34 || out_size != M * D || ws_size < WS_END) { fprintf(stderr, "kernel_launch: unexpected problem (n_in %d out %d ws %zu need %zu)\n", n_in, out_size, ws_size, (size_t)WS_END); grid = -1; return; }
        int dev = 0, cus = 0, per_cu = 0;
        if (hipGetDevice(&dev) != hipSuccess || hipDeviceGetAttribute(&cus, hipDeviceAttributeMultiprocessorCount, dev) != hipSuccess) { grid = -1; return; }
        if (hipFuncSetAttribute((const void*)trunk_fwd, hipFuncAttributeMaxDynamicSharedMemorySize, LDS_BYTES) != hipSuccess) { fprintf(stderr, "kernel_launch: hipFuncSetAttribute failed\n"); grid = -1; return; }
        if (hipOccupancyMaxActiveBlocksPerMultiprocessor(&per_cu, (const void*)trunk_fwd, NTHR, LDS_BYTES) != hipSuccess || per_cu < 1) fprintf(stderr, "kernel_launch: occupancy query reports %d\n", per_cu);
        (void)hipGetLastError();
        grid = 256;
        if (cus < 256) { fprintf(stderr, "kernel_launch: device has %d CUs, need 256\n", cus); grid = -1; return; }
    }
    if (grid < 0) return;
    (void)in_sizes;
    (void)hipMemsetAsync((char*)d_ws + WS_CTL, 0, CTL_BYTES, stream);
    Args a{};
    for (int i = 0; i < 34; ++i) a.in[i] = (const float*)d_in[i];
    a.out = (float*)d_out; a.ws = (unsigned char*)d_ws;
    for (int li = 0; li < MK_N_LAUNCHES; ++li) {
        a.ph_lo = (MK_N_LAUNCHES == 1) ? 0 : li; a.ph_hi = (MK_N_LAUNCHES == 1) ? N_PHASES : li + 1;
        hipLaunchKernelGGL(trunk_fwd, dim3(grid), dim3(NTHR), LDS_BYTES, stream, a);
    }
}
```
